# Optimizing an MI355X kernel written in HIP

```python
import math
import jax
import jax.numpy as jnp
from jax import lax
import numpy as np

D_MODEL = 1024
BATCH = 4
SEQ = 8192
DEPTH = 4

N_MEM = 256
N_MIXERS = 3
EPS = 1e-6

D_MIX = D_MODEL
XA_HEADS = 4
XA_HEAD_DIM = 128
D_XA = XA_HEADS * XA_HEAD_DIM
D_CAT = D_MIX + D_XA
D_GATE = D_CAT

GM_CHUNK = 128
GM_GROUPS = 8
GM_GROUP_DIM = D_MIX // GM_GROUPS

SC_WIDTH = 3

DN_HEADS = 8
DN_HEAD_DIM = D_MIX // DN_HEADS
DN_CONV = 4
DN_CHUNK = 64

N_LAYERS_A = (DEPTH + 2) // N_MIXERS
N_LAYERS_B = (DEPTH + 1) // N_MIXERS
N_LAYERS_C = DEPTH // N_MIXERS

A_IN = 2 * D_MIX + D_XA + D_GATE
B_IN = 3 * D_MIX + D_XA + D_GATE
C_IN = 3 * D_MIX + 2 * DN_HEADS + D_XA + D_GATE

kernel_name = "hybrid_gmlp_shortconv_gdn_memattn_trunk"


def rmsnorm(x, w):
    xf = x.astype(jnp.float32)
    y = xf * lax.rsqrt(jnp.mean(xf * xf, axis=-1, keepdims=True) + EPS)
    return (y * w.astype(jnp.float32)).astype(x.dtype)


def layernorm(x, w, b):
    xf = x.astype(jnp.float32)
    xc = xf - jnp.mean(xf, axis=-1, keepdims=True)
    y = xc * lax.rsqrt(jnp.mean(xc * xc, axis=-1, keepdims=True) + EPS)
    return (y * w.astype(jnp.float32) + b.astype(jnp.float32)).astype(x.dtype)


def l2norm(x):
    xf = x.astype(jnp.float32)
    return xf * lax.rsqrt(jnp.sum(xf * xf, axis=-1, keepdims=True) + EPS)


def causal_depthwise_conv(x, w):
    K = w.shape[0]
    S = x.shape[1]
    xp = jnp.pad(x, ((0, 0), (K - 1, 0), (0, 0)))
    y = xp[:, 0:S] * w[0]
    for k in range(1, K):
        y = y + xp[:, k:k + S] * w[k]
    return y


def memory_attention(q, mem_k, mem_v):
    B, S, _ = q.shape
    qh = q.reshape(B, S, XA_HEADS, XA_HEAD_DIM)
    s = jnp.einsum("bshd,bmhd->bhsm", qh, mem_k).astype(jnp.float32) * (XA_HEAD_DIM ** -0.5)
    p = jax.nn.softmax(s, axis=-1).astype(q.dtype)
    o = jnp.einsum("bhsm,bmhd->bshd", p, mem_v)
    return o.reshape(B, S, D_XA)


def chunked_causal_gmlp(u, v, ln_w, ln_b, w_s, b_s):
    B, S, _ = u.shape
    n_chunks = S // GM_CHUNK
    u = jax.nn.gelu(u)
    v = layernorm(jax.nn.gelu(v), ln_w, ln_b)
    vc = v.reshape(B, n_chunks, GM_CHUNK, GM_GROUPS, GM_GROUP_DIM)
    causal = jnp.tril(jnp.ones((GM_CHUNK, GM_CHUNK), dtype=bool))
    ws = jnp.where(causal[None], w_s, jnp.zeros_like(w_s))
    sp = jnp.einsum("gts,bnsgc->bntgc", ws, vc) + b_s.T[:, :, None]
    return u * sp.reshape(B, S, D_MIX)


def chunk_gated_delta_rule(q, k, v, g, beta):
    B, S, H, D = q.shape
    C = DN_CHUNK
    N = S // C

    def to_chunks(t):
        t = t.reshape((B, N, C, H) + t.shape[3:])
        return jnp.moveaxis(t, 3, 1)

    qc, kc, vc = to_chunks(q), to_chunks(k), to_chunks(v)
    gc, bc = to_chunks(g), to_chunks(beta)
    gcum = jnp.cumsum(gc, axis=-1)
    incl = jnp.tril(jnp.ones((C, C), dtype=bool))
    strict = jnp.tril(jnp.ones((C, C), dtype=bool), k=-1)
    decay = jnp.exp(jnp.where(incl, gcum[..., :, None] - gcum[..., None, :], -jnp.inf))
    kb = kc * bc[..., None]
    a_mat = jnp.where(strict, jnp.einsum("bhnid,bhnjd->bhnij", kb, kc) * decay, 0.0)
    eye = jnp.eye(C, dtype=q.dtype)
    t_mat = lax.linalg.triangular_solve(eye + a_mat, jnp.broadcast_to(eye, a_mat.shape),
                                        left_side=True, lower=True, unit_diagonal=True)
    u_c = jnp.einsum("bhnij,bhnjd->bhnid", t_mat, vc * bc[..., None])
    w_c = jnp.einsum("bhnij,bhnjd->bhnid", t_mat, kb * jnp.exp(gcum)[..., None])
    qk = jnp.einsum("bhnid,bhnjd->bhnij", qc, kc) * decay
    q_dec = qc * jnp.exp(gcum)[..., None]
    k_dec = kc * jnp.exp(gcum[..., -1:] - gcum)[..., None]
    g_last = jnp.exp(gcum[..., -1])
    xs = tuple(jnp.moveaxis(t, 2, 0) for t in (q_dec, qk, u_c, w_c, k_dec, g_last))

    def step(state, inp):
        q_i, qk_i, u_i, w_i, k_i, gl_i = inp
        v_new = u_i - jnp.einsum("bhcd,bhde->bhce", w_i, state)
        o_i = (jnp.einsum("bhcd,bhde->bhce", q_i, state)
               + jnp.einsum("bhij,bhje->bhie", qk_i, v_new))
        state = state * gl_i[..., None, None] + jnp.einsum("bhcd,bhce->bhde", k_i, v_new)
        return state, o_i

    state0 = jnp.zeros((B, H, D, D), dtype=q.dtype)
    _, o = lax.scan(step, state0, xs)
    o = jnp.transpose(o, (1, 0, 3, 2, 4))
    return o.reshape(B, S, H, D)


def gated_deltanet(qkv, a, b, conv_w, a_log, dt_bias, o_norm_w):
    B, S, _ = qkv.shape
    dtype = qkv.dtype
    qkv = jax.nn.silu(causal_depthwise_conv(qkv, conv_w))
    q, k, v = jnp.split(qkv, 3, axis=-1)
    shp = (B, S, DN_HEADS, DN_HEAD_DIM)
    q = l2norm(q.reshape(shp)) * (DN_HEAD_DIM ** -0.5)
    k = l2norm(k.reshape(shp))
    v = v.reshape(shp).astype(jnp.float32)
    beta = jax.nn.sigmoid(b.astype(jnp.float32))
    g = -jnp.exp(a_log.astype(jnp.float32)) * jax.nn.softplus(
        a.astype(jnp.float32) + dt_bias.astype(jnp.float32))
    o = chunk_gated_delta_rule(q, k, v, g, beta)
    o = rmsnorm(o, o_norm_w)
    return o.reshape(B, S, D_MIX).astype(dtype)


def branch_a(h, w_in, ln_w, ln_b, w_s, b_s, mem_k, mem_v):
    u, v, qx, z = jnp.split(h @ w_in, [D_MIX, 2 * D_MIX, 2 * D_MIX + D_XA], axis=-1)
    y = chunked_causal_gmlp(u, v, ln_w, ln_b, w_s, b_s)
    return jnp.concatenate([y, memory_attention(qx, mem_k, mem_v)], axis=-1) * jax.nn.silu(z)


def branch_b(h, w_in, conv_w, mem_k, mem_v):
    bg, cg, hv, qx, z = jnp.split(h @ w_in, [D_MIX, 2 * D_MIX, 3 * D_MIX, 3 * D_MIX + D_XA], axis=-1)
    y = bg * causal_depthwise_conv(cg * hv, conv_w)
    return jnp.concatenate([y, memory_attention(qx, mem_k, mem_v)], axis=-1) * jax.nn.silu(z)


def branch_c(h, w_in, conv_w, a_log, dt_bias, o_norm_w, mem_k, mem_v):
    c0 = 3 * D_MIX
    qkv, a, b, qx, z = jnp.split(
        h @ w_in, [c0, c0 + DN_HEADS, c0 + 2 * DN_HEADS, c0 + 2 * DN_HEADS + D_XA], axis=-1)
    y = gated_deltanet(qkv, a, b, conv_w, a_log, dt_bias, o_norm_w)
    return jnp.concatenate([y, memory_attention(qx, mem_k, mem_v)], axis=-1) * jax.nn.silu(z)


def setup_inputs(seed: int = 0) -> dict:
    key = jax.random.key(seed)
    ks = jax.random.split(key, 20)
    f32 = jnp.float32

    def normal(k, shape, scale):
        return jax.random.normal(k, shape, f32) * scale

    def gain(k, shape):
        return 1.0 + 0.02 * jax.random.normal(k, shape, f32)

    a_coef = jax.random.uniform(ks[17], (N_LAYERS_C, DN_HEADS), f32, 1.0, 16.0)
    dt = jnp.exp(jax.random.uniform(ks[18], (N_LAYERS_C, DN_HEADS), f32,
                                    math.log(1e-3), math.log(1e-1)))
    return {
        "x": normal(ks[0], (BATCH, SEQ, D_MODEL), 1.0),
        "mem": normal(ks[1], (BATCH, N_MEM, D_MODEL), 1.0),
        "mem_norm_w": gain(ks[2], (D_MODEL,)),
        "w_mem_kv": normal(ks[3], (D_MODEL, 2 * D_XA), D_MODEL ** -0.5),
        "norm_pre": gain(ks[4], (DEPTH, D_MODEL)),
        "norm_post": gain(ks[5], (DEPTH, D_MODEL)),
        "w_out": normal(ks[6], (DEPTH, D_CAT, D_MODEL), D_CAT ** -0.5),
        "a_w_in": normal(ks[7], (N_LAYERS_A, D_MODEL, A_IN), D_MODEL ** -0.5),
        "a_ln_w": gain(ks[8], (N_LAYERS_A, D_MIX)),
        "a_ln_b": normal(ks[9], (N_LAYERS_A, D_MIX), 0.02),
        "a_w_s": normal(ks[10], (N_LAYERS_A, GM_GROUPS, GM_CHUNK, GM_CHUNK), 0.5 * GM_CHUNK ** -0.5),
        "a_b_s": gain(ks[11], (N_LAYERS_A, GM_GROUPS, GM_CHUNK)),
        "b_w_in": normal(ks[12], (N_LAYERS_B, D_MODEL, B_IN), D_MODEL ** -0.5),
        "b_conv_w": normal(ks[13], (N_LAYERS_B, SC_WIDTH, D_MIX), SC_WIDTH ** -0.5),
        "c_w_in": normal(ks[14], (N_LAYERS_C, D_MODEL, C_IN), D_MODEL ** -0.5),
        "c_conv_w": normal(ks[15], (N_LAYERS_C, DN_CONV, 3 * D_MIX), DN_CONV ** -0.5),
        "c_a_log": jnp.log(a_coef),
        "c_dt_bias": dt + jnp.log(-jnp.expm1(-dt)),
        "c_o_norm_w": gain(ks[16], (N_LAYERS_C, DN_HEAD_DIM)),
    }


def reference(x, mem, mem_norm_w, w_mem_kv, norm_pre, norm_post, w_out,
              a_w_in, a_ln_w, a_ln_b, a_w_s, a_b_s,
              b_w_in, b_conv_w,
              c_w_in, c_conv_w, c_a_log, c_dt_bias, c_o_norm_w):
    B = mem.shape[0]
    mem_k, mem_v = jnp.split(rmsnorm(mem, mem_norm_w) @ w_mem_kv, 2, axis=-1)
    mem_k = mem_k.reshape(B, N_MEM, XA_HEADS, XA_HEAD_DIM)
    mem_v = mem_v.reshape(B, N_MEM, XA_HEADS, XA_HEAD_DIM)
    for i in range(DEPTH):
        kind, j = i % N_MIXERS, i // N_MIXERS
        h = rmsnorm(x, norm_pre[i])
        if kind == 0:
            y = branch_a(h, a_w_in[j], a_ln_w[j], a_ln_b[j], a_w_s[j], a_b_s[j], mem_k, mem_v)
        elif kind == 1:
            y = branch_b(h, b_w_in[j], b_conv_w[j], mem_k, mem_v)
        else:
            y = branch_c(h, c_w_in[j], c_conv_w[j], c_a_log[j], c_dt_bias[j], c_o_norm_w[j],
                         mem_k, mem_v)
        x = x + rmsnorm(y @ w_out[i], norm_post[i])
    return x
```

```cpp
#include <hip/hip_runtime.h>
#include <hip/hip_cooperative_groups.h>
#include <cstdio>
namespace cg = cooperative_groups;

#define DI __device__ __forceinline__
typedef unsigned short bf16_t;
typedef short bf16x8 __attribute__((ext_vector_type(8)));
typedef float f32x4 __attribute__((ext_vector_type(4)));
typedef unsigned u32x4 __attribute__((ext_vector_type(4)));
typedef unsigned u32x2 __attribute__((ext_vector_type(2)));

constexpr int NTOK = 32768;
constexpr float EPS = 1e-6f;
constexpr int LDS_BYTES = 149568;
constexpr int OPS_STRIDE = 73728;

constexpr size_t SZ_W1A = 2560ull * 1024 * 2, SZ_W1B = 3584ull * 1024 * 2, SZ_W1C = 3840ull * 1024 * 2;
constexpr size_t OFF_W1_0 = 0;
constexpr size_t OFF_W1_1 = OFF_W1_0 + SZ_W1A;
constexpr size_t OFF_W1_2 = OFF_W1_1 + SZ_W1B;
constexpr size_t OFF_W1_3 = OFF_W1_2 + SZ_W1C;
constexpr size_t SZ_W2 = 1536ull * 1024 * 2;
constexpr size_t OFF_W2 = OFF_W1_3 + SZ_W1A;
constexpr size_t OFF_WO = OFF_W2 + 4 * SZ_W2;
constexpr size_t OFF_WM = OFF_WO + 4 * SZ_W2;
constexpr size_t OFF_WS = OFF_WM + 2097152;
constexpr size_t OFF_HMEM = OFF_WS + 524288;
constexpr size_t OFF_KIMG = OFF_HMEM + 2097152;
constexpr size_t OFF_VIMG = OFF_KIMG + 1048576;
constexpr size_t OFF_AB = OFF_VIMG + 1048576;
constexpr size_t OFF_SSQ = OFF_AB + 2097152;
constexpr size_t OFF_GL = OFF_SSQ + 1048576;
constexpr size_t OFF_ST = OFF_GL + 65536;
constexpr size_t OFF_STASH = OFF_ST + 2097152;
constexpr size_t OFF_BAR = OFF_STASH + 131072;
constexpr size_t OFF_PRM = OFF_BAR + 65536;
constexpr size_t OFF_H = OFF_PRM + 131072;
constexpr size_t OFF_MIX = OFF_H + 67108864;
constexpr size_t OFF_BIG = OFF_MIX + 100663296;
constexpr size_t BIG_VT = 67108864, BIG_QX = 134217728, BIG_OPS = 117440512;
static_assert(OFF_BIG + 268435456ull <= 536870912ull, "workspace overflow");

struct Params {
  const float *x, *mem, *mem_norm_w, *w_mem_kv, *norm_pre, *norm_post, *w_out, *a_w_in, *a_ln_w, *a_ln_b, *a_w_s, *a_b_s,
      *b_w_in, *b_conv_w, *c_w_in, *c_conv_w, *c_a_log, *c_dt_bias, *c_o_norm_w;
  float* out;
  char* ws;
};

typedef float f32x2 __attribute__((ext_vector_type(2)));
typedef __bf16 bf16x2_t __attribute__((ext_vector_type(2)));
DI unsigned pk2(float lo, float hi) { f32x2 v = {lo, hi}; bf16x2_t b = __builtin_convertvector(v, bf16x2_t); return __builtin_bit_cast(unsigned, b); }
DI float lo2f(unsigned p) { return __uint_as_float(p << 16); }
DI float hi2f(unsigned p) { return __uint_as_float(p & 0xffff0000u); }
DI float bf2f(bf16_t v) { return __uint_as_float(((unsigned)v) << 16); }
DI bf16_t f2bf(float f) { return (bf16_t)(pk2(f, 0.f) & 0xffffu); }
DI int zoff() { int z; asm volatile("s_mov_b32 %0, 0" : "=s"(z)); return z; }
DI int obid() { int r; asm volatile("s_mov_b32 %0, %1" : "=s"(r) : "s"(blockIdx.x)); return r; }
DI int ogrid() { int r; asm volatile("s_mov_b32 %0, %1" : "=s"(r) : "s"(gridDim.x)); return r; }
template <class T> DI T* lp(T* p) { return (T*)((char*)p + zoff()); }
DI int otid() { int t; asm volatile("v_mov_b32 %0, %1" : "=v"(t) : "v"(threadIdx.x)); return t; }
DI float wsum(float v) {
#pragma unroll
  for (int o = 32; o; o >>= 1) v += __shfl_xor(v, o);
  return v;
}
DI float sigmoidf_(float x) { return __builtin_amdgcn_rcpf(1.f + __expf(-x)); }
DI float siluf_(float x) { return x * sigmoidf_(x); }
DI float geluf_(float x) { const float u = 0.7978845608028654f * (x + 0.044715f * x * x * x); return x * sigmoidf_(2.f * u); }
DI f32x4 mfma16(bf16x8 a, bf16x8 b, f32x4 c) { return __builtin_amdgcn_mfma_f32_16x16x32_bf16(a, b, c, 0, 0, 0); }
DI bf16x8 pack8(f32x4 a, f32x4 b) {
  u32x4 p; p[0] = pk2(a[0], a[1]); p[1] = pk2(a[2], a[3]); p[2] = pk2(b[0], b[1]); p[3] = pk2(b[2], b[3]);
  return __builtin_bit_cast(bf16x8, p);
}
DI void unpack8(u32x4 p, float* v) {
#pragma unroll
  for (int i = 0; i < 4; i++) { v[2 * i] = lo2f(p[i]); v[2 * i + 1] = hi2f(p[i]); }
}

#define LAS __attribute__((address_space(3)))
constexpr int G_BM = 256, G_BK = 64, G_HALF = 128, G_HTB = G_HALF * G_BK * 2, G_NXCD = 8, G_WGM = 8;
DI int lds_byte(int r, int c) { const int st = (r >> 4) * 2 + (c >> 5), rr = r & 15, cc = c & 31, ob = rr * 64 + cc * 2; return st * 1024 + (ob ^ (((ob >> 9) & 1) << 5)); }
DI void stage_rc(int b, int& R, int& C) { const int st = b / 1024, sb = b % 1024, swz = sb ^ (((sb >> 9) & 1) << 5); R = (st >> 1) * 16 + swz / 64; C = (st & 1) * 32 + (swz % 64) / 2; }
struct UnitOrder {
  int nM, nN, nwg, G, c;
  DI void init(int M, int N, int G_, int c_) { nM = M / G_BM; nN = N / G_BM; nwg = nM * nN; G = G_; c = c_; }
  DI bool next(int i, int& pm, int& pn) const {
    const long L = (long)i * G + c; if (L >= nwg) return false;
    int wgid = (int)L; { const int q = nwg / G_NXCD, r = nwg % G_NXCD, xcd = wgid % G_NXCD, off = wgid / G_NXCD; wgid = (xcd < r ? xcd * (q + 1) : r * (q + 1) + (xcd - r) * q) + off; }
    const int nig = G_WGM * nN, gid = wgid / nig, fm = gid * G_WGM, gsz = (nM - fm) < G_WGM ? (nM - fm) : G_WGM;
    pm = fm + ((wgid % nig) % gsz); pn = (wgid % nig) / gsz; return true;
  }
};
template <class Epi>
DI void gemm_phase(const bf16_t* __restrict__ A, const bf16_t* __restrict__ Bt, int M, int N, int K, const Epi& epi, char* smem, int asplit = -1, int gG = -1, int gC = 0) {
  const int bx_ = obid(), G_ = ogrid(); (void)bx_; (void)G_;
  A = lp(A);
  Bt = lp(Bt);
  smem += zoff();
  LAS unsigned char* lds = (LAS unsigned char*)smem;
  const int tid = otid(), wid = __builtin_amdgcn_readfirstlane(tid >> 6), lane = tid & 63, wr = wid >> 2, wc = wid & 3, fr = lane & 15, fq = lane >> 4;
  const int nt = K / G_BK;
  unsigned voff[2];
#pragma unroll
  for (int i = 0; i < 2; ++i) { int R, C; stage_rc(tid * 16 + i * 8192, R, C); voff[i] = (unsigned)(R * K + C) * 2u; }
  const size_t kstep = (size_t)(G_BK * 2);
  const size_t hstep = (size_t)G_HALF * K * 2;
  const size_t tstep = 2 * hstep;
  const unsigned ldsw = (unsigned)wid * 1024u;
  const int aoff = lds_byte(wr * 64 + fr, fq * 8), boff = lds_byte(wc * 32 + fr, fq * 8);
#define PG8_SA(b, h) (((b) * 2 + (h)) * G_HTB)
#define PG8_SB(b, h) ((4 + (b) * 2 + (h)) * G_HTB)
#define PG8_STAGE(bufoff, gbase) do { _Pragma("unroll") for (int _i = 0; _i < 2; ++_i) \
    __builtin_amdgcn_global_load_lds((const unsigned*)((const char*)(gbase) + voff[_i]), (LAS unsigned*)(lds + (bufoff) + ldsw + _i * 8192), 16, 0, 0); } while (0)
#define PG8_LDA(dst, b, h) do { _Pragma("unroll") for (int m = 0; m < 4; ++m) _Pragma("unroll") for (int k = 0; k < 2; ++k) dst[m][k] = *(const LAS bf16x8*)(lds + PG8_SA(b, h) + aoff + m * 2048 + k * 1024); } while (0)
#define PG8_LDB(dst, b, h) do { _Pragma("unroll") for (int n = 0; n < 2; ++n) _Pragma("unroll") for (int k = 0; k < 2; ++k) dst[n][k] = *(const LAS bf16x8*)(lds + PG8_SB(b, h) + boff + n * 2048 + k * 1024); } while (0)
#define PG8_MMA(ai, bj, At, Bt_) do { __builtin_amdgcn_s_setprio(1); _Pragma("unroll") for (int m = 0; m < 4; ++m) _Pragma("unroll") for (int n = 0; n < 2; ++n) _Pragma("unroll") for (int k = 0; k < 2; ++k) \
    acc[ai][bj][m][n] = __builtin_amdgcn_mfma_f32_16x16x32_bf16(Bt_[n][k], At[m][k], acc[ai][bj][m][n], 0, 0, 0); __builtin_amdgcn_s_setprio(0); } while (0)
#define PG8_WAIT_V(n) asm volatile("s_waitcnt vmcnt(" #n ")" ::: "memory")
#define PG8_WAIT_L(n) asm volatile("s_waitcnt lgkmcnt(" #n ")" ::: "memory")
#define PG8_BAR __builtin_amdgcn_s_barrier()
#define PG8_SCHED __builtin_amdgcn_sched_barrier(0)
#define PG8_AROW(pm) ((size_t)(asplit < 0 ? (pm) * 256 : (((pm) >> 4) << 13) + asplit + (((pm) & 15) << 8)))
  UnitOrder S; S.init(M, N, gG < 0 ? G_ : gG, gG < 0 ? bx_ : gC);
  int cpm, cpn, npm = 0, npn = 0, ui = 0;
  if (!S.next(0, cpm, cpn)) return;
  f32x4 acc[2][2][4][2];
#pragma unroll
  for (int a = 0; a < 2; ++a)
#pragma unroll
    for (int b = 0; b < 2; ++b)
#pragma unroll
      for (int m = 0; m < 4; ++m)
#pragma unroll
        for (int n = 0; n < 2; ++n) acc[a][b][m][n] = (f32x4){0.f, 0.f, 0.f, 0.f};
  bf16x8 At[4][2], B0[2][2], B1[2][2];
  const char* cA = (const char*)A + PG8_AROW(cpm) * K * 2; const char* cB = (const char*)Bt + (size_t)cpn * tstep;
  PG8_STAGE(PG8_SB(0, 0), cB); PG8_STAGE(PG8_SA(0, 0), cA); PG8_STAGE(PG8_SB(0, 1), cB + hstep); PG8_STAGE(PG8_SA(0, 1), cA + hstep);
  if (wr == 1) PG8_BAR;
  PG8_WAIT_V(4); PG8_BAR;
  PG8_STAGE(PG8_SB(1, 0), cB + kstep); PG8_STAGE(PG8_SA(1, 0), cA + kstep); PG8_STAGE(PG8_SB(1, 1), cB + hstep + kstep);
  PG8_WAIT_V(6); PG8_BAR;
  for (;;) {
    const bool has_next = S.next(ui + 1, npm, npn);
    const char* nA = has_next ? (const char*)A + PG8_AROW(npm) * K * 2 : cA; const char* nB = has_next ? (const char*)Bt + (size_t)npn * tstep : cB;
    for (int t = 0; t < nt; t += 2) {
      const bool last = (t == nt - 2);
      const char* a1 = cA + (size_t)(t + 1) * kstep;
      const char* a2 = last ? nA : cA + (size_t)(t + 2) * kstep; const char* b2 = last ? nB : cB + (size_t)(t + 2) * kstep;
      const char* a3 = a2 + kstep; const char* b3 = b2 + kstep;
      PG8_LDB(B0, 0, 0); PG8_SCHED; PG8_LDA(At, 0, 0); PG8_STAGE(PG8_SA(1, 1), a1 + hstep);
      PG8_WAIT_L(8); PG8_BAR; PG8_WAIT_L(0); PG8_MMA(0, 0, At, B0); PG8_BAR; PG8_SCHED;
      PG8_LDB(B1, 0, 1); PG8_STAGE(PG8_SB(0, 0), b2);
      PG8_BAR; PG8_WAIT_L(0); PG8_MMA(0, 1, At, B1); PG8_BAR;
      PG8_LDA(At, 0, 1); PG8_STAGE(PG8_SA(0, 0), a2);
      PG8_BAR; PG8_WAIT_L(0); PG8_MMA(1, 0, At, B0); PG8_BAR; PG8_SCHED;
      PG8_STAGE(PG8_SB(0, 1), b2 + hstep);
      PG8_WAIT_V(6); PG8_BAR; PG8_MMA(1, 1, At, B1); PG8_BAR;
      PG8_LDB(B0, 1, 0); PG8_SCHED; PG8_LDA(At, 1, 0); PG8_STAGE(PG8_SA(0, 1), a2 + hstep);
      PG8_WAIT_L(8); PG8_BAR; PG8_WAIT_L(0); PG8_MMA(0, 0, At, B0); PG8_BAR; PG8_SCHED;
      PG8_LDB(B1, 1, 1); PG8_STAGE(PG8_SB(1, 0), b3);
      PG8_BAR; PG8_WAIT_L(0); PG8_MMA(0, 1, At, B1); PG8_BAR;
      PG8_LDA(At, 1, 1); PG8_STAGE(PG8_SA(1, 0), a3);
      PG8_BAR; PG8_WAIT_L(0); PG8_MMA(1, 0, At, B0); PG8_BAR; PG8_SCHED;
      PG8_STAGE(PG8_SB(1, 1), b3 + hstep);
      PG8_WAIT_V(6); PG8_BAR; PG8_MMA(1, 1, At, B1); PG8_BAR;
    }
#pragma unroll
    for (int ai = 0; ai < 2; ++ai)
#pragma unroll
      for (int m = 0; m < 4; ++m)
#pragma unroll
        for (int bj = 0; bj < 2; ++bj)
#pragma unroll
          for (int n = 0; n < 2; ++n)
            epi(cpm * 256 + ai * 128 + wr * 64 + m * 16 + fr, cpn * 256 + bj * 128 + wc * 32 + n * 16 + fq * 4, acc[ai][bj][m][n]);
    if (!has_next) break;
#pragma unroll
    for (int a = 0; a < 2; ++a)
#pragma unroll
      for (int b = 0; b < 2; ++b)
#pragma unroll
        for (int m = 0; m < 4; ++m)
#pragma unroll
          for (int n = 0; n < 2; ++n) acc[a][b][m][n] = (f32x4){0.f, 0.f, 0.f, 0.f};
    cpm = npm; cpn = npn; cA = nA; cB = nB; ++ui;
  }
  PG8_WAIT_V(0);
  if (wr == 0) PG8_BAR;
  PG8_BAR;
#undef PG8_SA
#undef PG8_SB
#undef PG8_STAGE
#undef PG8_LDA
#undef PG8_LDB
#undef PG8_MMA
#undef PG8_WAIT_V
#undef PG8_WAIT_L
#undef PG8_BAR
#undef PG8_SCHED
#undef PG8_AROW
}

struct EpiMem {
  bf16_t *kimg, *vimg;
  DI void operator()(int row, int col, f32x4 v) const {
    const int b = row >> 8, m = row & 255;
    const int cb = __builtin_amdgcn_readfirstlane(col & ~127);
    if (cb < 512) {
      const int head = col >> 7, d = col & 127;
      const int mt = m >> 4, n = m & 15, ks = d >> 5, jq = (d & 31) >> 3, j = d & 7;
      bf16_t* p = kimg + (size_t)(b * 4 + head) * 32768 + ((mt * 4 + ks) * 64 + jq * 16 + n) * 8 + j;
      *(u32x2*)p = (u32x2){pk2(v[0], v[1]), pk2(v[2], v[3])};
    } else {
      const int c2 = col - 512, head = c2 >> 7, d0 = c2 & 127;
      const int kk = m >> 5, mm = m & 31, j = 4 * (mm >> 4) + (mm & 3), jq = (mm & 15) >> 2;
#pragma unroll
      for (int i = 0; i < 4; i++) {
        const int d = d0 + i, dt = d >> 4, r = d & 15;
        vimg[(size_t)(b * 4 + head) * 32768 + ((dt * 8 + kk) * 64 + jq * 16 + r) * 8 + j] = f2bf(v[i]);
      }
    }
  }
};
struct EpiA1 {
  bf16_t *U, *VT, *QX;
  DI void operator()(int row, int col, f32x4 v) const {
    const int cb = __builtin_amdgcn_readfirstlane(col & ~127);
    if (cb < 1024) {
      *(u32x2*)(U + (size_t)row * 1024 + col) = (u32x2){pk2(geluf_(v[0]), geluf_(v[1])), pk2(geluf_(v[2]), geluf_(v[3]))};
    } else if (cb < 2048) {
      const int c = col - 1024, chunk = row >> 7, s = row & 127;
#pragma unroll
      for (int i = 0; i < 4; i++) VT[(((size_t)chunk * 1024 + c + i) << 7) + s] = f2bf(geluf_(v[i]));
    } else {
      *(u32x2*)(QX + (size_t)row * 512 + (col - 2048)) = (u32x2){pk2(v[0], v[1]), pk2(v[2], v[3])};
    }
  }
};
struct EpiPlain {
  bf16_t* R; int ld;
  DI void operator()(int row, int col, f32x4 v) const { *(u32x2*)(R + (size_t)row * ld + col) = (u32x2){pk2(v[0], v[1]), pk2(v[2], v[3])}; }
};
struct EpiC1 {
  bf16_t* R; float* ab; int hfoff;
  DI void operator()(int row, int col, f32x4 v) const {
    const int cb = __builtin_amdgcn_readfirstlane(col & ~127);
    if (cb < 3584) *(u32x2*)(R + (size_t)row * 3584 + col) = (u32x2){pk2(v[0], v[1]), pk2(v[2], v[3])};
    else if (cb == 3584 && col < 3600) *(f32x4*)(ab + (size_t)(((row >> 12) << 13) + hfoff + (row & 4095)) * 16 + (col - 3584)) = v;
  }
};
struct EpiGate {
  bf16_t* Y; const float* ssq; const float* onw; int isC, col0, hfoff;
  DI void operator()(int row, int col, f32x4 v) const {
    const int tok = hfoff < 0 ? row : ((row >> 12) << 13) + hfoff + (row & 4095);
    const int yc = col + col0;
    u32x2* p = (u32x2*)(Y + (size_t)tok * 1536 + yc);
    const u32x2 m = *p;
    float a0 = lo2f(m[0]), a1 = hi2f(m[0]), a2 = lo2f(m[1]), a3 = hi2f(m[1]);
    if (isC && __builtin_amdgcn_readfirstlane(yc & ~127) < 1024) {
      const float r = rsqrtf(ssq[(size_t)tok * 8 + (yc >> 7)] * (1.f / 128.f) + EPS);
      const f32x4 w = *(const f32x4*)(onw + (yc & 127));
      a0 *= r * w[0]; a1 *= r * w[1]; a2 *= r * w[2]; a3 *= r * w[3];
    }
    *p = (u32x2){pk2(a0 * siluf_(v[0]), a1 * siluf_(v[1])), pk2(a2 * siluf_(v[2]), a3 * siluf_(v[3]))};
  }
};
struct EpiOut {
  bf16_t* O;
  DI void operator()(int row, int col, f32x4 v) const { *(u32x2*)(O + (size_t)row * 1024 + col) = (u32x2){pk2(v[0], v[1]), pk2(v[2], v[3])}; }
};

DI void conv_seg(const float* __restrict__ src, int ld, int col0, int ncols, bf16_t* __restrict__ dst, int K, char* smem) {
  const int bx_ = obid(), G_ = ogrid(); (void)bx_; (void)G_;
  src = lp(src);
  dst = lp(dst);
  smem += zoff();
  float* tile = (float*)smem;
  const int tid = otid();
  const int ntj = (ncols + 63) >> 6, ntk = K >> 6;
  for (int t = bx_; t < ntj * ntk; t += G_) {
    const int tj = t % ntj, tk = t / ntj;
    {
      const int jj = tid & 63, k0 = tid >> 6;
      const bool ok = (tj * 64 + jj) < ncols;
#pragma unroll
      for (int i = 0; i < 8; i++) {
        const int kk = k0 + 8 * i;
        tile[kk * 65 + jj] = ok ? src[(size_t)(tk * 64 + kk) * ld + col0 + tj * 64 + jj] : 0.f;
      }
    }
    __syncthreads();
    {
      const int kk2 = (tid & 31) * 2, j2 = tid >> 5;
#pragma unroll
      for (int i = 0; i < 4; i++) {
        const int jj = j2 + 16 * i;
        if (tj * 64 + jj < ncols) *(unsigned*)(dst + (size_t)(tj * 64 + jj) * K + tk * 64 + kk2) = pk2(tile[kk2 * 65 + jj], tile[(kk2 + 1) * 65 + jj]);
      }
    }
    __syncthreads();
  }
}

DI void rmsnorm_rows(const float* __restrict__ x, const float* __restrict__ w, bf16_t* __restrict__ h, int nrows) {
  const int bx_ = obid(), G_ = ogrid(); (void)bx_; (void)G_;
  x = lp(x);
  w = lp(w);
  h = lp(h);
  const int lane = otid() & 63, wid = otid() >> 6;
  f32x4 wv[4];
#pragma unroll
  for (int i = 0; i < 4; i++) wv[i] = *(const f32x4*)(w + i * 256 + lane * 4);
  for (int row = bx_ * 8 + wid; row < nrows; row += G_ * 8) {
    f32x4 v[4]; float ss = 0.f;
#pragma unroll
    for (int i = 0; i < 4; i++) { v[i] = *(const f32x4*)(x + (size_t)row * 1024 + i * 256 + lane * 4); ss += v[i][0] * v[i][0] + v[i][1] * v[i][1] + v[i][2] * v[i][2] + v[i][3] * v[i][3]; }
    ss = wsum(ss);
    const float r = rsqrtf(ss * (1.f / 1024.f) + EPS);
#pragma unroll
    for (int i = 0; i < 4; i++)
      *(u32x2*)(h + (size_t)row * 1024 + i * 256 + lane * 4) = (u32x2){pk2(v[i][0] * r * wv[i][0], v[i][1] * r * wv[i][1]), pk2(v[i][2] * r * wv[i][2], v[i][3] * r * wv[i][3])};
  }
}

DI void norm_phase(const bf16_t* __restrict__ O, const float* xin, const bf16_t* xinb, float* xout, bf16_t* xoutb, const float* __restrict__ wpost,
                   const float* __restrict__ wpre, bf16_t* __restrict__ h) {
  const int bx_ = obid(), G_ = ogrid();
  const int lane = otid() & 63, wid = otid() >> 6;
  f32x4 wp[4], wq[4];
#pragma unroll
  for (int i = 0; i < 4; i++) { wp[i] = *(const f32x4*)(wpost + i * 256 + lane * 4); wq[i] = wpre ? *(const f32x4*)(wpre + i * 256 + lane * 4) : (f32x4){0.f, 0.f, 0.f, 0.f}; }
  for (int row = bx_ * 8 + wid; row < NTOK; row += G_ * 8) {
    f32x4 o[4], xv[4]; float ss = 0.f;
#pragma unroll
    for (int i = 0; i < 4; i++) {
      const size_t off = (size_t)row * 1024 + i * 256 + lane * 4;
      { const u32x2 ob = *(const u32x2*)(O + off); o[i] = (f32x4){lo2f(ob[0]), hi2f(ob[0]), lo2f(ob[1]), hi2f(ob[1])}; }
      if (xin) xv[i] = *(const f32x4*)(xin + off);
      else { const u32x2 xb = *(const u32x2*)(xinb + off); xv[i] = (f32x4){lo2f(xb[0]), hi2f(xb[0]), lo2f(xb[1]), hi2f(xb[1])}; }
      ss += o[i][0] * o[i][0] + o[i][1] * o[i][1] + o[i][2] * o[i][2] + o[i][3] * o[i][3];
    }
    ss = wsum(ss);
    const float r = rsqrtf(ss * (1.f / 1024.f) + EPS);
    float s2 = 0.f;
#pragma unroll
    for (int i = 0; i < 4; i++) {
      const size_t off = (size_t)row * 1024 + i * 256 + lane * 4;
#pragma unroll
      for (int j = 0; j < 4; j++) { xv[i][j] += o[i][j] * r * wp[i][j]; s2 += xv[i][j] * xv[i][j]; }
      if (xout) *(f32x4*)(xout + off) = xv[i];
      else *(u32x2*)(xoutb + off) = (u32x2){pk2(xv[i][0], xv[i][1]), pk2(xv[i][2], xv[i][3])};
    }
    if (wpre) {
      s2 = wsum(s2);
      const float r2 = rsqrtf(s2 * (1.f / 1024.f) + EPS);
#pragma unroll
      for (int i = 0; i < 4; i++)
        *(u32x2*)(h + (size_t)row * 1024 + i * 256 + lane * 4) = (u32x2){pk2(xv[i][0] * r2 * wq[i][0], xv[i][1] * r2 * wq[i][1]), pk2(xv[i][2] * r2 * wq[i][2], xv[i][3] * r2 * wq[i][3])};
    }
  }
}

DI void attn_phase(const bf16_t* __restrict__ Q, int ldq, int hfoff  , int nrows, const bf16_t* __restrict__ Kimg, const bf16_t* __restrict__ Vimg,
                   bf16_t* __restrict__ mix, int bid, int nb, char* smem) {
  const int bx_ = obid(), G_ = ogrid(); (void)bx_; (void)G_;
  Q = lp(Q);
  Kimg = lp(Kimg);
  Vimg = lp(Vimg);
  mix = lp(mix);
  smem += zoff();
  const int tid = otid(), lane = tid & 63, wid = tid >> 6, fr = lane & 15, fq = lane >> 4;
  const int items = (nrows >> 9) * 4;
  for (int it = bid; it < items; it += nb) {
    const int head = it & 3, span = it >> 2, lrow0 = span * 512;
    const int tokb = hfoff < 0 ? lrow0 : ((lrow0 >> 12) << 13) + hfoff + (lrow0 & 4095);
    const int b = tokb >> 13;
    const u32x4* ksrc = (const u32x4*)(Kimg + (size_t)(b * 4 + head) * 32768);
    const u32x4* vsrc = (const u32x4*)(Vimg + (size_t)(b * 4 + head) * 32768);
#pragma unroll
    for (int i = 0; i < 8; i++) ((u32x4*)smem)[tid + 512 * i] = ksrc[tid + 512 * i];
#pragma unroll
    for (int i = 0; i < 8; i++) ((u32x4*)(smem + 65536))[tid + 512 * i] = vsrc[tid + 512 * i];
    __syncthreads();
    for (int qi = 0; qi < 4; qi++) {
      const int lr = lrow0 + qi * 128 + wid * 16;
      bf16x8 qf[4];
#pragma unroll
      for (int ks = 0; ks < 4; ks++) qf[ks] = *(const bf16x8*)(Q + (size_t)(lr + fr) * ldq + head * 128 + ks * 32 + fq * 8);
      f32x4 st[16];
#pragma unroll
      for (int mt = 0; mt < 16; mt++) {
        f32x4 a = (f32x4){0.f, 0.f, 0.f, 0.f};
#pragma unroll
        for (int ks = 0; ks < 4; ks++) a = mfma16(*(const bf16x8*)(smem + ((mt * 4 + ks) * 64 + lane) * 16), qf[ks], a);
        st[mt] = a;
        if (mt & 1) __builtin_amdgcn_sched_barrier(0);
      }
      float mx = -3.0e38f;
#pragma unroll
      for (int mt = 0; mt < 16; mt++)
#pragma unroll
        for (int i = 0; i < 4; i++) mx = fmaxf(mx, st[mt][i]);
      mx = fmaxf(mx, __shfl_xor(mx, 16)); mx = fmaxf(mx, __shfl_xor(mx, 32));
      const float sc = 0.08838834764831845f * 1.4426950408889634f;
      float sum = 0.f;
#pragma unroll
      for (int mt = 0; mt < 16; mt++)
#pragma unroll
        for (int i = 0; i < 4; i++) { const float pz = __builtin_amdgcn_exp2f((st[mt][i] - mx) * sc); st[mt][i] = pz; sum += pz; }
      sum += __shfl_xor(sum, 16); sum += __shfl_xor(sum, 32);
      bf16x8 pf[8];
#pragma unroll
      for (int kk = 0; kk < 8; kk++) pf[kk] = pack8(st[2 * kk], st[2 * kk + 1]);
      const float inv = 1.f / sum;
      bf16_t* op = mix + (size_t)(tokb + (lr - lrow0) + fr) * 1536 + 1024 + head * 128 + fq * 4;
#pragma unroll
      for (int dt = 0; dt < 8; dt++) {
        f32x4 o = (f32x4){0.f, 0.f, 0.f, 0.f};
#pragma unroll
        for (int kk = 0; kk < 8; kk++) o = mfma16(*(const bf16x8*)(smem + 65536 + ((dt * 8 + kk) * 64 + lane) * 16), pf[kk], o);
        *(u32x2*)(op + dt * 16) = (u32x2){pk2(o[0] * inv, o[1] * inv), pk2(o[2] * inv, o[3] * inv)};
        __builtin_amdgcn_sched_barrier(0);
      }
    }
    __syncthreads();
  }
}

DI void gmlp_phase(const bf16_t* __restrict__ U, const bf16_t* __restrict__ VT, const bf16_t* __restrict__ Wsb, const float* __restrict__ ln_w,
                   const float* __restrict__ ln_b, const float* __restrict__ b_s, bf16_t* __restrict__ mix, char* smem) {
  const int bx_ = obid(), G_ = ogrid(); (void)bx_; (void)G_;
  U = lp(U);
  VT = lp(VT);
  Wsb = lp(Wsb);
  ln_w = lp(ln_w);
  ln_b = lp(ln_b);
  b_s = lp(b_s);
  mix = lp(mix);
  smem += zoff();
  float* red = (float*)smem;
  float* stats = (float*)(smem + 32768);
  for (int chunk = bx_; chunk < 256; chunk += G_) {
    const int tid = otid(), lane = tid & 63, wid = tid >> 6, fr = lane & 15, fq = lane >> 4;
    {
      const int s8 = tid & 15, cgp = tid >> 4;
      float sm[8], sq[8];
#pragma unroll
      for (int j = 0; j < 8; j++) { sm[j] = 0.f; sq[j] = 0.f; }
#pragma unroll 8
      for (int cc = 0; cc < 32; cc++) {
        const u32x4 raw = *(const u32x4*)(VT + (((size_t)chunk * 1024 + cgp * 32 + cc) << 7) + s8 * 8);
        float v[8]; unpack8(raw, v);
#pragma unroll
        for (int j = 0; j < 8; j++) { sm[j] += v[j]; sq[j] += v[j] * v[j]; }
      }
#pragma unroll
      for (int j = 0; j < 8; j++) { red[(cgp * 128 + s8 * 8 + j) * 2] = sm[j]; red[(cgp * 128 + s8 * 8 + j) * 2 + 1] = sq[j]; }
    }
    __syncthreads();
    if (tid < 128) {
      float S = 0.f, Q = 0.f;
      for (int g2 = 0; g2 < 32; g2++) { S += red[(g2 * 128 + tid) * 2]; Q += red[(g2 * 128 + tid) * 2 + 1]; }
      const float mean = S * (1.f / 1024.f), var = Q * (1.f / 1024.f) - mean * mean;
      stats[tid * 2] = mean; stats[tid * 2 + 1] = rsqrtf(fmaxf(var, 0.f) + EPS);
    }
    __syncthreads();
    const int g = wid;
    float lwv[8], lbv[8];
#pragma unroll
    for (int ct = 0; ct < 8; ct++) { lwv[ct] = ln_w[g * 128 + 16 * ct + fr]; lbv[ct] = ln_b[g * 128 + 16 * ct + fr]; }
#pragma unroll
    for (int tq = 0; tq < 4; tq++) {
      f32x4 acc[8][2];
#pragma unroll
      for (int ct = 0; ct < 8; ct++)
#pragma unroll
        for (int tt = 0; tt < 2; tt++) acc[ct][tt] = (f32x4){0.f, 0.f, 0.f, 0.f};
#pragma unroll
      for (int ks = 0; ks < 4; ks++) {
        if (ks <= tq) {
          float mean8[8], rstd8[8];
#pragma unroll
          for (int j = 0; j < 8; j++) { mean8[j] = stats[(32 * ks + 8 * fq + j) * 2]; rstd8[j] = stats[(32 * ks + 8 * fq + j) * 2 + 1]; }
          bf16x8 bfr[2];
#pragma unroll
          for (int tt = 0; tt < 2; tt++) bfr[tt] = *(const bf16x8*)(Wsb + ((size_t)g * 128 + 32 * tq + 16 * tt + fr) * 128 + 32 * ks + 8 * fq);
          u32x4 rawv[8];
#pragma unroll
          for (int ct = 0; ct < 8; ct++) rawv[ct] = *(const u32x4*)(VT + (((size_t)chunk * 1024 + g * 128 + 16 * ct + fr) << 7) + 32 * ks + 8 * fq);
#pragma unroll
          for (int ct = 0; ct < 8; ct++) {
            const float lw = lwv[ct], lb = lbv[ct];
            float v[8]; unpack8(rawv[ct], v);
#pragma unroll
            for (int j = 0; j < 8; j++) v[j] = (v[j] - mean8[j]) * rstd8[j] * lw + lb;
            u32x4 pa; pa[0] = pk2(v[0], v[1]); pa[1] = pk2(v[2], v[3]); pa[2] = pk2(v[4], v[5]); pa[3] = pk2(v[6], v[7]);
            const bf16x8 af = __builtin_bit_cast(bf16x8, pa);
#pragma unroll
            for (int tt = 0; tt < 2; tt++) acc[ct][tt] = mfma16(af, bfr[tt], acc[ct][tt]);
            if (ct & 1) __builtin_amdgcn_sched_barrier(0);
          }
        }
      }
#pragma unroll
      for (int tt = 0; tt < 2; tt++) {
        const int t = 32 * tq + 16 * tt + fr;
        const size_t tok = (size_t)chunk * 128 + t;
        const float bs = b_s[g * 128 + t];
        u32x2 uuv[8];
#pragma unroll
        for (int ct = 0; ct < 8; ct++) uuv[ct] = *(const u32x2*)(U + tok * 1024 + g * 128 + 16 * ct + 4 * fq);
#pragma unroll
        for (int ct = 0; ct < 8; ct++) {
          const int col = g * 128 + 16 * ct + 4 * fq;
          const u32x2 uu = uuv[ct];
          const f32x4 a = acc[ct][tt];
          *(u32x2*)(mix + tok * 1536 + col) = (u32x2){pk2(lo2f(uu[0]) * (a[0] + bs), hi2f(uu[0]) * (a[1] + bs)), pk2(lo2f(uu[1]) * (a[2] + bs), hi2f(uu[1]) * (a[3] + bs))};
        }
      }
      __builtin_amdgcn_sched_barrier(0);
    }
    __syncthreads();
  }
}

DI void sconv_phase(const bf16_t* __restrict__ R, const float* __restrict__ cw, bf16_t* __restrict__ mix) {
  const int bx_ = obid(), G_ = ogrid(); (void)bx_; (void)G_;
  R = lp(R);
  cw = lp(cw);
  mix = lp(mix);
  for (int idx = bx_ * 512 + otid(); idx < NTOK * 128; idx += G_ * 512) {
    const int row = idx >> 7, c = (idx & 127) * 8, s = row & 8191;
    float acc[8];
#pragma unroll
    for (int j = 0; j < 8; j++) acc[j] = 0.f;
#pragma unroll
    for (int k = 0; k < 3; k++) {
      if (s - 2 + k >= 0) {
        const size_t r2 = (size_t)(row - 2 + k);
        float a[8], b[8]; unpack8(*(const u32x4*)(R + r2 * 3584 + 1024 + c), a); unpack8(*(const u32x4*)(R + r2 * 3584 + 2048 + c), b);
        const f32x4 w0 = *(const f32x4*)(cw + k * 1024 + c), w1 = *(const f32x4*)(cw + k * 1024 + c + 4);
#pragma unroll
        for (int j = 0; j < 4; j++) { acc[j] += w0[j] * a[j] * b[j]; acc[4 + j] += w1[j] * a[4 + j] * b[4 + j]; }
      }
    }
    float g[8]; unpack8(*(const u32x4*)(R + (size_t)row * 3584 + c), g);
    u32x4 o;
#pragma unroll
    for (int j = 0; j < 4; j++) o[j] = pk2(g[2 * j] * acc[2 * j], g[2 * j + 1] * acc[2 * j + 1]);
    *(u32x4*)(mix + (size_t)row * 1536 + c) = o;
  }
}

constexpr int P_SET = 1024 + 3 * 17408;
constexpr int P_AF = 0, P_SET0 = 16384, P_WB = P_SET0 + 2 * P_SET, P_QK = P_WB + 17408, P_END = P_QK + 9216;
constexpr int XST_OFF = P_END;
static_assert(XST_OFF + 64 <= LDS_BYTES, "prep lds");

DI void prep_conv(const bf16_t* __restrict__ R, const float* __restrict__ ab, const float* __restrict__ cw, const float* __restrict__ a_log,
                  const float* __restrict__ dt_bias, float* __restrict__ glbuf, bf16_t* __restrict__ stash, int half, int ci, char* sb, int t0, int nth) {
  float* gc = (float*)sb; float* be = gc + 64; float* eg = gc + 128; float* ek = gc + 192;
  bf16_t* Kb = (bf16_t*)(sb + 1024); bf16_t* Qb = Kb + 64 * 136; bf16_t* Vb = Qb + 64 * 136;
  const int bl = ci >> 9, hh = (ci >> 6) & 7, n = ci & 63;
  const int tokg = bl * 8192 + half * 4096 + n * 64;
  if (t0 < 64) {
    const int lane = t0;
    const float a = ab[(size_t)(tokg + lane) * 16 + hh], bb = ab[(size_t)(tokg + lane) * 16 + 8 + hh];
    const float xs = a + dt_bias[hh];
    const float sp = xs > 20.f ? xs : log1pf(__expf(xs));
    float g = -__expf(a_log[hh]) * sp;
#pragma unroll
    for (int o = 1; o < 64; o <<= 1) { const float t = __shfl_up(g, o); if (lane >= o) g += t; }
    const float gl = __shfl(g, 63);
    gc[lane] = g; be[lane] = sigmoidf_(bb); eg[lane] = __expf(g); ek[lane] = __expf(gl - g);
    if (lane == 63) glbuf[ci] = __expf(gl);
  }
  for (int idx = t0; idx < 512; idx += nth) {
    const int t = idx >> 3, sub = idx & 7;
#pragma unroll
    for (int sec = 0; sec < 3; sec++) {
      const int col0 = sec * 1024 + hh * 128 + sub * 16;
      float acc[16];
#pragma unroll
      for (int j = 0; j < 16; j++) acc[j] = 0.f;
#pragma unroll
      for (int kk = 0; kk < 4; kk++) {
        const int sl = n * 64 + t - 3 + kk;
        if (sl >= 0 || half == 1) {
          const bf16_t* src = sl >= 0 ? R + (size_t)(bl * 4096 + sl) * 3584 + col0
                                      : stash + (size_t)((bl * 8 + hh) * 3 + (sl + 3)) * 384 + sec * 128 + sub * 16;
          float xv[16]; unpack8(*(const u32x4*)src, xv); unpack8(*(const u32x4*)(src + 8), xv + 8);
#pragma unroll
          for (int q4 = 0; q4 < 4; q4++) {
            const f32x4 w = *(const f32x4*)(cw + (size_t)kk * 3072 + col0 + q4 * 4);
#pragma unroll
            for (int j = 0; j < 4; j++) acc[q4 * 4 + j] += w[j] * xv[q4 * 4 + j];
          }
        }
      }
      float ss = 0.f;
#pragma unroll
      for (int j = 0; j < 16; j++) { acc[j] = siluf_(acc[j]); ss += acc[j] * acc[j]; }
      float scale = 1.f;
      if (sec < 2) {
        ss += __shfl_xor(ss, 1); ss += __shfl_xor(ss, 2); ss += __shfl_xor(ss, 4);
        scale = rsqrtf(ss + EPS) * (sec == 0 ? 0.08838834764831845f : 1.f);
      }
      bf16_t* dst = (sec == 0 ? Qb : (sec == 1 ? Kb : Vb)) + t * 136 + sub * 16;
      u32x4 p0, p1;
#pragma unroll
      for (int j = 0; j < 4; j++) { p0[j] = pk2(acc[2 * j] * scale, acc[2 * j + 1] * scale); p1[j] = pk2(acc[8 + 2 * j] * scale, acc[9 + 2 * j] * scale); }
      *(u32x4*)dst = p0; *(u32x4*)(dst + 8) = p1;
      __builtin_amdgcn_sched_barrier(0);
    }
  }
  if (half == 0 && n == 63 && t0 < 144) {
    const int r = t0 / 48, piece = t0 % 48, sec = piece >> 4, c16 = piece & 15;
    *(u32x4*)(stash + (size_t)((bl * 8 + hh) * 3 + r) * 384 + sec * 128 + c16 * 8) =
        *(const u32x4*)(R + (size_t)(bl * 4096 + 4093 + r) * 3584 + sec * 1024 + hh * 128 + c16 * 8);
  }
}

#define LDS_BAR() do { asm volatile("s_waitcnt lgkmcnt(0)" ::: "memory"); __builtin_amdgcn_s_barrier(); asm volatile("" ::: "memory"); } while (0)

DI void prep_phase(const bf16_t* __restrict__ R, const float* __restrict__ ab, const float* __restrict__ cw, const float* __restrict__ a_log,
                   const float* __restrict__ dt_bias, char* __restrict__ ops, float* __restrict__ glbuf, bf16_t* __restrict__ stash, int half, char* smem) {
  const int bx_ = obid(), G_ = ogrid(); (void)bx_; (void)G_;
  R = lp(R);
  ab = lp(ab);
  cw = lp(cw);
  a_log = lp(a_log);
  dt_bias = lp(dt_bias);
  ops = lp(ops);
  glbuf = lp(glbuf);
  stash = lp(stash);
  smem += zoff();
  float* Af = (float*)(smem + P_AF); bf16_t* Wb = (bf16_t*)(smem + P_WB); bf16_t* QKb = (bf16_t*)(smem + P_QK);
  int k = -1;
  for (int ci = bx_ - G_; ci < 2048; ci += G_, k++) {
    const bool live = ci >= 0;
    const int tid = otid(), lane = tid & 63, wid = tid >> 6, fr = lane & 15, fq = lane >> 4;
    char* sb = smem + P_SET0 + (k & 1) * P_SET;
    const float* gc = (const float*)sb; const float* be = gc + 64; const float* eg = gc + 128; const float* ek = gc + 192;
    const bf16_t* Kb = (const bf16_t*)(sb + 1024); const bf16_t* Qb = Kb + 64 * 136; const bf16_t* Vb = Qb + 64 * 136;
    char* op = ops + (size_t)ci * OPS_STRIDE;
    if (live) {
      const int it = wid & 3, which = wid >> 2;
      const bf16_t* X = which ? Qb : Kb;
      bf16x8 af[4];
#pragma unroll
      for (int ks = 0; ks < 4; ks++) af[ks] = *(const bf16x8*)(X + (16 * it + fr) * 136 + 32 * ks + 8 * fq);
#pragma unroll
      for (int jt = 0; jt < 4; jt++) {
        f32x4 a = (f32x4){0.f, 0.f, 0.f, 0.f};
#pragma unroll
        for (int ks = 0; ks < 4; ks++) a = mfma16(af[ks], *(const bf16x8*)(Kb + (16 * jt + fr) * 136 + 32 * ks + 8 * fq), a);
        const int j = 16 * jt + fr;
        const float gj = gc[j];
#pragma unroll
        for (int ii = 0; ii < 4; ii++) {
          const int i = 16 * it + 4 * fq + ii;
          const float dec = __expf(fminf(gc[i] - gj, 0.f));
          if (which == 0) Af[i * 64 + j] = (j < i) ? be[i] * a[ii] * dec : 0.f;
          else QKb[i * 72 + j] = f2bf((j <= i) ? a[ii] * dec : 0.f);
        }
      }
    }
    LDS_BAR();
    if (tid < 256) {
      if (live) {
      const int col = tid;
      float Uv[64];
      const bool isv = col < 128;
      const bf16_t* xs = isv ? (Vb + col) : (Kb + (col - 128));
#pragma unroll
      for (int i = 0; i < 64; i++) { Uv[i] = bf2f(xs[i * 136]) * (be[i] * (isv ? 1.f : eg[i])); asm volatile("" : "+v"(Uv[i])); }
      __builtin_amdgcn_sched_barrier(0);
#pragma unroll
      for (int i = 1; i < 64; i++) {
        float xv = Uv[i], xw = 0.f, xy = 0.f, xz = 0.f;
#pragma unroll
        for (int j4 = 0; j4 < (i + 3) / 4; j4++) {
          const f32x4 a = *(const f32x4*)(Af + i * 64 + j4 * 4);
          if (j4 * 4 + 0 < i) xv -= a[0] * Uv[j4 * 4 + 0];
          if (j4 * 4 + 1 < i) xw -= a[1] * Uv[j4 * 4 + 1];
          if (j4 * 4 + 2 < i) xy -= a[2] * Uv[j4 * 4 + 2];
          if (j4 * 4 + 3 < i) xz -= a[3] * Uv[j4 * 4 + 3];
        }
        Uv[i] = (xv + xw) + (xy + xz);
        __builtin_amdgcn_sched_barrier(0);
      }
      if (col < 128) {
        const int w8 = col >> 4, lo = col & 15;
#pragma unroll
        for (int ct = 0; ct < 4; ct++)
#pragma unroll
          for (int jq = 0; jq < 4; jq++)
            *(u32x2*)(op + 57344 + (((w8 * 4 + ct) * 64 + jq * 16 + lo) * 8)) = (u32x2){pk2(Uv[16 * ct + 4 * jq], Uv[16 * ct + 4 * jq + 1]), pk2(Uv[16 * ct + 4 * jq + 2], Uv[16 * ct + 4 * jq + 3])};
      } else {
#pragma unroll
        for (int i = 0; i < 64; i++) Wb[i * 136 + col - 128] = f2bf(Uv[i]);
      }
      }
    } else {
      const int t2 = tid - 256;
      if (live) {
#pragma unroll
      for (int i = 0; i < 4; i++) {
        const int idx = t2 + 256 * i, frag = idx >> 6, ln = idx & 63, ct = frag >> 2, m = frag & 3, r = ln & 15, jq = ln >> 4;
        const int c = 16 * ct + r, d0 = 32 * m + 4 * jq;
        const u32x2 lo = *(const u32x2*)(Qb + c * 136 + d0), hi = *(const u32x2*)(Qb + c * 136 + d0 + 16);
        const float e = eg[c];
        *(u32x4*)(op + 16384 + idx * 16) = (u32x4){pk2(lo2f(lo[0]) * e, hi2f(lo[0]) * e), pk2(lo2f(lo[1]) * e, hi2f(lo[1]) * e), pk2(lo2f(hi[0]) * e, hi2f(hi[0]) * e), pk2(lo2f(hi[1]) * e, hi2f(hi[1]) * e)};
      }
#pragma unroll
      for (int i = 0; i < 4; i++) {
        const int idx = t2 + 256 * i, frag = idx >> 6, ln = idx & 63, dt = frag >> 1, kk = frag & 1, r = ln & 15, jq = ln >> 4;
        const int d = 16 * dt + r;
        float v[8];
#pragma unroll
        for (int j = 0; j < 8; j++) { const int c = 32 * kk + 16 * (j >> 2) + 4 * jq + (j & 3); v[j] = bf2f(Kb[c * 136 + d]) * ek[c]; }
        *(u32x4*)(op + 40960 + idx * 16) = (u32x4){pk2(v[0], v[1]), pk2(v[2], v[3]), pk2(v[4], v[5]), pk2(v[6], v[7])};
      }
#pragma unroll
      for (int i = 0; i < 2; i++) {
        const int idx = t2 + 256 * i, frag = idx >> 6, ln = idx & 63, ct = frag >> 1, kk = frag & 1, r = ln & 15, jq = ln >> 4;
        const int row = 16 * ct + r, c0 = 32 * kk + 4 * jq;
        const u32x2 lo = *(const u32x2*)(QKb + row * 72 + c0), hi = *(const u32x2*)(QKb + row * 72 + c0 + 16);
        *(u32x4*)(op + 32768 + idx * 16) = (u32x4){lo[0], lo[1], hi[0], hi[1]};
      }
      }
      if (ci + G_ < 2048) prep_conv(R, ab, cw, a_log, dt_bias, glbuf, stash, half, ci + G_, smem + P_SET0 + ((k + 1) & 1) * P_SET, t2, 256);
    }
    LDS_BAR();
    if (live)
#pragma unroll
    for (int i = 0; i < 2; i++) {
      const int idx = tid + 512 * i, frag = idx >> 6, ln = idx & 63, ct = frag >> 2, m = frag & 3, r = ln & 15, jq = ln >> 4;
      const int c = 16 * ct + r, d0 = 32 * m + 4 * jq;
      const u32x2 lo = *(const u32x2*)(Wb + c * 136 + d0), hi = *(const u32x2*)(Wb + c * 136 + d0 + 16);
      *(u32x4*)(op + idx * 16) = (u32x4){lo[0], lo[1], hi[0], hi[1]};
    }
  }
  LDS_BAR();
}

DI void scan_block(const char* __restrict__ ops, const float* __restrict__ glbuf, bf16_t* __restrict__ mix, float* __restrict__ ssq,
                   f32x4* __restrict__ stbuf, int half, char* smem) {
  const int bx_ = obid(), G_ = ogrid(); (void)bx_; (void)G_;
  ops = lp(ops);
  glbuf = lp(glbuf);
  mix = lp(mix);
  ssq = lp(ssq);
  stbuf = lp(stbuf);
  smem += zoff();
  const int tid = otid(), lane = tid & 63, w = tid >> 6, fr = lane & 15, fq = lane >> 4;
  const bool comp = w < 4;
  const int blk = bx_, bl = blk >> 3, hh = blk & 7;
  const int chunk0 = (bl * 8 + hh) * 64;
  const int tokbase = bl * 8192 + half * 4096;
  const char* cp = ops + (size_t)chunk0 * OPS_STRIDE;
  float* part = (float*)(smem + 114688);
#pragma unroll
  for (int i = 0; i < 7; i++) ((u32x4*)smem)[tid + 512 * i] = ((const u32x4*)cp)[tid + 512 * i];
  __syncthreads();
  if (!comp) {
    const int t2 = tid - 256;
    u32x4 sx[14], sy[14];
    {
      const u32x4* np = (const u32x4*)(cp + (size_t)1 * OPS_STRIDE);
#pragma unroll
      for (int i = 0; i < 14; i++) sy[i] = np[t2 + 256 * i];
    }
    for (int n = 0; n < 64; n += 2) {
      if (n + 2 < 64) {
        const u32x4* np = (const u32x4*)(cp + (size_t)(n + 2) * OPS_STRIDE);
#pragma unroll
        for (int i = 0; i < 14; i++) sx[i] = np[t2 + 256 * i];
      }
      {
        u32x4* nb = (u32x4*)(smem + 57344);
#pragma unroll
        for (int i = 0; i < 14; i++) nb[t2 + 256 * i] = sy[i];
      }
      asm volatile("s_waitcnt lgkmcnt(0)" ::: "memory");
      __builtin_amdgcn_s_barrier();
      asm volatile("" ::: "memory");
      if (n + 3 < 64) {
        const u32x4* np = (const u32x4*)(cp + (size_t)(n + 3) * OPS_STRIDE);
#pragma unroll
        for (int i = 0; i < 14; i++) sy[i] = np[t2 + 256 * i];
      }
      if (n + 2 < 64) {
        u32x4* nb = (u32x4*)smem;
#pragma unroll
        for (int i = 0; i < 14; i++) nb[t2 + 256 * i] = sx[i];
      }
      asm volatile("s_waitcnt lgkmcnt(0)" ::: "memory");
      __builtin_amdgcn_s_barrier();
      asm volatile("" ::: "memory");
    }
  } else {
    f32x4* stp = stbuf + ((size_t)(blk * 4 + w) * 16) * 64 + lane;
    f32x4 S[8][2]; bf16x8 sB[4][2];
#pragma unroll
    for (int i = 0; i < 8; i++)
#pragma unroll
      for (int nt = 0; nt < 2; nt++) S[i][nt] = half ? stp[(i * 2 + nt) * 64] : (f32x4){0.f, 0.f, 0.f, 0.f};
#pragma unroll
    for (int m = 0; m < 4; m++)
#pragma unroll
      for (int nt = 0; nt < 2; nt++) sB[m][nt] = pack8(S[2 * m][nt], S[2 * m + 1][nt]);
    u32x2 uf[4][2];
#pragma unroll
    for (int ct = 0; ct < 4; ct++)
#pragma unroll
      for (int nt = 0; nt < 2; nt++) uf[ct][nt] = *(const u32x2*)(cp + 57344 + (((2 * w + nt) * 4 + ct) * 64 + lane) * 8);
    float gl = glbuf[chunk0];
    for (int n = 0; n < 64; n++) {
      const char* buf = smem + (n & 1) * 57344;
      if (n > 0 && lane < 16) {
        const float* pp = part + ((n - 1) & 1) * 256 + 16 * w + lane;
        ssq[(size_t)(tokbase + (n - 1) * 64 + 16 * w + lane) * 8 + hh] = pp[0] + pp[64] + pp[128] + pp[192];
      }
      bf16x8 vB[2][2];
      {
        f32x4 vn[4][2];
#pragma unroll
        for (int ct = 0; ct < 4; ct++) {
          f32x4 t0 = (f32x4){0.f, 0.f, 0.f, 0.f}, t1 = t0;
#pragma unroll
          for (int m = 0; m < 4; m++) {
            const bf16x8 a = *(const bf16x8*)(buf + ((ct * 4 + m) * 64 + lane) * 16);
            t0 = mfma16(a, sB[m][0], t0); t1 = mfma16(a, sB[m][1], t1);
          }
          vn[ct][0] = (f32x4){lo2f(uf[ct][0][0]) - t0[0], hi2f(uf[ct][0][0]) - t0[1], lo2f(uf[ct][0][1]) - t0[2], hi2f(uf[ct][0][1]) - t0[3]};
          vn[ct][1] = (f32x4){lo2f(uf[ct][1][0]) - t1[0], hi2f(uf[ct][1][0]) - t1[1], lo2f(uf[ct][1][1]) - t1[2], hi2f(uf[ct][1][1]) - t1[3]};
        }
#pragma unroll
        for (int kk = 0; kk < 2; kk++)
#pragma unroll
          for (int nt = 0; nt < 2; nt++) vB[kk][nt] = pack8(vn[2 * kk][nt], vn[2 * kk + 1][nt]);
      }
      const float glc = gl;
      if (n + 1 < 64) {
        const char* np = cp + (size_t)(n + 1) * OPS_STRIDE;
#pragma unroll
        for (int ct = 0; ct < 4; ct++)
#pragma unroll
          for (int nt = 0; nt < 2; nt++) uf[ct][nt] = *(const u32x2*)(np + 57344 + (((2 * w + nt) * 4 + ct) * 64 + lane) * 8);
        gl = glbuf[chunk0 + n + 1];
      }
      __builtin_amdgcn_sched_barrier(0);
      float v[16];
      {
        bf16_t* mp = mix + (size_t)(tokbase + n * 64) * 1536 + hh * 128 + 32 * w + fr;
#pragma unroll
        for (int ct = 0; ct < 4; ct++) {
          f32x4 t0 = (f32x4){0.f, 0.f, 0.f, 0.f}, t1 = t0;
#pragma unroll
          for (int m = 0; m < 4; m++) {
            const bf16x8 a = *(const bf16x8*)(buf + 16384 + ((ct * 4 + m) * 64 + lane) * 16);
            t0 = mfma16(a, sB[m][0], t0); t1 = mfma16(a, sB[m][1], t1);
          }
#pragma unroll
          for (int kk = 0; kk < 2; kk++) {
            const bf16x8 a = *(const bf16x8*)(buf + 32768 + ((ct * 2 + kk) * 64 + lane) * 16);
            t0 = mfma16(a, vB[kk][0], t0); t1 = mfma16(a, vB[kk][1], t1);
          }
#pragma unroll
          for (int ii = 0; ii < 4; ii++) {
            const bf16_t b0 = f2bf(t0[ii]), b1 = f2bf(t1[ii]);
            bf16_t* rp = mp + (size_t)(16 * ct + 4 * fq + ii) * 1536;
            rp[0] = b0; rp[16] = b1;
            const float f0 = bf2f(b0), f1 = bf2f(b1);
            v[ct * 4 + ii] = f0 * f0 + f1 * f1;
          }
        }
      }
      __builtin_amdgcn_sched_barrier(0);
#pragma unroll
      for (int dt = 0; dt < 8; dt++) {
        f32x4 t0 = S[dt][0] * glc, t1 = S[dt][1] * glc;
#pragma unroll
        for (int kk = 0; kk < 2; kk++) {
          const bf16x8 a = *(const bf16x8*)(buf + 40960 + ((dt * 2 + kk) * 64 + lane) * 16);
          t0 = mfma16(a, vB[kk][0], t0); t1 = mfma16(a, vB[kk][1], t1);
        }
        S[dt][0] = t0; S[dt][1] = t1;
      }
#pragma unroll
      for (int m = 0; m < 4; m++)
#pragma unroll
        for (int nt = 0; nt < 2; nt++) sB[m][nt] = pack8(S[2 * m][nt], S[2 * m + 1][nt]);
      __builtin_amdgcn_sched_barrier(0);
#pragma unroll
      for (int st = 8; st >= 1; st >>= 1) {
        const bool hiL = (fr & st) != 0;
#pragma unroll
        for (int k = 0; k < st; k++) {
          const float keep = hiL ? v[k + st] : v[k];
          const float send = hiL ? v[k] : v[k + st];
          v[k] = keep + __shfl_xor(send, st);
        }
      }
      part[(n & 1) * 256 + w * 64 + 16 * (fr >> 2) + 4 * fq + (fr & 3)] = v[0];
      asm volatile("s_waitcnt lgkmcnt(0)" ::: "memory");
      __builtin_amdgcn_s_barrier();
      asm volatile("" ::: "memory");
    }
    if (lane < 16) {
      const float* pp = part + (63 & 1) * 256 + 16 * w + lane;
      ssq[(size_t)(tokbase + 63 * 64 + 16 * w + lane) * 8 + hh] = pp[0] + pp[64] + pp[128] + pp[192];
    }
    if (half == 0) {
#pragma unroll
      for (int i = 0; i < 8; i++)
#pragma unroll
        for (int nt = 0; nt < 2; nt++) stp[(i * 2 + nt) * 64] = S[i][nt];
    }
  }
  __syncthreads();
}

#define XB_TMO      128
#define XB_XCNT(j)  (256  + 64 * (j))
#define XB_XSUB(j)  (1280 + 64 * (j))
#define XB_XGEN(j)  (2304 + 64 * (j))
#define XB_TOP      3328
#define XB_TOPGEN   3392
#define XCD_BAR_WORDS 3456
#define XB_SPIN_CAP (1u << 18)

__device__ __forceinline__ unsigned xb_ld(unsigned* p)              { return __hip_atomic_load(p, __ATOMIC_RELAXED, __HIP_MEMORY_SCOPE_AGENT); }
__device__ __forceinline__ unsigned xb_add(unsigned* p, unsigned v) { return __hip_atomic_fetch_add(p, v, __ATOMIC_RELAXED, __HIP_MEMORY_SCOPE_AGENT); }
__device__ __forceinline__ unsigned xb_xcc_id() { return (unsigned)__builtin_amdgcn_s_getreg((3 << 11) | 20) & 0xFu; }
#define XB_SPIN(cond, bar) do { unsigned _sp = 0; while (cond) { __builtin_amdgcn_s_sleep(1); \
    if ((++_sp & 255u) == 0u) { if (xb_ld(&(bar)[XB_TMO])) break; if (_sp > XB_SPIN_CAP) { atomicAdd(&(bar)[XB_TMO], 1u); break; } } } } while (0)

struct XcdBarrier {
    unsigned* bar; unsigned x;
    volatile LAS unsigned* st;
};

__device__ __forceinline__ XcdBarrier xcd_barrier_post(unsigned* bar, volatile LAS unsigned* st) {
    XcdBarrier b; b.bar = bar; b.x = xb_xcc_id(); b.st = st;
    if (threadIdx.x == 0) (void)xb_add(&bar[XB_XCNT(b.x)], 1u);
    return b;
}
__device__ __forceinline__ void xcd_barrier_complete(unsigned* bar, unsigned x, unsigned& nloc, unsigned& nx) {
    const unsigned G = gridDim.x * gridDim.y * gridDim.z;
    unsigned sum, cnt, mine, sp = 0u;
    for (;;) {
        sum = 0u; cnt = 0u; mine = 0u;
#pragma unroll
        for (unsigned j = 0; j < 16; ++j) { const unsigned c = xb_ld(&bar[XB_XCNT(j)]); sum += c; cnt += (c > 0u) ? 1u : 0u; mine = (j == x) ? c : mine; }
        if (sum == G) break;
        __builtin_amdgcn_s_sleep(1);
        if ((++sp & 255u) == 0u) { if (xb_ld(&bar[XB_TMO])) break; if (sp > XB_SPIN_CAP) { atomicAdd(&bar[XB_TMO], 1u); break; } }
    }
    nloc = mine > 0u ? mine : 1u; nx = cnt > 0u ? cnt : 1u;
}

__device__ __forceinline__ void xcd_barrier(const XcdBarrier& b) {
    asm volatile("s_waitcnt vmcnt(0)" ::: "memory");
    __syncthreads();
    if (threadIdx.x == 0) {
        unsigned* bar = b.bar;
        __builtin_amdgcn_s_waitcnt(0);
        unsigned nloc = b.st[0], nx = b.st[1];
        if (nloc == 0u) { xcd_barrier_complete(bar, b.x, nloc, nx); b.st[0] = nloc; b.st[1] = nx; }
        const unsigned old = xb_add(&bar[XB_XSUB(b.x)], 1u);
        const unsigned gen = old / nloc;
        if (old + 1u == (gen + 1u) * nloc) {
            __builtin_amdgcn_fence(__ATOMIC_RELEASE, "agent");
            asm volatile("s_waitcnt vmcnt(0)" ::: "memory");
            const unsigned og = xb_add(&bar[XB_TOP], 1u);
            const unsigned tg = og / nx;
            if (og + 1u == (tg + 1u) * nx) xb_add(&bar[XB_TOPGEN], 1u);
            else XB_SPIN(xb_ld(&bar[XB_TOPGEN]) == tg, bar);
            __builtin_amdgcn_fence(__ATOMIC_ACQUIRE, "agent");
            xb_add(&bar[XB_XGEN(b.x)], 1u);
            asm volatile("s_waitcnt vmcnt(0)" ::: "memory");
        } else {
            XB_SPIN(xb_ld(&bar[XB_XGEN(b.x)]) == gen, bar);
            __builtin_amdgcn_fence(__ATOMIC_ACQUIRE, "agent");
            asm volatile("s_waitcnt vmcnt(0)" ::: "memory");
        }
    }
    __syncthreads();
}

constexpr int PRM_NPRE = 0, PRM_NPOST = 4096, PRM_ALNW = 8192, PRM_ALNB = 10240, PRM_ABS = 12288, PRM_BCW = 14336, PRM_CCW = 17408, PRM_CALOG = 29696, PRM_CDT = 29704, PRM_CONW = 29712;
#define WS_PTRS(ws) \
  const float* PRM = (const float*)(ws + OFF_PRM); \
  bf16_t* W2 = (bf16_t*)(ws + OFF_W2); \
  bf16_t* WO = (bf16_t*)(ws + OFF_WO); \
  bf16_t* WM = (bf16_t*)(ws + OFF_WM); \
  bf16_t* WS = (bf16_t*)(ws + OFF_WS); \
  bf16_t* HMEM = (bf16_t*)(ws + OFF_HMEM); \
  bf16_t* KIMG = (bf16_t*)(ws + OFF_KIMG); \
  bf16_t* VIMG = (bf16_t*)(ws + OFF_VIMG); \
  float* AB = (float*)(ws + OFF_AB); \
  float* SSQ = (float*)(ws + OFF_SSQ); \
  float* GL = (float*)(ws + OFF_GL); \
  f32x4* STB = (f32x4*)(ws + OFF_ST); \
  bf16_t* STASH = (bf16_t*)(ws + OFF_STASH); \
  bf16_t* H = (bf16_t*)(ws + OFF_H); \
  bf16_t* MIX = (bf16_t*)(ws + OFF_MIX); \
  char* BIG = ws + OFF_BIG;
__global__ void __launch_bounds__(512) mega_kernel(Params p) {
  __shared__ __attribute__((aligned(16))) char smem[LDS_BYTES];
  cg::grid_group grid = cg::this_grid();
  char* ws0 = p.ws;
  volatile LAS unsigned* xst = (volatile LAS unsigned*)(LAS unsigned char*)(smem + XST_OFF);
  if (threadIdx.x < 2) xst[threadIdx.x] = 0u;
  __syncthreads();
  const XcdBarrier xb = xcd_barrier_post((unsigned*)(ws0 + OFF_BAR), xst);

  {
  char* ws = lp(ws0);
  WS_PTRS(ws)
  conv_seg(p.a_w_in, 4096, 0, 2560, (bf16_t*)(ws + OFF_W1_0), 1024, smem);
  conv_seg(p.a_w_in, 4096, 2560, 1536, W2, 1024, smem);
  conv_seg(p.a_w_in + 1024 * 4096, 4096, 0, 2560, (bf16_t*)(ws + OFF_W1_3), 1024, smem);
  conv_seg(p.a_w_in + 1024 * 4096, 4096, 2560, 1536, W2 + 3 * 1536 * 1024, 1024, smem);
  conv_seg(p.b_w_in, 5120, 0, 3584, (bf16_t*)(ws + OFF_W1_1), 1024, smem);
  conv_seg(p.b_w_in, 5120, 3584, 1536, W2 + 1 * 1536 * 1024, 1024, smem);
  conv_seg(p.c_w_in, 5136, 0, 3072, ((bf16_t*)(ws + OFF_W1_2)), 1024, smem);
  conv_seg(p.c_w_in, 5136, 3088, 512, ((bf16_t*)(ws + OFF_W1_2)) + 3072 * 1024, 1024, smem);
  conv_seg(p.c_w_in, 5136, 3072, 16, ((bf16_t*)(ws + OFF_W1_2)) + 3584 * 1024, 1024, smem);
  conv_seg(p.c_w_in, 5136, 3600, 1536, W2 + 2 * 1536 * 1024, 1024, smem);
  for (int l = 0; l < 4; l++) conv_seg(p.w_out + (size_t)l * 1536 * 1024, 1024, 0, 1024, WO + (size_t)l * 1024 * 1536, 1536, smem);
  conv_seg(p.w_mem_kv, 1024, 0, 1024, WM, 1024, smem);
  for (int i = blockIdx.x * 512 + otid(); i < 240 * 1024 / 2; i += gridDim.x * 512) ((unsigned*)(((bf16_t*)(ws + OFF_W1_2)) + 3600 * 1024))[i] = 0u;
  for (int i = blockIdx.x * 512 + otid(); i < 2 * 8 * 128 * 128; i += gridDim.x * 512) {
    const int s = i & 127, t = (i >> 7) & 127;
    WS[i] = (s <= t) ? f2bf(p.a_w_s[i]) : (bf16_t)0;
  }
  {
    float* prm = (float*)(ws + OFF_PRM);
    const int gt = blockIdx.x * 512 + otid(), gs = gridDim.x * 512;
    for (int i = gt; i < 4096; i += gs) { prm[PRM_NPRE + i] = p.norm_pre[i]; prm[PRM_NPOST + i] = p.norm_post[i]; }
    for (int i = gt; i < 2048; i += gs) { prm[PRM_ALNW + i] = p.a_ln_w[i]; prm[PRM_ALNB + i] = p.a_ln_b[i]; prm[PRM_ABS + i] = p.a_b_s[i]; }
    for (int i = gt; i < 3072; i += gs) prm[PRM_BCW + i] = p.b_conv_w[i];
    for (int i = gt; i < 12288; i += gs) prm[PRM_CCW + i] = p.c_conv_w[i];
    for (int i = gt; i < 8; i += gs) { prm[PRM_CALOG + i] = p.c_a_log[i]; prm[PRM_CDT + i] = p.c_dt_bias[i]; }
    for (int i = gt; i < 128; i += gs) prm[PRM_CONW + i] = p.c_o_norm_w[i];
  }
  rmsnorm_rows(p.x, p.norm_pre, H, NTOK);
  rmsnorm_rows(p.mem, p.mem_norm_w, HMEM, 1024);
  }
  grid.sync();

  for (int ph = 0; ph < 23; ph++) {
    char* ws = lp(ws0);
    WS_PTRS(ws)
    int l, q;
    if (ph < 5) { l = 0; q = ph; } else if (ph < 10) { l = 1; q = ph - 5; } else if (ph < 18) { l = 2; q = ph - 10; } else { l = 3; q = ph - 18; }
    const int kind = l % 3;
    int op, hf = 0;
    if (kind == 2) { op = q == 0 ? 0 : q == 1 ? 1 : q == 2 ? 6 : q == 3 ? 1 : q == 4 ? 7 : q == 5 ? 8 : q == 6 ? 4 : 5; hf = q >= 3 ? 1 : 0; }
    else op = q == 0 ? 0 : (q == 1 ? 2 : q + 1);
    const int bx = blockIdx.x, G = gridDim.x;
    const bool scanblk = (op == 6 || op == 7) && bx < 32;
    if (op == 0 || (op == 6 && !scanblk)) {
      const bf16_t* W1l = (const bf16_t*)(ws + (l == 0 ? OFF_W1_0 : l == 1 ? OFF_W1_1 : l == 2 ? OFF_W1_2 : OFF_W1_3));
      if (kind == 0) {
        EpiA1 e{(bf16_t*)BIG, (bf16_t*)(BIG + BIG_VT), (bf16_t*)(BIG + BIG_QX)};
        gemm_phase(H, W1l, NTOK, 2560, 1024, e, smem);
      } else if (kind == 1) {
        EpiPlain e{(bf16_t*)BIG, 3584};
        gemm_phase(H, W1l, NTOK, 3584, 1024, e, smem);
      } else {
        const int g1h = op == 6 ? 1 : 0;
        EpiC1 e{(bf16_t*)BIG, AB, g1h * 4096};
        gemm_phase(H, W1l, 16384, 3840, 1024, e, smem, g1h * 4096, op == 6 ? G - 32 : -1, bx - 32);
      }
      if (l == 0) {
        EpiMem e{KIMG, VIMG};
        gemm_phase(HMEM, WM, 1024, 1024, 1024, e, smem);
      }
    }
    if (op == 1) prep_phase((const bf16_t*)BIG, AB, PRM + PRM_CCW, PRM + PRM_CALOG, PRM + PRM_CDT, BIG + BIG_OPS, GL, STASH, hf, smem);
    if (op == 2) {
      if (kind == 0) {
        const int j = l / 3;
        gmlp_phase((const bf16_t*)BIG, (const bf16_t*)(BIG + BIG_VT), WS + (size_t)j * 8 * 128 * 128, PRM + PRM_ALNW + j * 1024, PRM + PRM_ALNB + j * 1024,
                   PRM + PRM_ABS + j * 1024, MIX, smem);
      } else {
        sconv_phase((const bf16_t*)BIG, PRM + PRM_BCW, MIX);
      }
    }
    if (scanblk) scan_block(BIG + BIG_OPS, GL, MIX, SSQ, STB, op == 6 ? 0 : 1, smem);
    if (op == 1 || op == 2) {
      const bf16_t* Q; int ldq, tok0, nrows;
      if (kind == 0) { Q = (const bf16_t*)(BIG + BIG_QX); ldq = 512; tok0 = -1; nrows = NTOK; }
      else if (kind == 1) { Q = (const bf16_t*)BIG + 3072; ldq = 3584; tok0 = -1; nrows = NTOK; }
      else { Q = (const bf16_t*)BIG + 3072; ldq = 3584; tok0 = hf * 4096; nrows = 16384; }
      attn_phase(Q, ldq, tok0, nrows, KIMG, VIMG, MIX, bx, G, smem);
    }
    if (op == 3 || op == 8 || (op == 7 && !scanblk)) {
      const int nv = op == 7 ? 2 : 1;
      for (int v = 0; v < nv; v++) {
        const bf16_t* Bz = W2 + (size_t)l * 1536 * 1024;
        int M = NTOK, N = 1536, asplit = -1, col0 = 0;
        if (op == 7 && v == 0) { Bz += (size_t)1024 * 1024; N = 512; col0 = 1024; }
        if ((op == 7 && v == 1) || op == 8) { M = 16384; N = 1024; asplit = op == 8 ? 4096 : 0; }
        EpiGate e{MIX, SSQ, PRM + PRM_CONW, kind == 2 ? 1 : 0, col0, asplit};
        gemm_phase(H, Bz, M, N, 1024, e, smem, asplit, op == 7 ? G - 32 : -1, bx - 32);
      }
    }
    if (op == 4) {
      EpiOut e{(bf16_t*)BIG};
      gemm_phase(MIX, WO + (size_t)l * 1024 * 1536, NTOK, 1024, 1536, e, smem);
    }
    if (op == 5) {
      bf16_t* XB12 = (bf16_t*)p.out; bf16_t* XB3 = (bf16_t*)(BIG + 199229440);
      norm_phase((const bf16_t*)BIG, l == 0 ? p.x : nullptr, l == 0 ? nullptr : (l == 3 ? XB3 : XB12), l == 3 ? p.out : nullptr,
                 l == 3 ? nullptr : (l == 2 ? XB3 : XB12), PRM + PRM_NPOST + l * 1024, l < 3 ? PRM + PRM_NPRE + (l + 1) * 1024 : nullptr, H);
    }
    xcd_barrier(xb);
  }
}

extern "C" void kernel_launch(void* const* d_in, const int* in_sizes, int n_in, void* d_out, int out_size, void* d_ws, size_t ws_size,
                              hipStream_t stream) {
  static int grid_blocks = 0;
  if (!grid_blocks) {
    int dev = 0, cus = 0, per_cu = 0;
    (void)hipGetDevice(&dev);
    (void)hipDeviceGetAttribute(&cus, hipDeviceAttributeMultiprocessorCount, dev);
    (void)hipOccupancyMaxActiveBlocksPerMultiprocessor(&per_cu, mega_kernel, 512, 0);
    if (per_cu > 1) per_cu = 1;
    if (per_cu < 1) per_cu = 1;
    grid_blocks = cus * per_cu;
  }
  Params p{};
  p.x = (const float*)d_in[0]; p.mem = (const float*)d_in[1]; p.mem_norm_w = (const float*)d_in[2]; p.w_mem_kv = (const float*)d_in[3];
  p.norm_pre = (const float*)d_in[4]; p.norm_post = (const float*)d_in[5]; p.w_out = (const float*)d_in[6]; p.a_w_in = (const float*)d_in[7];
  p.a_ln_w = (const float*)d_in[8]; p.a_ln_b = (const float*)d_in[9]; p.a_w_s = (const float*)d_in[10]; p.a_b_s = (const float*)d_in[11];
  p.b_w_in = (const float*)d_in[12]; p.b_conv_w = (const float*)d_in[13]; p.c_w_in = (const float*)d_in[14]; p.c_conv_w = (const float*)d_in[15];
  p.c_a_log = (const float*)d_in[16]; p.c_dt_bias = (const float*)d_in[17]; p.c_o_norm_w = (const float*)d_in[18];
  p.out = (float*)d_out;
  p.ws = (char*)d_ws;
  (void)hipMemsetAsync((char*)d_ws + OFF_BAR, 0, XCD_BAR_WORDS * sizeof(unsigned), stream);
  void* args[] = {&p};
  hipError_t e = hipLaunchCooperativeKernel((void*)mega_kernel, dim3(grid_blocks), dim3(512), args, 0, stream);
  if (e != hipSuccess) fprintf(stderr, "cooperative launch failed: %s (grid %d)\n", hipGetErrorString(e), grid_blocks);
}
```

```cpp
#include <hip/hip_runtime.h>
#include <hip/hip_cooperative_groups.h>
#include <cstdio>
namespace cg = cooperative_groups;

#define DI __device__ __forceinline__
typedef unsigned short bf16_t;
typedef short bf16x8 __attribute__((ext_vector_type(8)));
typedef float f32x4 __attribute__((ext_vector_type(4)));
typedef unsigned u32x4 __attribute__((ext_vector_type(4)));
typedef unsigned u32x2 __attribute__((ext_vector_type(2)));

constexpr int NTOK = 32768;
constexpr float EPS = 1e-6f;
constexpr int LDS_BYTES = 161856;
constexpr int OPS_STRIDE = 73728;

constexpr size_t SZ_W1A = 2560ull * 1024 * 2, SZ_W1B = 3584ull * 1024 * 2, SZ_W1C = 3840ull * 1024 * 2;
constexpr size_t OFF_W1_0 = 0;
constexpr size_t OFF_W1_1 = OFF_W1_0 + SZ_W1A;
constexpr size_t OFF_W1_2 = OFF_W1_1 + SZ_W1B;
constexpr size_t OFF_W1_3 = OFF_W1_2 + SZ_W1C;
constexpr size_t SZ_W2 = 1536ull * 1024 * 2;
constexpr size_t OFF_W2 = OFF_W1_3 + SZ_W1A;
constexpr size_t OFF_WO = OFF_W2 + 4 * SZ_W2;
constexpr size_t OFF_WM = OFF_WO + 4 * SZ_W2;
constexpr size_t OFF_WS = OFF_WM + 2097152;
constexpr size_t OFF_HMEM = OFF_WS + 524288;
constexpr size_t OFF_KIMG = OFF_HMEM + 2097152;
constexpr size_t OFF_VIMG = OFF_KIMG + 1048576;
constexpr size_t OFF_AB = OFF_VIMG + 1048576;
constexpr size_t OFF_SSQ = OFF_AB + 2097152;
constexpr size_t OFF_GL = OFF_SSQ + 1048576;
constexpr size_t OFF_ST = OFF_GL + 65536;
constexpr size_t OFF_STASH = OFF_ST + 2097152;
constexpr size_t OFF_BAR = OFF_STASH + 131072;
constexpr size_t OFF_PRM = OFF_BAR + 65536;
constexpr size_t OFF_H = OFF_PRM + 131072;
constexpr size_t OFF_MIX = OFF_H + 67108864;
constexpr size_t OFF_BIG = OFF_MIX + 100663296;
constexpr size_t BIG_VT = 67108864, BIG_QX = 134217728, BIG_OPS = 117440512;
static_assert(OFF_BIG + 268435456ull <= 536870912ull, "workspace overflow");

struct Params {
  const float *x, *mem, *mem_norm_w, *w_mem_kv, *norm_pre, *norm_post, *w_out, *a_w_in, *a_ln_w, *a_ln_b, *a_w_s, *a_b_s,
      *b_w_in, *b_conv_w, *c_w_in, *c_conv_w, *c_a_log, *c_dt_bias, *c_o_norm_w;
  float* out;
  char* ws;
};

typedef float f32x2 __attribute__((ext_vector_type(2)));
typedef __bf16 bf16x2_t __attribute__((ext_vector_type(2)));
DI unsigned pk2(float lo, float hi) { f32x2 v = {lo, hi}; bf16x2_t b = __builtin_convertvector(v, bf16x2_t); return __builtin_bit_cast(unsigned, b); }
DI float lo2f(unsigned p) { return __uint_as_float(p << 16); }
DI float hi2f(unsigned p) { return __uint_as_float(p & 0xffff0000u); }
DI float bf2f(bf16_t v) { return __uint_as_float(((unsigned)v) << 16); }
DI bf16_t f2bf(float f) { return (bf16_t)(pk2(f, 0.f) & 0xffffu); }
DI int zoff() { int z; asm volatile("s_mov_b32 %0, 0" : "=s"(z)); return z; }
DI int obid() { int r; asm volatile("s_mov_b32 %0, %1" : "=s"(r) : "s"(blockIdx.x)); return r; }
DI int ogrid() { int r; asm volatile("s_mov_b32 %0, %1" : "=s"(r) : "s"(gridDim.x)); return r; }
template <class T> DI T* lp(T* p) { return (T*)((char*)p + zoff()); }
DI int otid() { int t; asm volatile("v_mov_b32 %0, %1" : "=v"(t) : "v"(threadIdx.x)); return t; }
DI float wsum(float v) {
#pragma unroll
  for (int o = 32; o; o >>= 1) v += __shfl_xor(v, o);
  return v;
}
DI float sigmoidf_(float x) { return __builtin_amdgcn_rcpf(1.f + __expf(-x)); }
DI float siluf_(float x) { return x * sigmoidf_(x); }
DI float geluf_(float x) { const float u = 0.7978845608028654f * (x + 0.044715f * x * x * x); return x * sigmoidf_(2.f * u); }
DI f32x4 mfma16(bf16x8 a, bf16x8 b, f32x4 c) { return __builtin_amdgcn_mfma_f32_16x16x32_bf16(a, b, c, 0, 0, 0); }
DI bf16x8 pack8(f32x4 a, f32x4 b) {
  u32x4 p; p[0] = pk2(a[0], a[1]); p[1] = pk2(a[2], a[3]); p[2] = pk2(b[0], b[1]); p[3] = pk2(b[2], b[3]);
  return __builtin_bit_cast(bf16x8, p);
}
DI void unpack8(u32x4 p, float* v) {
#pragma unroll
  for (int i = 0; i < 4; i++) { v[2 * i] = lo2f(p[i]); v[2 * i + 1] = hi2f(p[i]); }
}

#define LAS __attribute__((address_space(3)))
constexpr int G_BM = 256, G_BK = 64, G_HALF = 128, G_HTB = G_HALF * G_BK * 2, G_NXCD = 8, G_WGM = 8;
DI int lds_byte(int r, int c) { const int st = (r >> 4) * 2 + (c >> 5), rr = r & 15, cc = c & 31, ob = rr * 64 + cc * 2; return st * 1024 + (ob ^ (((ob >> 9) & 1) << 5)); }
DI void stage_rc(int b, int& R, int& C) { const int st = b / 1024, sb = b % 1024, swz = sb ^ (((sb >> 9) & 1) << 5); R = (st >> 1) * 16 + swz / 64; C = (st & 1) * 32 + (swz % 64) / 2; }
struct UnitOrder {
  int nM, nN, nwg, G, c;
  DI void init(int M, int N, int G_, int c_) { nM = M / G_BM; nN = N / G_BM; nwg = nM * nN; G = G_; c = c_; }
  DI bool next(int i, int& pm, int& pn) const {
    const long L = (long)i * G + c; if (L >= nwg) return false;
    int wgid = (int)L; { const int q = nwg / G_NXCD, r = nwg % G_NXCD, xcd = wgid % G_NXCD, off = wgid / G_NXCD; wgid = (xcd < r ? xcd * (q + 1) : r * (q + 1) + (xcd - r) * q) + off; }
    const int nig = G_WGM * nN, gid = wgid / nig, fm = gid * G_WGM, gsz = (nM - fm) < G_WGM ? (nM - fm) : G_WGM;
    pm = fm + ((wgid % nig) % gsz); pn = (wgid % nig) / gsz; return true;
  }
};
template <class Epi>
DI void gemm_phase(const bf16_t* __restrict__ A, const bf16_t* __restrict__ Bt, int M, int N, int K, const Epi& epi, char* smem, int asplit = -1, int gG = -1, int gC = 0) {
  const int bx_ = obid(), G_ = ogrid(); (void)bx_; (void)G_;
  A = lp(A);
  Bt = lp(Bt);
  smem += zoff();
  LAS unsigned char* lds = (LAS unsigned char*)smem;
  const int tid = otid(), wid = __builtin_amdgcn_readfirstlane(tid >> 6), lane = tid & 63, wr = wid >> 2, wc = wid & 3, fr = lane & 15, fq = lane >> 4;
  const int nt = K / G_BK;
  unsigned voff[2];
#pragma unroll
  for (int i = 0; i < 2; ++i) { int R, C; stage_rc(tid * 16 + i * 8192, R, C); voff[i] = (unsigned)(R * K + C) * 2u; }
  const size_t kstep = (size_t)(G_BK * 2);
  const size_t hstep = (size_t)G_HALF * K * 2;
  const size_t tstep = 2 * hstep;
  const unsigned ldsw = (unsigned)wid * 1024u;
  const int aoff = lds_byte(wr * 64 + fr, fq * 8), boff = lds_byte(wc * 32 + fr, fq * 8);
#define PG8_SA(b, h) (((b) * 2 + (h)) * G_HTB)
#define PG8_SB(b, h) ((4 + (b) * 2 + (h)) * G_HTB)
#define PG8_STAGE(bufoff, gbase) do { _Pragma("unroll") for (int _i = 0; _i < 2; ++_i) \
    __builtin_amdgcn_global_load_lds((const unsigned*)((const char*)(gbase) + voff[_i]), (LAS unsigned*)(lds + (bufoff) + ldsw + _i * 8192), 16, 0, 0); } while (0)
#define PG8_LDA(dst, b, h) do { _Pragma("unroll") for (int m = 0; m < 4; ++m) _Pragma("unroll") for (int k = 0; k < 2; ++k) dst[m][k] = *(const LAS bf16x8*)(lds + PG8_SA(b, h) + aoff + m * 2048 + k * 1024); } while (0)
#define PG8_LDB(dst, b, h) do { _Pragma("unroll") for (int n = 0; n < 2; ++n) _Pragma("unroll") for (int k = 0; k < 2; ++k) dst[n][k] = *(const LAS bf16x8*)(lds + PG8_SB(b, h) + boff + n * 2048 + k * 1024); } while (0)
#define PG8_MMA(ai, bj, At, Bt_) do { __builtin_amdgcn_s_setprio(1); _Pragma("unroll") for (int m = 0; m < 4; ++m) _Pragma("unroll") for (int n = 0; n < 2; ++n) _Pragma("unroll") for (int k = 0; k < 2; ++k) \
    acc[ai][bj][m][n] = __builtin_amdgcn_mfma_f32_16x16x32_bf16(Bt_[n][k], At[m][k], acc[ai][bj][m][n], 0, 0, 0); __builtin_amdgcn_s_setprio(0); } while (0)
#define PG8_WAIT_V(n) asm volatile("s_waitcnt vmcnt(" #n ")" ::: "memory")
#define PG8_WAIT_L(n) asm volatile("s_waitcnt lgkmcnt(" #n ")" ::: "memory")
#define PG8_BAR __builtin_amdgcn_s_barrier()
#define PG8_SCHED __builtin_amdgcn_sched_barrier(0)
#define PG8_AROW(pm) ((size_t)(asplit < 0 ? (pm) * 256 : (((pm) >> 4) << 13) + asplit + (((pm) & 15) << 8)))
  UnitOrder S; S.init(M, N, gG < 0 ? G_ : gG, gG < 0 ? bx_ : gC);
  int cpm, cpn, npm = 0, npn = 0, ui = 0;
  if (!S.next(0, cpm, cpn)) return;
  f32x4 acc[2][2][4][2];
#pragma unroll
  for (int a = 0; a < 2; ++a)
#pragma unroll
    for (int b = 0; b < 2; ++b)
#pragma unroll
      for (int m = 0; m < 4; ++m)
#pragma unroll
        for (int n = 0; n < 2; ++n) acc[a][b][m][n] = (f32x4){0.f, 0.f, 0.f, 0.f};
  bf16x8 At[4][2], B0[2][2], B1[2][2];
  const char* cA = (const char*)A + PG8_AROW(cpm) * K * 2; const char* cB = (const char*)Bt + (size_t)cpn * tstep;
  PG8_STAGE(PG8_SB(0, 0), cB); PG8_STAGE(PG8_SA(0, 0), cA); PG8_STAGE(PG8_SB(0, 1), cB + hstep); PG8_STAGE(PG8_SA(0, 1), cA + hstep);
  if (wr == 1) PG8_BAR;
  PG8_WAIT_V(4); PG8_BAR;
  PG8_STAGE(PG8_SB(1, 0), cB + kstep); PG8_STAGE(PG8_SA(1, 0), cA + kstep); PG8_STAGE(PG8_SB(1, 1), cB + hstep + kstep);
  PG8_WAIT_V(6); PG8_BAR;
  for (;;) {
    const bool has_next = S.next(ui + 1, npm, npn);
    const char* nA = has_next ? (const char*)A + PG8_AROW(npm) * K * 2 : cA; const char* nB = has_next ? (const char*)Bt + (size_t)npn * tstep : cB;
    for (int t = 0; t < nt; t += 2) {
      const bool last = (t == nt - 2);
      const char* a1 = cA + (size_t)(t + 1) * kstep;
      const char* a2 = last ? nA : cA + (size_t)(t + 2) * kstep; const char* b2 = last ? nB : cB + (size_t)(t + 2) * kstep;
      const char* a3 = a2 + kstep; const char* b3 = b2 + kstep;
      PG8_LDB(B0, 0, 0); PG8_SCHED; PG8_LDA(At, 0, 0); PG8_STAGE(PG8_SA(1, 1), a1 + hstep);
      PG8_WAIT_L(8); PG8_BAR; PG8_WAIT_L(0); PG8_MMA(0, 0, At, B0); PG8_BAR; PG8_SCHED;
      PG8_LDB(B1, 0, 1); PG8_STAGE(PG8_SB(0, 0), b2);
      PG8_BAR; PG8_WAIT_L(0); PG8_MMA(0, 1, At, B1); PG8_BAR;
      PG8_LDA(At, 0, 1); PG8_STAGE(PG8_SA(0, 0), a2);
      PG8_BAR; PG8_WAIT_L(0); PG8_MMA(1, 0, At, B0); PG8_BAR; PG8_SCHED;
      PG8_STAGE(PG8_SB(0, 1), b2 + hstep);
      PG8_WAIT_V(6); PG8_BAR; PG8_MMA(1, 1, At, B1); PG8_BAR;
      PG8_LDB(B0, 1, 0); PG8_SCHED; PG8_LDA(At, 1, 0); PG8_STAGE(PG8_SA(0, 1), a2 + hstep);
      PG8_WAIT_L(8); PG8_BAR; PG8_WAIT_L(0); PG8_MMA(0, 0, At, B0); PG8_BAR; PG8_SCHED;
      PG8_LDB(B1, 1, 1); PG8_STAGE(PG8_SB(1, 0), b3);
      PG8_BAR; PG8_WAIT_L(0); PG8_MMA(0, 1, At, B1); PG8_BAR;
      PG8_LDA(At, 1, 1); PG8_STAGE(PG8_SA(1, 0), a3);
      PG8_BAR; PG8_WAIT_L(0); PG8_MMA(1, 0, At, B0); PG8_BAR; PG8_SCHED;
      PG8_STAGE(PG8_SB(1, 1), b3 + hstep);
      PG8_WAIT_V(6); PG8_BAR; PG8_MMA(1, 1, At, B1); PG8_BAR;
    }
#pragma unroll
    for (int ai = 0; ai < 2; ++ai)
#pragma unroll
      for (int m = 0; m < 4; ++m)
#pragma unroll
        for (int bj = 0; bj < 2; ++bj)
#pragma unroll
          for (int n = 0; n < 2; ++n)
            epi(cpm * 256 + ai * 128 + wr * 64 + m * 16 + fr, cpn * 256 + bj * 128 + wc * 32 + n * 16 + fq * 4, acc[ai][bj][m][n]);
    if (!has_next) break;
#pragma unroll
    for (int a = 0; a < 2; ++a)
#pragma unroll
      for (int b = 0; b < 2; ++b)
#pragma unroll
        for (int m = 0; m < 4; ++m)
#pragma unroll
          for (int n = 0; n < 2; ++n) acc[a][b][m][n] = (f32x4){0.f, 0.f, 0.f, 0.f};
    cpm = npm; cpn = npn; cA = nA; cB = nB; ++ui;
  }
  PG8_WAIT_V(0);
  if (wr == 0) PG8_BAR;
  PG8_BAR;
#undef PG8_SA
#undef PG8_SB
#undef PG8_STAGE
#undef PG8_LDA
#undef PG8_LDB
#undef PG8_MMA
#undef PG8_WAIT_V
#undef PG8_WAIT_L
#undef PG8_BAR
#undef PG8_SCHED
#undef PG8_AROW
}

struct EpiMem {
  bf16_t *kimg, *vimg;
  DI void operator()(int row, int col, f32x4 v) const {
    const int b = row >> 8, m = row & 255;
    const int cb = __builtin_amdgcn_readfirstlane(col & ~127);
    if (cb < 512) {
      const int head = col >> 7, d = col & 127;
      const int mt = m >> 4, n = m & 15, ks = d >> 5, jq = (d & 31) >> 3, j = d & 7;
      bf16_t* p = kimg + (size_t)(b * 4 + head) * 32768 + ((mt * 4 + ks) * 64 + jq * 16 + n) * 8 + j;
      *(u32x2*)p = (u32x2){pk2(v[0], v[1]), pk2(v[2], v[3])};
    } else {
      const int c2 = col - 512, head = c2 >> 7, d0 = c2 & 127;
      const int kk = m >> 5, mm = m & 31, j = 4 * (mm >> 4) + (mm & 3), jq = (mm & 15) >> 2;
#pragma unroll
      for (int i = 0; i < 4; i++) {
        const int d = d0 + i, dt = d >> 4, r = d & 15;
        vimg[(size_t)(b * 4 + head) * 32768 + ((dt * 8 + kk) * 64 + jq * 16 + r) * 8 + j] = f2bf(v[i]);
      }
    }
  }
};
struct EpiA1 {
  bf16_t *U, *VT, *QX;
  DI void operator()(int row, int col, f32x4 v) const {
    const int cb = __builtin_amdgcn_readfirstlane(col & ~127);
    if (cb < 1024) {
      *(u32x2*)(U + (size_t)row * 1024 + col) = (u32x2){pk2(geluf_(v[0]), geluf_(v[1])), pk2(geluf_(v[2]), geluf_(v[3]))};
    } else if (cb < 2048) {
      const int c = col - 1024, chunk = row >> 7, s = row & 127;
#pragma unroll
      for (int i = 0; i < 4; i++) VT[(((size_t)chunk * 1024 + c + i) << 7) + s] = f2bf(geluf_(v[i]));
    } else {
      *(u32x2*)(QX + (size_t)row * 512 + (col - 2048)) = (u32x2){pk2(v[0], v[1]), pk2(v[2], v[3])};
    }
  }
};
struct EpiPlain {
  bf16_t* R; int ld;
  DI void operator()(int row, int col, f32x4 v) const { *(u32x2*)(R + (size_t)row * ld + col) = (u32x2){pk2(v[0], v[1]), pk2(v[2], v[3])}; }
};
struct EpiC1 {
  bf16_t* R; float* ab; int hfoff;
  DI void operator()(int row, int col, f32x4 v) const {
    const int cb = __builtin_amdgcn_readfirstlane(col & ~127);
    if (cb < 3584) *(u32x2*)(R + (size_t)row * 3584 + col) = (u32x2){pk2(v[0], v[1]), pk2(v[2], v[3])};
    else if (cb == 3584 && col < 3600) *(f32x4*)(ab + (size_t)(((row >> 12) << 13) + hfoff + (row & 4095)) * 16 + (col - 3584)) = v;
  }
};
struct EpiGate {
  bf16_t* Y; const float* ssq; const float* onw; int isC, col0, hfoff;
  DI void operator()(int row, int col, f32x4 v) const {
    const int tok = hfoff < 0 ? row : ((row >> 12) << 13) + hfoff + (row & 4095);
    const int yc = col + col0;
    u32x2* p = (u32x2*)(Y + (size_t)tok * 1536 + yc);
    const u32x2 m = *p;
    float a0 = lo2f(m[0]), a1 = hi2f(m[0]), a2 = lo2f(m[1]), a3 = hi2f(m[1]);
    if (isC && __builtin_amdgcn_readfirstlane(yc & ~127) < 1024) {
      const float r = rsqrtf(ssq[(size_t)tok * 8 + (yc >> 7)] * (1.f / 128.f) + EPS);
      const f32x4 w = *(const f32x4*)(onw + (yc & 127));
      a0 *= r * w[0]; a1 *= r * w[1]; a2 *= r * w[2]; a3 *= r * w[3];
    }
    *p = (u32x2){pk2(a0 * siluf_(v[0]), a1 * siluf_(v[1])), pk2(a2 * siluf_(v[2]), a3 * siluf_(v[3]))};
  }
};
struct EpiOut {
  bf16_t* O;
  DI void operator()(int row, int col, f32x4 v) const { *(u32x2*)(O + (size_t)row * 1024 + col) = (u32x2){pk2(v[0], v[1]), pk2(v[2], v[3])}; }
};

DI void conv_seg(const float* __restrict__ src, int ld, int col0, int ncols, bf16_t* __restrict__ dst, int K, char* smem) {
  const int bx_ = obid(), G_ = ogrid(); (void)bx_; (void)G_;
  src = lp(src);
  dst = lp(dst);
  smem += zoff();
  float* tile = (float*)smem;
  const int tid = otid();
  const int ntj = (ncols + 63) >> 6, ntk = K >> 6;
  for (int t = bx_; t < ntj * ntk; t += G_) {
    const int tj = t % ntj, tk = t / ntj;
    {
      const int jj = tid & 63, k0 = tid >> 6;
      const bool ok = (tj * 64 + jj) < ncols;
#pragma unroll
      for (int i = 0; i < 8; i++) {
        const int kk = k0 + 8 * i;
        tile[kk * 65 + jj] = ok ? src[(size_t)(tk * 64 + kk) * ld + col0 + tj * 64 + jj] : 0.f;
      }
    }
    __syncthreads();
    {
      const int kk2 = (tid & 31) * 2, j2 = tid >> 5;
#pragma unroll
      for (int i = 0; i < 4; i++) {
        const int jj = j2 + 16 * i;
        if (tj * 64 + jj < ncols) *(unsigned*)(dst + (size_t)(tj * 64 + jj) * K + tk * 64 + kk2) = pk2(tile[kk2 * 65 + jj], tile[(kk2 + 1) * 65 + jj]);
      }
    }
    __syncthreads();
  }
}

DI void rmsnorm_rows(const float* __restrict__ x, const float* __restrict__ w, bf16_t* __restrict__ h, int nrows) {
  const int bx_ = obid(), G_ = ogrid(); (void)bx_; (void)G_;
  x = lp(x);
  w = lp(w);
  h = lp(h);
  const int lane = otid() & 63, wid = otid() >> 6;
  f32x4 wv[4];
#pragma unroll
  for (int i = 0; i < 4; i++) wv[i] = *(const f32x4*)(w + i * 256 + lane * 4);
  for (int row = bx_ * 8 + wid; row < nrows; row += G_ * 8) {
    f32x4 v[4]; float ss = 0.f;
#pragma unroll
    for (int i = 0; i < 4; i++) { v[i] = *(const f32x4*)(x + (size_t)row * 1024 + i * 256 + lane * 4); ss += v[i][0] * v[i][0] + v[i][1] * v[i][1] + v[i][2] * v[i][2] + v[i][3] * v[i][3]; }
    ss = wsum(ss);
    const float r = rsqrtf(ss * (1.f / 1024.f) + EPS);
#pragma unroll
    for (int i = 0; i < 4; i++)
      *(u32x2*)(h + (size_t)row * 1024 + i * 256 + lane * 4) = (u32x2){pk2(v[i][0] * r * wv[i][0], v[i][1] * r * wv[i][1]), pk2(v[i][2] * r * wv[i][2], v[i][3] * r * wv[i][3])};
  }
}

DI void norm_phase(const bf16_t* __restrict__ O, const float* xin, float* xout, const float* __restrict__ wpost, const float* __restrict__ wpre, bf16_t* __restrict__ h) {
  const int bx_ = obid(), G_ = ogrid(); (void)bx_; (void)G_;
  O = lp(O);
  xin = lp(xin);
  xout = lp(xout);
  wpost = lp(wpost);
  wpre = lp(wpre);
  h = lp(h);
  const int lane = otid() & 63, wid = otid() >> 6;
  f32x4 wp[4], wq[4];
#pragma unroll
  for (int i = 0; i < 4; i++) { wp[i] = *(const f32x4*)(wpost + i * 256 + lane * 4); wq[i] = wpre ? *(const f32x4*)(wpre + i * 256 + lane * 4) : (f32x4){0.f, 0.f, 0.f, 0.f}; }
  for (int row = bx_ * 8 + wid; row < NTOK; row += G_ * 8) {
    f32x4 o[4], xv[4]; float ss = 0.f;
#pragma unroll
    for (int i = 0; i < 4; i++) {
      { const u32x2 ob = *(const u32x2*)(O + (size_t)row * 1024 + i * 256 + lane * 4); o[i] = (f32x4){lo2f(ob[0]), hi2f(ob[0]), lo2f(ob[1]), hi2f(ob[1])}; }
      xv[i] = *(const f32x4*)(xin + (size_t)row * 1024 + i * 256 + lane * 4);
      ss += o[i][0] * o[i][0] + o[i][1] * o[i][1] + o[i][2] * o[i][2] + o[i][3] * o[i][3];
    }
    ss = wsum(ss);
    const float r = rsqrtf(ss * (1.f / 1024.f) + EPS);
    float s2 = 0.f;
#pragma unroll
    for (int i = 0; i < 4; i++) {
#pragma unroll
      for (int j = 0; j < 4; j++) { xv[i][j] += o[i][j] * r * wp[i][j]; s2 += xv[i][j] * xv[i][j]; }
      *(f32x4*)(xout + (size_t)row * 1024 + i * 256 + lane * 4) = xv[i];
    }
    if (wpre) {
      s2 = wsum(s2);
      const float r2 = rsqrtf(s2 * (1.f / 1024.f) + EPS);
#pragma unroll
      for (int i = 0; i < 4; i++)
        *(u32x2*)(h + (size_t)row * 1024 + i * 256 + lane * 4) = (u32x2){pk2(xv[i][0] * r2 * wq[i][0], xv[i][1] * r2 * wq[i][1]), pk2(xv[i][2] * r2 * wq[i][2], xv[i][3] * r2 * wq[i][3])};
    }
  }
}

DI void attn_phase(const bf16_t* __restrict__ Q, int ldq, int hfoff  , int nrows, const bf16_t* __restrict__ Kimg, const bf16_t* __restrict__ Vimg,
                   bf16_t* __restrict__ mix, int bid, int nb, char* smem) {
  const int bx_ = obid(), G_ = ogrid(); (void)bx_; (void)G_;
  Q = lp(Q);
  Kimg = lp(Kimg);
  Vimg = lp(Vimg);
  mix = lp(mix);
  smem += zoff();
  const int tid = otid(), lane = tid & 63, wid = tid >> 6, fr = lane & 15, fq = lane >> 4;
  const int items = (nrows >> 9) * 4;
  for (int it = bid; it < items; it += nb) {
    const int head = it & 3, span = it >> 2, lrow0 = span * 512;
    const int tokb = hfoff < 0 ? lrow0 : ((lrow0 >> 12) << 13) + hfoff + (lrow0 & 4095);
    const int b = tokb >> 13;
    const u32x4* ksrc = (const u32x4*)(Kimg + (size_t)(b * 4 + head) * 32768);
    const u32x4* vsrc = (const u32x4*)(Vimg + (size_t)(b * 4 + head) * 32768);
#pragma unroll
    for (int i = 0; i < 8; i++) ((u32x4*)smem)[tid + 512 * i] = ksrc[tid + 512 * i];
#pragma unroll
    for (int i = 0; i < 8; i++) ((u32x4*)(smem + 65536))[tid + 512 * i] = vsrc[tid + 512 * i];
    __syncthreads();
    for (int qi = 0; qi < 4; qi++) {
      const int lr = lrow0 + qi * 128 + wid * 16;
      bf16x8 qf[4];
#pragma unroll
      for (int ks = 0; ks < 4; ks++) qf[ks] = *(const bf16x8*)(Q + (size_t)(lr + fr) * ldq + head * 128 + ks * 32 + fq * 8);
      f32x4 st[16];
#pragma unroll
      for (int mt = 0; mt < 16; mt++) {
        f32x4 a = (f32x4){0.f, 0.f, 0.f, 0.f};
#pragma unroll
        for (int ks = 0; ks < 4; ks++) a = mfma16(*(const bf16x8*)(smem + ((mt * 4 + ks) * 64 + lane) * 16), qf[ks], a);
        st[mt] = a;
        if (mt & 1) __builtin_amdgcn_sched_barrier(0);
      }
      float mx = -3.0e38f;
#pragma unroll
      for (int mt = 0; mt < 16; mt++)
#pragma unroll
        for (int i = 0; i < 4; i++) mx = fmaxf(mx, st[mt][i]);
      mx = fmaxf(mx, __shfl_xor(mx, 16)); mx = fmaxf(mx, __shfl_xor(mx, 32));
      const float sc = 0.08838834764831845f * 1.4426950408889634f;
      float sum = 0.f;
#pragma unroll
      for (int mt = 0; mt < 16; mt++)
#pragma unroll
        for (int i = 0; i < 4; i++) { const float pz = __builtin_amdgcn_exp2f((st[mt][i] - mx) * sc); st[mt][i] = pz; sum += pz; }
      sum += __shfl_xor(sum, 16); sum += __shfl_xor(sum, 32);
      bf16x8 pf[8];
#pragma unroll
      for (int kk = 0; kk < 8; kk++) pf[kk] = pack8(st[2 * kk], st[2 * kk + 1]);
      const float inv = 1.f / sum;
      bf16_t* op = mix + (size_t)(tokb + (lr - lrow0) + fr) * 1536 + 1024 + head * 128 + fq * 4;
#pragma unroll
      for (int dt = 0; dt < 8; dt++) {
        f32x4 o = (f32x4){0.f, 0.f, 0.f, 0.f};
#pragma unroll
        for (int kk = 0; kk < 8; kk++) o = mfma16(*(const bf16x8*)(smem + 65536 + ((dt * 8 + kk) * 64 + lane) * 16), pf[kk], o);
        *(u32x2*)(op + dt * 16) = (u32x2){pk2(o[0] * inv, o[1] * inv), pk2(o[2] * inv, o[3] * inv)};
        __builtin_amdgcn_sched_barrier(0);
      }
    }
    __syncthreads();
  }
}

DI void gmlp_phase(const bf16_t* __restrict__ U, const bf16_t* __restrict__ VT, const bf16_t* __restrict__ Wsb, const float* __restrict__ ln_w,
                   const float* __restrict__ ln_b, const float* __restrict__ b_s, bf16_t* __restrict__ mix, char* smem) {
  const int bx_ = obid(), G_ = ogrid(); (void)bx_; (void)G_;
  U = lp(U);
  VT = lp(VT);
  Wsb = lp(Wsb);
  ln_w = lp(ln_w);
  ln_b = lp(ln_b);
  b_s = lp(b_s);
  mix = lp(mix);
  smem += zoff();
  float* red = (float*)smem;
  float* stats = (float*)(smem + 32768);
  for (int chunk = bx_; chunk < 256; chunk += G_) {
    const int tid = otid(), lane = tid & 63, wid = tid >> 6, fr = lane & 15, fq = lane >> 4;
    {
      const int s8 = tid & 15, cgp = tid >> 4;
      float sm[8], sq[8];
#pragma unroll
      for (int j = 0; j < 8; j++) { sm[j] = 0.f; sq[j] = 0.f; }
#pragma unroll 8
      for (int cc = 0; cc < 32; cc++) {
        const u32x4 raw = *(const u32x4*)(VT + (((size_t)chunk * 1024 + cgp * 32 + cc) << 7) + s8 * 8);
        float v[8]; unpack8(raw, v);
#pragma unroll
        for (int j = 0; j < 8; j++) { sm[j] += v[j]; sq[j] += v[j] * v[j]; }
      }
#pragma unroll
      for (int j = 0; j < 8; j++) { red[(cgp * 128 + s8 * 8 + j) * 2] = sm[j]; red[(cgp * 128 + s8 * 8 + j) * 2 + 1] = sq[j]; }
    }
    __syncthreads();
    if (tid < 128) {
      float S = 0.f, Q = 0.f;
      for (int g2 = 0; g2 < 32; g2++) { S += red[(g2 * 128 + tid) * 2]; Q += red[(g2 * 128 + tid) * 2 + 1]; }
      const float mean = S * (1.f / 1024.f), var = Q * (1.f / 1024.f) - mean * mean;
      stats[tid * 2] = mean; stats[tid * 2 + 1] = rsqrtf(fmaxf(var, 0.f) + EPS);
    }
    __syncthreads();
    const int g = wid;
    float lwv[8], lbv[8];
#pragma unroll
    for (int ct = 0; ct < 8; ct++) { lwv[ct] = ln_w[g * 128 + 16 * ct + fr]; lbv[ct] = ln_b[g * 128 + 16 * ct + fr]; }
#pragma unroll
    for (int tq = 0; tq < 4; tq++) {
      f32x4 acc[8][2];
#pragma unroll
      for (int ct = 0; ct < 8; ct++)
#pragma unroll
        for (int tt = 0; tt < 2; tt++) acc[ct][tt] = (f32x4){0.f, 0.f, 0.f, 0.f};
#pragma unroll
      for (int ks = 0; ks < 4; ks++) {
        if (ks <= tq) {
          float mean8[8], rstd8[8];
#pragma unroll
          for (int j = 0; j < 8; j++) { mean8[j] = stats[(32 * ks + 8 * fq + j) * 2]; rstd8[j] = stats[(32 * ks + 8 * fq + j) * 2 + 1]; }
          bf16x8 bfr[2];
#pragma unroll
          for (int tt = 0; tt < 2; tt++) bfr[tt] = *(const bf16x8*)(Wsb + ((size_t)g * 128 + 32 * tq + 16 * tt + fr) * 128 + 32 * ks + 8 * fq);
          u32x4 rawv[8];
#pragma unroll
          for (int ct = 0; ct < 8; ct++) rawv[ct] = *(const u32x4*)(VT + (((size_t)chunk * 1024 + g * 128 + 16 * ct + fr) << 7) + 32 * ks + 8 * fq);
#pragma unroll
          for (int ct = 0; ct < 8; ct++) {
            const float lw = lwv[ct], lb = lbv[ct];
            float v[8]; unpack8(rawv[ct], v);
#pragma unroll
            for (int j = 0; j < 8; j++) v[j] = (v[j] - mean8[j]) * rstd8[j] * lw + lb;
            u32x4 pa; pa[0] = pk2(v[0], v[1]); pa[1] = pk2(v[2], v[3]); pa[2] = pk2(v[4], v[5]); pa[3] = pk2(v[6], v[7]);
            const bf16x8 af = __builtin_bit_cast(bf16x8, pa);
#pragma unroll
            for (int tt = 0; tt < 2; tt++) acc[ct][tt] = mfma16(af, bfr[tt], acc[ct][tt]);
            if (ct & 1) __builtin_amdgcn_sched_barrier(0);
          }
        }
      }
#pragma unroll
      for (int tt = 0; tt < 2; tt++) {
        const int t = 32 * tq + 16 * tt + fr;
        const size_t tok = (size_t)chunk * 128 + t;
        const float bs = b_s[g * 128 + t];
        u32x2 uuv[8];
#pragma unroll
        for (int ct = 0; ct < 8; ct++) uuv[ct] = *(const u32x2*)(U + tok * 1024 + g * 128 + 16 * ct + 4 * fq);
#pragma unroll
        for (int ct = 0; ct < 8; ct++) {
          const int col = g * 128 + 16 * ct + 4 * fq;
          const u32x2 uu = uuv[ct];
          const f32x4 a = acc[ct][tt];
          *(u32x2*)(mix + tok * 1536 + col) = (u32x2){pk2(lo2f(uu[0]) * (a[0] + bs), hi2f(uu[0]) * (a[1] + bs)), pk2(lo2f(uu[1]) * (a[2] + bs), hi2f(uu[1]) * (a[3] + bs))};
        }
      }
      __builtin_amdgcn_sched_barrier(0);
    }
    __syncthreads();
  }
}

DI void sconv_phase(const bf16_t* __restrict__ R, const float* __restrict__ cw, bf16_t* __restrict__ mix) {
  const int bx_ = obid(), G_ = ogrid(); (void)bx_; (void)G_;
  R = lp(R);
  cw = lp(cw);
  mix = lp(mix);
  for (int idx = bx_ * 512 + otid(); idx < NTOK * 128; idx += G_ * 512) {
    const int row = idx >> 7, c = (idx & 127) * 8, s = row & 8191;
    float acc[8];
#pragma unroll
    for (int j = 0; j < 8; j++) acc[j] = 0.f;
#pragma unroll
    for (int k = 0; k < 3; k++) {
      if (s - 2 + k >= 0) {
        const size_t r2 = (size_t)(row - 2 + k);
        float a[8], b[8]; unpack8(*(const u32x4*)(R + r2 * 3584 + 1024 + c), a); unpack8(*(const u32x4*)(R + r2 * 3584 + 2048 + c), b);
        const f32x4 w0 = *(const f32x4*)(cw + k * 1024 + c), w1 = *(const f32x4*)(cw + k * 1024 + c + 4);
#pragma unroll
        for (int j = 0; j < 4; j++) { acc[j] += w0[j] * a[j] * b[j]; acc[4 + j] += w1[j] * a[4 + j] * b[4 + j]; }
      }
    }
    float g[8]; unpack8(*(const u32x4*)(R + (size_t)row * 3584 + c), g);
    u32x4 o;
#pragma unroll
    for (int j = 0; j < 4; j++) o[j] = pk2(g[2 * j] * acc[2 * j], g[2 * j + 1] * acc[2 * j + 1]);
    *(u32x4*)(mix + (size_t)row * 1536 + c) = o;
  }
}

constexpr int P_SET = 1024 + 3 * 17408;
constexpr int P_AF = 0, P_SET0 = 16384, P_WB = P_SET0 + 2 * P_SET, P_QK = P_WB + 17408, P_END = P_QK + 9216;
constexpr int P_WL = P_END;
constexpr int XST_OFF = P_END + 2 * 6144;
static_assert(XST_OFF + 64 <= LDS_BYTES, "prep lds");

DI void prep_loadw(const float* __restrict__ cw, int ci, float* wl, int t0, int nth) {
  const int hh = (ci >> 6) & 7;
  for (int i = t0; i < 384; i += nth) {
    const int sec = i >> 7, kk = (i >> 5) & 3, c4 = i & 31;
    *(f32x4*)(wl + i * 4) = *(const f32x4*)(cw + (size_t)kk * 3072 + sec * 1024 + hh * 128 + c4 * 4);
  }
}
DI void prep_conv(const bf16_t* __restrict__ R, const float* __restrict__ ab, const float* wl, const float* __restrict__ a_log,
                  const float* __restrict__ dt_bias, float* __restrict__ glbuf, bf16_t* __restrict__ stash, int half, int ci, char* sb, int t0, int nth) {
  float* gc = (float*)sb; float* be = gc + 64; float* eg = gc + 128; float* ek = gc + 192;
  bf16_t* Kb = (bf16_t*)(sb + 1024); bf16_t* Qb = Kb + 64 * 136; bf16_t* Vb = Qb + 64 * 136;
  const int bl = ci >> 9, hh = (ci >> 6) & 7, n = ci & 63;
  const int tokg = bl * 8192 + half * 4096 + n * 64;
  if (t0 < 64) {
    const int lane = t0;
    const float a = ab[(size_t)(tokg + lane) * 16 + hh], bb = ab[(size_t)(tokg + lane) * 16 + 8 + hh];
    const float xs = a + dt_bias[hh];
    const float sp = xs > 20.f ? xs : log1pf(__expf(xs));
    float g = -__expf(a_log[hh]) * sp;
#pragma unroll
    for (int o = 1; o < 64; o <<= 1) { const float t = __shfl_up(g, o); if (lane >= o) g += t; }
    const float gl = __shfl(g, 63);
    gc[lane] = g; be[lane] = sigmoidf_(bb); eg[lane] = __expf(g); ek[lane] = __expf(gl - g);
    if (lane == 63) glbuf[ci] = __expf(gl);
  }
  for (int idx = t0; idx < 512; idx += nth) {
    const int t = idx >> 3, sub = idx & 7;
    u32x4 raw[3][4][2];
#pragma unroll
    for (int sec = 0; sec < 3; sec++)
#pragma unroll
      for (int kk = 0; kk < 4; kk++) {
        const int sl = n * 64 + t - 3 + kk;
        if (sl >= 0 || half == 1) {
          const bf16_t* src = sl >= 0 ? R + (size_t)(bl * 4096 + sl) * 3584 + sec * 1024 + hh * 128 + sub * 16
                                      : stash + (size_t)((bl * 8 + hh) * 3 + (sl + 3)) * 384 + sec * 128 + sub * 16;
          raw[sec][kk][0] = *(const u32x4*)src; raw[sec][kk][1] = *(const u32x4*)(src + 8);
        } else {
          raw[sec][kk][0] = (u32x4){0u, 0u, 0u, 0u}; raw[sec][kk][1] = (u32x4){0u, 0u, 0u, 0u};
        }
      }
#pragma unroll
    for (int sec = 0; sec < 3; sec++) {
      float acc[16];
#pragma unroll
      for (int j = 0; j < 16; j++) acc[j] = 0.f;
#pragma unroll
      for (int kk = 0; kk < 4; kk++) {
        float xv[16]; unpack8(raw[sec][kk][0], xv); unpack8(raw[sec][kk][1], xv + 8);
#pragma unroll
        for (int q4 = 0; q4 < 4; q4++) {
          const f32x4 w = *(const f32x4*)(wl + (sec * 4 + kk) * 128 + sub * 16 + q4 * 4);
#pragma unroll
          for (int j = 0; j < 4; j++) acc[q4 * 4 + j] += w[j] * xv[q4 * 4 + j];
        }
      }
      float ss = 0.f;
#pragma unroll
      for (int j = 0; j < 16; j++) { acc[j] = siluf_(acc[j]); ss += acc[j] * acc[j]; }
      float scale = 1.f;
      if (sec < 2) {
        ss += __shfl_xor(ss, 1); ss += __shfl_xor(ss, 2); ss += __shfl_xor(ss, 4);
        scale = rsqrtf(ss + EPS) * (sec == 0 ? 0.08838834764831845f : 1.f);
      }
      bf16_t* dst = (sec == 0 ? Qb : (sec == 1 ? Kb : Vb)) + t * 136 + sub * 16;
      u32x4 p0, p1;
#pragma unroll
      for (int j = 0; j < 4; j++) { p0[j] = pk2(acc[2 * j] * scale, acc[2 * j + 1] * scale); p1[j] = pk2(acc[8 + 2 * j] * scale, acc[9 + 2 * j] * scale); }
      *(u32x4*)dst = p0; *(u32x4*)(dst + 8) = p1;
    }
    __builtin_amdgcn_sched_barrier(0);
  }
  if (half == 0 && n == 63 && t0 < 144) {
    const int r = t0 / 48, piece = t0 % 48, sec = piece >> 4, c16 = piece & 15;
    *(u32x4*)(stash + (size_t)((bl * 8 + hh) * 3 + r) * 384 + sec * 128 + c16 * 8) =
        *(const u32x4*)(R + (size_t)(bl * 4096 + 4093 + r) * 3584 + sec * 1024 + hh * 128 + c16 * 8);
  }
}

#define LDS_BAR() do { asm volatile("s_waitcnt lgkmcnt(0)" ::: "memory"); __builtin_amdgcn_s_barrier(); asm volatile("" ::: "memory"); } while (0)

DI void prep_phase(const bf16_t* __restrict__ R, const float* __restrict__ ab, const float* __restrict__ cw, const float* __restrict__ a_log,
                   const float* __restrict__ dt_bias, char* __restrict__ ops, float* __restrict__ glbuf, bf16_t* __restrict__ stash, int half, char* smem) {
  const int bx_ = obid(), G_ = ogrid(); (void)bx_; (void)G_;
  R = lp(R);
  ab = lp(ab);
  cw = lp(cw);
  a_log = lp(a_log);
  dt_bias = lp(dt_bias);
  ops = lp(ops);
  glbuf = lp(glbuf);
  stash = lp(stash);
  smem += zoff();
  float* Af = (float*)(smem + P_AF); bf16_t* Wb = (bf16_t*)(smem + P_WB); bf16_t* QKb = (bf16_t*)(smem + P_QK);
  float* WL = (float*)(smem + P_WL);
  if (bx_ < 2048) prep_loadw(cw, bx_, WL, otid(), 512);
  LDS_BAR();
  int k = -1;
  for (int ci = bx_ - G_; ci < 2048; ci += G_, k++) {
    const bool live = ci >= 0;
    const int tid = otid(), lane = tid & 63, wid = tid >> 6, fr = lane & 15, fq = lane >> 4;
    char* sb = smem + P_SET0 + (k & 1) * P_SET;
    const float* gc = (const float*)sb; const float* be = gc + 64; const float* eg = gc + 128; const float* ek = gc + 192;
    const bf16_t* Kb = (const bf16_t*)(sb + 1024); const bf16_t* Qb = Kb + 64 * 136; const bf16_t* Vb = Qb + 64 * 136;
    char* op = ops + (size_t)ci * OPS_STRIDE;
    if (live) {
      const int it = wid & 3, which = wid >> 2;
      const bf16_t* X = which ? Qb : Kb;
      bf16x8 af[4];
#pragma unroll
      for (int ks = 0; ks < 4; ks++) af[ks] = *(const bf16x8*)(X + (16 * it + fr) * 136 + 32 * ks + 8 * fq);
#pragma unroll
      for (int jt = 0; jt < 4; jt++) {
        f32x4 a = (f32x4){0.f, 0.f, 0.f, 0.f};
#pragma unroll
        for (int ks = 0; ks < 4; ks++) a = mfma16(af[ks], *(const bf16x8*)(Kb + (16 * jt + fr) * 136 + 32 * ks + 8 * fq), a);
        const int j = 16 * jt + fr;
        const float gj = gc[j];
#pragma unroll
        for (int ii = 0; ii < 4; ii++) {
          const int i = 16 * it + 4 * fq + ii;
          const float dec = __expf(fminf(gc[i] - gj, 0.f));
          if (which == 0) Af[i * 64 + j] = (j < i) ? be[i] * a[ii] * dec : 0.f;
          else QKb[i * 72 + j] = f2bf((j <= i) ? a[ii] * dec : 0.f);
        }
      }
    }
    LDS_BAR();
    if (tid < 256) {
      if (live) {
      const int col = tid;
      float Uv[64];
      const bool isv = col < 128;
      const bf16_t* xs = isv ? (Vb + col) : (Kb + (col - 128));
#pragma unroll
      for (int i = 0; i < 64; i++) { Uv[i] = bf2f(xs[i * 136]) * (be[i] * (isv ? 1.f : eg[i])); asm volatile("" : "+v"(Uv[i])); }
      __builtin_amdgcn_sched_barrier(0);
      f32x4 ac[16], an[16];
      ac[0] = *(const f32x4*)(Af + 1 * 64);
#pragma unroll
      for (int i = 1; i < 64; i++) {
        if (i + 1 < 64) {
#pragma unroll
          for (int j4 = 0; j4 < (i + 1 + 3) / 4; j4++) an[j4] = *(const f32x4*)(Af + (i + 1) * 64 + j4 * 4);
        }
        __builtin_amdgcn_sched_barrier(0);
        float xv = Uv[i], xw = 0.f, xy = 0.f, xz = 0.f;
#pragma unroll
        for (int j4 = 0; j4 < (i + 3) / 4; j4++) {
          const f32x4 a = ac[j4];
          if (j4 * 4 + 0 < i) xv -= a[0] * Uv[j4 * 4 + 0];
          if (j4 * 4 + 1 < i) xw -= a[1] * Uv[j4 * 4 + 1];
          if (j4 * 4 + 2 < i) xy -= a[2] * Uv[j4 * 4 + 2];
          if (j4 * 4 + 3 < i) xz -= a[3] * Uv[j4 * 4 + 3];
        }
        Uv[i] = (xv + xw) + (xy + xz);
        __builtin_amdgcn_sched_barrier(0);
        if (i + 1 < 64) {
#pragma unroll
          for (int j4 = 0; j4 < (i + 1 + 3) / 4; j4++) ac[j4] = an[j4];
        }
      }
      if (col < 128) {
        const int w8 = col >> 4, lo = col & 15;
#pragma unroll
        for (int ct = 0; ct < 4; ct++)
#pragma unroll
          for (int jq = 0; jq < 4; jq++)
            *(u32x2*)(op + 57344 + (((w8 * 4 + ct) * 64 + jq * 16 + lo) * 8)) = (u32x2){pk2(Uv[16 * ct + 4 * jq], Uv[16 * ct + 4 * jq + 1]), pk2(Uv[16 * ct + 4 * jq + 2], Uv[16 * ct + 4 * jq + 3])};
      } else {
#pragma unroll
        for (int i = 0; i < 64; i++) Wb[i * 136 + col - 128] = f2bf(Uv[i]);
      }
      }
    } else {
      const int t2 = tid - 256;
      if (live) {
#pragma unroll
      for (int i = 0; i < 4; i++) {
        const int idx = t2 + 256 * i, frag = idx >> 6, ln = idx & 63, ct = frag >> 2, m = frag & 3, r = ln & 15, jq = ln >> 4;
        const int c = 16 * ct + r, d0 = 32 * m + 4 * jq;
        const u32x2 lo = *(const u32x2*)(Qb + c * 136 + d0), hi = *(const u32x2*)(Qb + c * 136 + d0 + 16);
        const float e = eg[c];
        *(u32x4*)(op + 16384 + idx * 16) = (u32x4){pk2(lo2f(lo[0]) * e, hi2f(lo[0]) * e), pk2(lo2f(lo[1]) * e, hi2f(lo[1]) * e), pk2(lo2f(hi[0]) * e, hi2f(hi[0]) * e), pk2(lo2f(hi[1]) * e, hi2f(hi[1]) * e)};
      }
#pragma unroll
      for (int i = 0; i < 4; i++) {
        const int idx = t2 + 256 * i, frag = idx >> 6, ln = idx & 63, dt = frag >> 1, kk = frag & 1, r = ln & 15, jq = ln >> 4;
        const int d = 16 * dt + r;
        float v[8];
#pragma unroll
        for (int j = 0; j < 8; j++) { const int c = 32 * kk + 16 * (j >> 2) + 4 * jq + (j & 3); v[j] = bf2f(Kb[c * 136 + d]) * ek[c]; }
        *(u32x4*)(op + 40960 + idx * 16) = (u32x4){pk2(v[0], v[1]), pk2(v[2], v[3]), pk2(v[4], v[5]), pk2(v[6], v[7])};
      }
#pragma unroll
      for (int i = 0; i < 2; i++) {
        const int idx = t2 + 256 * i, frag = idx >> 6, ln = idx & 63, ct = frag >> 1, kk = frag & 1, r = ln & 15, jq = ln >> 4;
        const int row = 16 * ct + r, c0 = 32 * kk + 4 * jq;
        const u32x2 lo = *(const u32x2*)(QKb + row * 72 + c0), hi = *(const u32x2*)(QKb + row * 72 + c0 + 16);
        *(u32x4*)(op + 32768 + idx * 16) = (u32x4){lo[0], lo[1], hi[0], hi[1]};
      }
      }
      if (ci + G_ < 2048) prep_conv(R, ab, WL + ((k + 1) & 1) * 1536, a_log, dt_bias, glbuf, stash, half, ci + G_, smem + P_SET0 + ((k + 1) & 1) * P_SET, t2, 256);
      if (ci + 2 * G_ < 2048) prep_loadw(cw, ci + 2 * G_, WL + (k & 1) * 1536, t2, 256);
    }
    LDS_BAR();
    if (live)
#pragma unroll
    for (int i = 0; i < 2; i++) {
      const int idx = tid + 512 * i, frag = idx >> 6, ln = idx & 63, ct = frag >> 2, m = frag & 3, r = ln & 15, jq = ln >> 4;
      const int c = 16 * ct + r, d0 = 32 * m + 4 * jq;
      const u32x2 lo = *(const u32x2*)(Wb + c * 136 + d0), hi = *(const u32x2*)(Wb + c * 136 + d0 + 16);
      *(u32x4*)(op + idx * 16) = (u32x4){lo[0], lo[1], hi[0], hi[1]};
    }
  }
  LDS_BAR();
}

DI void scan_block(const char* __restrict__ ops, const float* __restrict__ glbuf, bf16_t* __restrict__ mix, float* __restrict__ ssq,
                   f32x4* __restrict__ stbuf, int half, char* smem) {
  const int bx_ = obid(), G_ = ogrid(); (void)bx_; (void)G_;
  ops = lp(ops);
  glbuf = lp(glbuf);
  mix = lp(mix);
  ssq = lp(ssq);
  stbuf = lp(stbuf);
  smem += zoff();
  const int tid = otid(), lane = tid & 63, w = tid >> 6, fr = lane & 15, fq = lane >> 4;
  const bool comp = w < 4;
  const int blk = bx_, bl = blk >> 3, hh = blk & 7;
  const int chunk0 = (bl * 8 + hh) * 64;
  const int tokbase = bl * 8192 + half * 4096;
  const char* cp = ops + (size_t)chunk0 * OPS_STRIDE;
  float* part = (float*)(smem + 114688);
#pragma unroll
  for (int i = 0; i < 7; i++) ((u32x4*)smem)[tid + 512 * i] = ((const u32x4*)cp)[tid + 512 * i];
  __syncthreads();
  if (!comp) {
    const int t2 = tid - 256;
    u32x4 sx[14], sy[14];
    {
      const u32x4* np = (const u32x4*)(cp + (size_t)1 * OPS_STRIDE);
#pragma unroll
      for (int i = 0; i < 14; i++) sy[i] = np[t2 + 256 * i];
    }
    for (int n = 0; n < 64; n += 2) {
      if (n + 2 < 64) {
        const u32x4* np = (const u32x4*)(cp + (size_t)(n + 2) * OPS_STRIDE);
#pragma unroll
        for (int i = 0; i < 14; i++) sx[i] = np[t2 + 256 * i];
      }
      {
        u32x4* nb = (u32x4*)(smem + 57344);
#pragma unroll
        for (int i = 0; i < 14; i++) nb[t2 + 256 * i] = sy[i];
      }
      asm volatile("s_waitcnt lgkmcnt(0)" ::: "memory");
      __builtin_amdgcn_s_barrier();
      asm volatile("" ::: "memory");
      if (n + 3 < 64) {
        const u32x4* np = (const u32x4*)(cp + (size_t)(n + 3) * OPS_STRIDE);
#pragma unroll
        for (int i = 0; i < 14; i++) sy[i] = np[t2 + 256 * i];
      }
      if (n + 2 < 64) {
        u32x4* nb = (u32x4*)smem;
#pragma unroll
        for (int i = 0; i < 14; i++) nb[t2 + 256 * i] = sx[i];
      }
      asm volatile("s_waitcnt lgkmcnt(0)" ::: "memory");
      __builtin_amdgcn_s_barrier();
      asm volatile("" ::: "memory");
    }
  } else {
    f32x4* stp = stbuf + ((size_t)(blk * 4 + w) * 16) * 64 + lane;
    f32x4 S[8][2]; bf16x8 sB[4][2];
#pragma unroll
    for (int i = 0; i < 8; i++)
#pragma unroll
      for (int nt = 0; nt < 2; nt++) S[i][nt] = half ? stp[(i * 2 + nt) * 64] : (f32x4){0.f, 0.f, 0.f, 0.f};
#pragma unroll
    for (int m = 0; m < 4; m++)
#pragma unroll
      for (int nt = 0; nt < 2; nt++) sB[m][nt] = pack8(S[2 * m][nt], S[2 * m + 1][nt]);
    u32x2 uf[4][2];
#pragma unroll
    for (int ct = 0; ct < 4; ct++)
#pragma unroll
      for (int nt = 0; nt < 2; nt++) uf[ct][nt] = *(const u32x2*)(cp + 57344 + (((2 * w + nt) * 4 + ct) * 64 + lane) * 8);
    float gl = glbuf[chunk0];
    for (int n = 0; n < 64; n++) {
      const char* buf = smem + (n & 1) * 57344;
      if (n > 0 && lane < 16) {
        const float* pp = part + ((n - 1) & 1) * 256 + 16 * w + lane;
        ssq[(size_t)(tokbase + (n - 1) * 64 + 16 * w + lane) * 8 + hh] = pp[0] + pp[64] + pp[128] + pp[192];
      }
      bf16x8 vB[2][2];
      {
        f32x4 vn[4][2];
#pragma unroll
        for (int ct = 0; ct < 4; ct++) {
          f32x4 t0 = (f32x4){0.f, 0.f, 0.f, 0.f}, t1 = t0;
#pragma unroll
          for (int m = 0; m < 4; m++) {
            const bf16x8 a = *(const bf16x8*)(buf + ((ct * 4 + m) * 64 + lane) * 16);
            t0 = mfma16(a, sB[m][0], t0); t1 = mfma16(a, sB[m][1], t1);
          }
          vn[ct][0] = (f32x4){lo2f(uf[ct][0][0]) - t0[0], hi2f(uf[ct][0][0]) - t0[1], lo2f(uf[ct][0][1]) - t0[2], hi2f(uf[ct][0][1]) - t0[3]};
          vn[ct][1] = (f32x4){lo2f(uf[ct][1][0]) - t1[0], hi2f(uf[ct][1][0]) - t1[1], lo2f(uf[ct][1][1]) - t1[2], hi2f(uf[ct][1][1]) - t1[3]};
        }
#pragma unroll
        for (int kk = 0; kk < 2; kk++)
#pragma unroll
          for (int nt = 0; nt < 2; nt++) vB[kk][nt] = pack8(vn[2 * kk][nt], vn[2 * kk + 1][nt]);
      }
      const float glc = gl;
      if (n + 1 < 64) {
        const char* np = cp + (size_t)(n + 1) * OPS_STRIDE;
#pragma unroll
        for (int ct = 0; ct < 4; ct++)
#pragma unroll
          for (int nt = 0; nt < 2; nt++) uf[ct][nt] = *(const u32x2*)(np + 57344 + (((2 * w + nt) * 4 + ct) * 64 + lane) * 8);
        gl = glbuf[chunk0 + n + 1];
      }
      __builtin_amdgcn_sched_barrier(0);
      float v[16];
      {
        bf16_t* mp = mix + (size_t)(tokbase + n * 64) * 1536 + hh * 128 + 32 * w + fr;
#pragma unroll
        for (int ct = 0; ct < 4; ct++) {
          f32x4 t0 = (f32x4){0.f, 0.f, 0.f, 0.f}, t1 = t0;
#pragma unroll
          for (int m = 0; m < 4; m++) {
            const bf16x8 a = *(const bf16x8*)(buf + 16384 + ((ct * 4 + m) * 64 + lane) * 16);
            t0 = mfma16(a, sB[m][0], t0); t1 = mfma16(a, sB[m][1], t1);
          }
#pragma unroll
          for (int kk = 0; kk < 2; kk++) {
            const bf16x8 a = *(const bf16x8*)(buf + 32768 + ((ct * 2 + kk) * 64 + lane) * 16);
            t0 = mfma16(a, vB[kk][0], t0); t1 = mfma16(a, vB[kk][1], t1);
          }
#pragma unroll
          for (int ii = 0; ii < 4; ii++) {
            const bf16_t b0 = f2bf(t0[ii]), b1 = f2bf(t1[ii]);
            bf16_t* rp = mp + (size_t)(16 * ct + 4 * fq + ii) * 1536;
            rp[0] = b0; rp[16] = b1;
            const float f0 = bf2f(b0), f1 = bf2f(b1);
            v[ct * 4 + ii] = f0 * f0 + f1 * f1;
          }
        }
      }
      __builtin_amdgcn_sched_barrier(0);
#pragma unroll
      for (int dt = 0; dt < 8; dt++) {
        f32x4 t0 = S[dt][0] * glc, t1 = S[dt][1] * glc;
#pragma unroll
        for (int kk = 0; kk < 2; kk++) {
          const bf16x8 a = *(const bf16x8*)(buf + 40960 + ((dt * 2 + kk) * 64 + lane) * 16);
          t0 = mfma16(a, vB[kk][0], t0); t1 = mfma16(a, vB[kk][1], t1);
        }
        S[dt][0] = t0; S[dt][1] = t1;
      }
#pragma unroll
      for (int m = 0; m < 4; m++)
#pragma unroll
        for (int nt = 0; nt < 2; nt++) sB[m][nt] = pack8(S[2 * m][nt], S[2 * m + 1][nt]);
      __builtin_amdgcn_sched_barrier(0);
#pragma unroll
      for (int st = 8; st >= 1; st >>= 1) {
        const bool hiL = (fr & st) != 0;
#pragma unroll
        for (int k = 0; k < st; k++) {
          const float keep = hiL ? v[k + st] : v[k];
          const float send = hiL ? v[k] : v[k + st];
          v[k] = keep + __shfl_xor(send, st);
        }
      }
      part[(n & 1) * 256 + w * 64 + 16 * (fr >> 2) + 4 * fq + (fr & 3)] = v[0];
      asm volatile("s_waitcnt lgkmcnt(0)" ::: "memory");
      __builtin_amdgcn_s_barrier();
      asm volatile("" ::: "memory");
    }
    if (lane < 16) {
      const float* pp = part + (63 & 1) * 256 + 16 * w + lane;
      ssq[(size_t)(tokbase + 63 * 64 + 16 * w + lane) * 8 + hh] = pp[0] + pp[64] + pp[128] + pp[192];
    }
    if (half == 0) {
#pragma unroll
      for (int i = 0; i < 8; i++)
#pragma unroll
        for (int nt = 0; nt < 2; nt++) stp[(i * 2 + nt) * 64] = S[i][nt];
    }
  }
  __syncthreads();
}

#define XB_TMO      128
#define XB_XCNT(j)  (256  + 64 * (j))
#define XB_XSUB(j)  (1280 + 64 * (j))
#define XB_XGEN(j)  (2304 + 64 * (j))
#define XB_TOP      3328
#define XB_TOPGEN   3392
#define XCD_BAR_WORDS 3456
#define XB_SPIN_CAP (1u << 18)

__device__ __forceinline__ unsigned xb_ld(unsigned* p)              { return __hip_atomic_load(p, __ATOMIC_RELAXED, __HIP_MEMORY_SCOPE_AGENT); }
__device__ __forceinline__ unsigned xb_add(unsigned* p, unsigned v) { return __hip_atomic_fetch_add(p, v, __ATOMIC_RELAXED, __HIP_MEMORY_SCOPE_AGENT); }
__device__ __forceinline__ unsigned xb_xcc_id() { return (unsigned)__builtin_amdgcn_s_getreg((3 << 11) | 20) & 0xFu; }
#define XB_SPIN(cond, bar) do { unsigned _sp = 0; while (cond) { __builtin_amdgcn_s_sleep(1); \
    if ((++_sp & 255u) == 0u) { if (xb_ld(&(bar)[XB_TMO])) break; if (_sp > XB_SPIN_CAP) { atomicAdd(&(bar)[XB_TMO], 1u); break; } } } } while (0)

struct XcdBarrier {
    unsigned* bar; unsigned x;
    volatile LAS unsigned* st;
};

__device__ __forceinline__ XcdBarrier xcd_barrier_post(unsigned* bar, volatile LAS unsigned* st) {
    XcdBarrier b; b.bar = bar; b.x = xb_xcc_id(); b.st = st;
    if (threadIdx.x == 0) (void)xb_add(&bar[XB_XCNT(b.x)], 1u);
    return b;
}
__device__ __forceinline__ void xcd_barrier_complete(unsigned* bar, unsigned x, unsigned& nloc, unsigned& nx) {
    const unsigned G = gridDim.x * gridDim.y * gridDim.z;
    unsigned sum, cnt, mine, sp = 0u;
    for (;;) {
        sum = 0u; cnt = 0u; mine = 0u;
#pragma unroll
        for (unsigned j = 0; j < 16; ++j) { const unsigned c = xb_ld(&bar[XB_XCNT(j)]); sum += c; cnt += (c > 0u) ? 1u : 0u; mine = (j == x) ? c : mine; }
        if (sum == G) break;
        __builtin_amdgcn_s_sleep(1);
        if ((++sp & 255u) == 0u) { if (xb_ld(&bar[XB_TMO])) break; if (sp > XB_SPIN_CAP) { atomicAdd(&bar[XB_TMO], 1u); break; } }
    }
    nloc = mine > 0u ? mine : 1u; nx = cnt > 0u ? cnt : 1u;
}

__device__ __forceinline__ void xcd_barrier(const XcdBarrier& b) {
    asm volatile("s_waitcnt vmcnt(0)" ::: "memory");
    __syncthreads();
    if (threadIdx.x == 0) {
        unsigned* bar = b.bar;
        __builtin_amdgcn_s_waitcnt(0);
        unsigned nloc = b.st[0], nx = b.st[1];
        if (nloc == 0u) { xcd_barrier_complete(bar, b.x, nloc, nx); b.st[0] = nloc; b.st[1] = nx; }
        const unsigned old = xb_add(&bar[XB_XSUB(b.x)], 1u);
        const unsigned gen = old / nloc;
        if (old + 1u == (gen + 1u) * nloc) {
            __builtin_amdgcn_fence(__ATOMIC_RELEASE, "agent");
            asm volatile("s_waitcnt vmcnt(0)" ::: "memory");
            const unsigned og = xb_add(&bar[XB_TOP], 1u);
            const unsigned tg = og / nx;
            if (og + 1u == (tg + 1u) * nx) xb_add(&bar[XB_TOPGEN], 1u);
            else XB_SPIN(xb_ld(&bar[XB_TOPGEN]) == tg, bar);
            __builtin_amdgcn_fence(__ATOMIC_ACQUIRE, "agent");
            xb_add(&bar[XB_XGEN(b.x)], 1u);
            asm volatile("s_waitcnt vmcnt(0)" ::: "memory");
        } else {
            XB_SPIN(xb_ld(&bar[XB_XGEN(b.x)]) == gen, bar);
            __builtin_amdgcn_fence(__ATOMIC_ACQUIRE, "agent");
            asm volatile("s_waitcnt vmcnt(0)" ::: "memory");
        }
    }
    __syncthreads();
}

constexpr int PRM_NPRE = 0, PRM_NPOST = 4096, PRM_ALNW = 8192, PRM_ALNB = 10240, PRM_ABS = 12288, PRM_BCW = 14336, PRM_CCW = 17408, PRM_CALOG = 29696, PRM_CDT = 29704, PRM_CONW = 29712;
#define WS_PTRS(ws) \
  const float* PRM = (const float*)(ws + OFF_PRM); \
  bf16_t* W2 = (bf16_t*)(ws + OFF_W2); \
  bf16_t* WO = (bf16_t*)(ws + OFF_WO); \
  bf16_t* WM = (bf16_t*)(ws + OFF_WM); \
  bf16_t* WS = (bf16_t*)(ws + OFF_WS); \
  bf16_t* HMEM = (bf16_t*)(ws + OFF_HMEM); \
  bf16_t* KIMG = (bf16_t*)(ws + OFF_KIMG); \
  bf16_t* VIMG = (bf16_t*)(ws + OFF_VIMG); \
  float* AB = (float*)(ws + OFF_AB); \
  float* SSQ = (float*)(ws + OFF_SSQ); \
  float* GL = (float*)(ws + OFF_GL); \
  f32x4* STB = (f32x4*)(ws + OFF_ST); \
  bf16_t* STASH = (bf16_t*)(ws + OFF_STASH); \
  bf16_t* H = (bf16_t*)(ws + OFF_H); \
  bf16_t* MIX = (bf16_t*)(ws + OFF_MIX); \
  char* BIG = ws + OFF_BIG;
__global__ void __launch_bounds__(512) mega_kernel(Params p) {
  __shared__ __attribute__((aligned(16))) char smem[LDS_BYTES];
  cg::grid_group grid = cg::this_grid();
  char* ws0 = p.ws;
  volatile LAS unsigned* xst = (volatile LAS unsigned*)(LAS unsigned char*)(smem + XST_OFF);
  if (threadIdx.x < 2) xst[threadIdx.x] = 0u;
  __syncthreads();
  const XcdBarrier xb = xcd_barrier_post((unsigned*)(ws0 + OFF_BAR), xst);

  {
  char* ws = lp(ws0);
  WS_PTRS(ws)
  conv_seg(p.a_w_in, 4096, 0, 2560, (bf16_t*)(ws + OFF_W1_0), 1024, smem);
  conv_seg(p.a_w_in, 4096, 2560, 1536, W2, 1024, smem);
  conv_seg(p.a_w_in + 1024 * 4096, 4096, 0, 2560, (bf16_t*)(ws + OFF_W1_3), 1024, smem);
  conv_seg(p.a_w_in + 1024 * 4096, 4096, 2560, 1536, W2 + 3 * 1536 * 1024, 1024, smem);
  conv_seg(p.b_w_in, 5120, 0, 3584, (bf16_t*)(ws + OFF_W1_1), 1024, smem);
  conv_seg(p.b_w_in, 5120, 3584, 1536, W2 + 1 * 1536 * 1024, 1024, smem);
  conv_seg(p.c_w_in, 5136, 0, 3072, ((bf16_t*)(ws + OFF_W1_2)), 1024, smem);
  conv_seg(p.c_w_in, 5136, 3088, 512, ((bf16_t*)(ws + OFF_W1_2)) + 3072 * 1024, 1024, smem);
  conv_seg(p.c_w_in, 5136, 3072, 16, ((bf16_t*)(ws + OFF_W1_2)) + 3584 * 1024, 1024, smem);
  conv_seg(p.c_w_in, 5136, 3600, 1536, W2 + 2 * 1536 * 1024, 1024, smem);
  for (int l = 0; l < 4; l++) conv_seg(p.w_out + (size_t)l * 1536 * 1024, 1024, 0, 1024, WO + (size_t)l * 1024 * 1536, 1536, smem);
  conv_seg(p.w_mem_kv, 1024, 0, 1024, WM, 1024, smem);
  for (int i = blockIdx.x * 512 + otid(); i < 240 * 1024 / 2; i += gridDim.x * 512) ((unsigned*)(((bf16_t*)(ws + OFF_W1_2)) + 3600 * 1024))[i] = 0u;
  for (int i = blockIdx.x * 512 + otid(); i < 2 * 8 * 128 * 128; i += gridDim.x * 512) {
    const int s = i & 127, t = (i >> 7) & 127;
    WS[i] = (s <= t) ? f2bf(p.a_w_s[i]) : (bf16_t)0;
  }
  {
    float* prm = (float*)(ws + OFF_PRM);
    const int gt = blockIdx.x * 512 + otid(), gs = gridDim.x * 512;
    for (int i = gt; i < 4096; i += gs) { prm[PRM_NPRE + i] = p.norm_pre[i]; prm[PRM_NPOST + i] = p.norm_post[i]; }
    for (int i = gt; i < 2048; i += gs) { prm[PRM_ALNW + i] = p.a_ln_w[i]; prm[PRM_ALNB + i] = p.a_ln_b[i]; prm[PRM_ABS + i] = p.a_b_s[i]; }
    for (int i = gt; i < 3072; i += gs) prm[PRM_BCW + i] = p.b_conv_w[i];
    for (int i = gt; i < 12288; i += gs) prm[PRM_CCW + i] = p.c_conv_w[i];
    for (int i = gt; i < 8; i += gs) { prm[PRM_CALOG + i] = p.c_a_log[i]; prm[PRM_CDT + i] = p.c_dt_bias[i]; }
    for (int i = gt; i < 128; i += gs) prm[PRM_CONW + i] = p.c_o_norm_w[i];
  }
  rmsnorm_rows(p.x, p.norm_pre, H, NTOK);
  rmsnorm_rows(p.mem, p.mem_norm_w, HMEM, 1024);
  }
  grid.sync();

  for (int ph = 0; ph < 23; ph++) {
    char* ws = lp(ws0);
    WS_PTRS(ws)
    int l, q;
    if (ph < 5) { l = 0; q = ph; } else if (ph < 10) { l = 1; q = ph - 5; } else if (ph < 18) { l = 2; q = ph - 10; } else { l = 3; q = ph - 18; }
    const int kind = l % 3;
    int op, hf = 0;
    if (kind == 2) { op = q == 0 ? 0 : q == 1 ? 1 : q == 2 ? 6 : q == 3 ? 1 : q == 4 ? 7 : q == 5 ? 8 : q == 6 ? 4 : 5; hf = q >= 3 ? 1 : 0; }
    else op = q == 0 ? 0 : (q == 1 ? 2 : q + 1);
    const int bx = blockIdx.x, G = gridDim.x;
    const bool scanblk = (op == 6 || op == 7) && bx < 32;
    if (op == 0 || (op == 6 && !scanblk)) {
      const bf16_t* W1l = (const bf16_t*)(ws + (l == 0 ? OFF_W1_0 : l == 1 ? OFF_W1_1 : l == 2 ? OFF_W1_2 : OFF_W1_3));
      if (kind == 0) {
        EpiA1 e{(bf16_t*)BIG, (bf16_t*)(BIG + BIG_VT), (bf16_t*)(BIG + BIG_QX)};
        gemm_phase(H, W1l, NTOK, 2560, 1024, e, smem);
      } else if (kind == 1) {
        EpiPlain e{(bf16_t*)BIG, 3584};
        gemm_phase(H, W1l, NTOK, 3584, 1024, e, smem);
      } else {
        const int g1h = op == 6 ? 1 : 0;
        EpiC1 e{(bf16_t*)BIG, AB, g1h * 4096};
        gemm_phase(H, W1l, 16384, 3840, 1024, e, smem, g1h * 4096, op == 6 ? G - 32 : -1, bx - 32);
      }
      if (l == 0) {
        EpiMem e{KIMG, VIMG};
        gemm_phase(HMEM, WM, 1024, 1024, 1024, e, smem);
      }
    }
    if (op == 1) prep_phase((const bf16_t*)BIG, AB, PRM + PRM_CCW, PRM + PRM_CALOG, PRM + PRM_CDT, BIG + BIG_OPS, GL, STASH, hf, smem);
    if (op == 2) {
      if (kind == 0) {
        const int j = l / 3;
        gmlp_phase((const bf16_t*)BIG, (const bf16_t*)(BIG + BIG_VT), WS + (size_t)j * 8 * 128 * 128, PRM + PRM_ALNW + j * 1024, PRM + PRM_ALNB + j * 1024,
                   PRM + PRM_ABS + j * 1024, MIX, smem);
      } else {
        sconv_phase((const bf16_t*)BIG, PRM + PRM_BCW, MIX);
      }
    }
    if (scanblk) scan_block(BIG + BIG_OPS, GL, MIX, SSQ, STB, op == 6 ? 0 : 1, smem);
    if (op == 1 || op == 2) {
      const bf16_t* Q; int ldq, tok0, nrows;
      if (kind == 0) { Q = (const bf16_t*)(BIG + BIG_QX); ldq = 512; tok0 = -1; nrows = NTOK; }
      else if (kind == 1) { Q = (const bf16_t*)BIG + 3072; ldq = 3584; tok0 = -1; nrows = NTOK; }
      else { Q = (const bf16_t*)BIG + 3072; ldq = 3584; tok0 = hf * 4096; nrows = 16384; }
      attn_phase(Q, ldq, tok0, nrows, KIMG, VIMG, MIX, bx, G, smem);
    }
    if (op == 3 || op == 8 || (op == 7 && !scanblk)) {
      const int nv = op == 7 ? 2 : 1;
      for (int v = 0; v < nv; v++) {
        const bf16_t* Bz = W2 + (size_t)l * 1536 * 1024;
        int M = NTOK, N = 1536, asplit = -1, col0 = 0;
        if (op == 7 && v == 0) { Bz += (size_t)1024 * 1024; N = 512; col0 = 1024; }
        if ((op == 7 && v == 1) || op == 8) { M = 16384; N = 1024; asplit = op == 8 ? 4096 : 0; }
        EpiGate e{MIX, SSQ, PRM + PRM_CONW, kind == 2 ? 1 : 0, col0, asplit};
        gemm_phase(H, Bz, M, N, 1024, e, smem, asplit, op == 7 ? G - 32 : -1, bx - 32);
      }
    }
    if (op == 4) {
      EpiOut e{(bf16_t*)BIG};
      gemm_phase(MIX, WO + (size_t)l * 1024 * 1536, NTOK, 1024, 1536, e, smem);
    }
    if (op == 5) {
      norm_phase((const bf16_t*)BIG, l == 0 ? p.x : p.out, p.out, PRM + PRM_NPOST + l * 1024, l < 3 ? PRM + PRM_NPRE + (l + 1) * 1024 : nullptr, H);
    }
    xcd_barrier(xb);
  }
}

extern "C" void kernel_launch(void* const* d_in, const int* in_sizes, int n_in, void* d_out, int out_size, void* d_ws, size_t ws_size,
                              hipStream_t stream) {
  static int grid_blocks = 0;
  if (!grid_blocks) {
    int dev = 0, cus = 0, per_cu = 0;
    (void)hipGetDevice(&dev);
    (void)hipDeviceGetAttribute(&cus, hipDeviceAttributeMultiprocessorCount, dev);
    (void)hipOccupancyMaxActiveBlocksPerMultiprocessor(&per_cu, mega_kernel, 512, 0);
    if (per_cu > 1) per_cu = 1;
    if (per_cu < 1) per_cu = 1;
    grid_blocks = cus * per_cu;
  }
  Params p{};
  p.x = (const float*)d_in[0]; p.mem = (const float*)d_in[1]; p.mem_norm_w = (const float*)d_in[2]; p.w_mem_kv = (const float*)d_in[3];
  p.norm_pre = (const float*)d_in[4]; p.norm_post = (const float*)d_in[5]; p.w_out = (const float*)d_in[6]; p.a_w_in = (const float*)d_in[7];
  p.a_ln_w = (const float*)d_in[8]; p.a_ln_b = (const float*)d_in[9]; p.a_w_s = (const float*)d_in[10]; p.a_b_s = (const float*)d_in[11];
  p.b_w_in = (const float*)d_in[12]; p.b_conv_w = (const float*)d_in[13]; p.c_w_in = (const float*)d_in[14]; p.c_conv_w = (const float*)d_in[15];
  p.c_a_log = (const float*)d_in[16]; p.c_dt_bias = (const float*)d_in[17]; p.c_o_norm_w = (const float*)d_in[18];
  p.out = (float*)d_out;
  p.ws = (char*)d_ws;
  (void)hipMemsetAsync((char*)d_ws + OFF_BAR, 0, XCD_BAR_WORDS * sizeof(unsigned), stream);
  void* args[] = {&p};
  hipError_t e = hipLaunchCooperativeKernel((void*)mega_kernel, dim3(grid_blocks), dim3(512), args, 0, stream);
  if (e != hipSuccess) fprintf(stderr, "cooperative launch failed: %s (grid %d)\n", hipGetErrorString(e), grid_blocks);
}
```

```cpp
#include <hip/hip_runtime.h>
#include <hip/hip_cooperative_groups.h>
#include <cstdio>
namespace cg = cooperative_groups;

#define DI __device__ __forceinline__
typedef unsigned short bf16_t;
typedef short bf16x8 __attribute__((ext_vector_type(8)));
typedef float f32x4 __attribute__((ext_vector_type(4)));
typedef unsigned u32x4 __attribute__((ext_vector_type(4)));
typedef unsigned u32x2 __attribute__((ext_vector_type(2)));

constexpr int NTOK = 32768;
constexpr float EPS = 1e-6f;
constexpr int LDS_BYTES = 161856;
constexpr int OPS_STRIDE = 73728;

constexpr size_t SZ_W1A = 2560ull * 1024 * 2, SZ_W1B = 3584ull * 1024 * 2, SZ_W1C = 3840ull * 1024 * 2;
constexpr size_t OFF_W1_0 = 0;
constexpr size_t OFF_W1_1 = OFF_W1_0 + SZ_W1A;
constexpr size_t OFF_W1_2 = OFF_W1_1 + SZ_W1B;
constexpr size_t OFF_W1_3 = OFF_W1_2 + SZ_W1C;
constexpr size_t SZ_W2 = 1536ull * 1024 * 2;
constexpr size_t OFF_W2 = OFF_W1_3 + SZ_W1A;
constexpr size_t OFF_WO = OFF_W2 + 4 * SZ_W2;
constexpr size_t OFF_WM = OFF_WO + 4 * SZ_W2;
constexpr size_t OFF_WS = OFF_WM + 2097152;
constexpr size_t OFF_HMEM = OFF_WS + 524288;
constexpr size_t OFF_KIMG = OFF_HMEM + 2097152;
constexpr size_t OFF_VIMG = OFF_KIMG + 1048576;
constexpr size_t OFF_AB = OFF_VIMG + 1048576;
constexpr size_t OFF_SSQ = OFF_AB + 2097152;
constexpr size_t OFF_GL = OFF_SSQ + 1048576;
constexpr size_t OFF_ST = OFF_GL + 65536;
constexpr size_t OFF_STASH = OFF_ST + 2097152;
constexpr size_t OFF_BAR = OFF_STASH + 131072;
constexpr size_t OFF_PRM = OFF_BAR + 65536;
constexpr size_t OFF_H = OFF_PRM + 131072;
constexpr size_t OFF_MIX = OFF_H + 67108864;
constexpr size_t OFF_BIG = OFF_MIX + 100663296;
constexpr size_t BIG_VT = 67108864, BIG_QX = 134217728, BIG_OPS = 117440512;
static_assert(OFF_BIG + 268435456ull <= 536870912ull, "workspace overflow");

struct Params {
  const float *x, *mem, *mem_norm_w, *w_mem_kv, *norm_pre, *norm_post, *w_out, *a_w_in, *a_ln_w, *a_ln_b, *a_w_s, *a_b_s,
      *b_w_in, *b_conv_w, *c_w_in, *c_conv_w, *c_a_log, *c_dt_bias, *c_o_norm_w;
  float* out;
  char* ws;
};

typedef float f32x2 __attribute__((ext_vector_type(2)));
typedef __bf16 bf16x2_t __attribute__((ext_vector_type(2)));
DI unsigned pk2(float lo, float hi) { f32x2 v = {lo, hi}; bf16x2_t b = __builtin_convertvector(v, bf16x2_t); return __builtin_bit_cast(unsigned, b); }
DI float lo2f(unsigned p) { return __uint_as_float(p << 16); }
DI float hi2f(unsigned p) { return __uint_as_float(p & 0xffff0000u); }
DI float bf2f(bf16_t v) { return __uint_as_float(((unsigned)v) << 16); }
DI bf16_t f2bf(float f) { return (bf16_t)(pk2(f, 0.f) & 0xffffu); }
DI int zoff() { int z; asm volatile("s_mov_b32 %0, 0" : "=s"(z)); return z; }
DI int obid() { int r; asm volatile("s_mov_b32 %0, %1" : "=s"(r) : "s"(blockIdx.x)); return r; }
DI int ogrid() { int r; asm volatile("s_mov_b32 %0, %1" : "=s"(r) : "s"(gridDim.x)); return r; }
template <class T> DI T* lp(T* p) { return (T*)((char*)p + zoff()); }
DI int otid() { int t; asm volatile("v_mov_b32 %0, %1" : "=v"(t) : "v"(threadIdx.x)); return t; }
DI float wsum(float v) {
#pragma unroll
  for (int o = 32; o; o >>= 1) v += __shfl_xor(v, o);
  return v;
}
DI float sigmoidf_(float x) { return __builtin_amdgcn_rcpf(1.f + __expf(-x)); }
DI float siluf_(float x) { return x * sigmoidf_(x); }
DI float geluf_(float x) { const float u = 0.7978845608028654f * (x + 0.044715f * x * x * x); return x * sigmoidf_(2.f * u); }
DI f32x4 mfma16(bf16x8 a, bf16x8 b, f32x4 c) { return __builtin_amdgcn_mfma_f32_16x16x32_bf16(a, b, c, 0, 0, 0); }
DI bf16x8 pack8(f32x4 a, f32x4 b) {
  u32x4 p; p[0] = pk2(a[0], a[1]); p[1] = pk2(a[2], a[3]); p[2] = pk2(b[0], b[1]); p[3] = pk2(b[2], b[3]);
  return __builtin_bit_cast(bf16x8, p);
}
DI void unpack8(u32x4 p, float* v) {
#pragma unroll
  for (int i = 0; i < 4; i++) { v[2 * i] = lo2f(p[i]); v[2 * i + 1] = hi2f(p[i]); }
}

#define LAS __attribute__((address_space(3)))
constexpr int G_BM = 256, G_BK = 64, G_HALF = 128, G_HTB = G_HALF * G_BK * 2, G_NXCD = 8, G_WGM = 8;
DI int lds_byte(int r, int c) { const int st = (r >> 4) * 2 + (c >> 5), rr = r & 15, cc = c & 31, ob = rr * 64 + cc * 2; return st * 1024 + (ob ^ (((ob >> 9) & 1) << 5)); }
DI void stage_rc(int b, int& R, int& C) { const int st = b / 1024, sb = b % 1024, swz = sb ^ (((sb >> 9) & 1) << 5); R = (st >> 1) * 16 + swz / 64; C = (st & 1) * 32 + (swz % 64) / 2; }
struct UnitOrder {
  int nM, nN, nwg, G, c;
  DI void init(int M, int N, int G_, int c_) { nM = M / G_BM; nN = N / G_BM; nwg = nM * nN; G = G_; c = c_; }
  DI bool next(int i, int& pm, int& pn) const {
    const long L = (long)i * G + c; if (L >= nwg) return false;
    int wgid = (int)L; { const int q = nwg / G_NXCD, r = nwg % G_NXCD, xcd = wgid % G_NXCD, off = wgid / G_NXCD; wgid = (xcd < r ? xcd * (q + 1) : r * (q + 1) + (xcd - r) * q) + off; }
    const int nig = G_WGM * nN, gid = wgid / nig, fm = gid * G_WGM, gsz = (nM - fm) < G_WGM ? (nM - fm) : G_WGM;
    pm = fm + ((wgid % nig) % gsz); pn = (wgid % nig) / gsz; return true;
  }
};
template <class Epi>
DI void gemm_phase(const bf16_t* __restrict__ A, const bf16_t* __restrict__ Bt, int M, int N, int K, const Epi& epi, char* smem, int asplit = -1, int gG = -1, int gC = 0) {
  const int bx_ = obid(), G_ = ogrid(); (void)bx_; (void)G_;
  A = lp(A);
  Bt = lp(Bt);
  smem += zoff();
  LAS unsigned char* lds = (LAS unsigned char*)smem;
  const int tid = otid(), wid = __builtin_amdgcn_readfirstlane(tid >> 6), lane = tid & 63, wr = wid >> 2, wc = wid & 3, fr = lane & 15, fq = lane >> 4;
  const int nt = K / G_BK;
  unsigned voff[2];
#pragma unroll
  for (int i = 0; i < 2; ++i) { int R, C; stage_rc(tid * 16 + i * 8192, R, C); voff[i] = (unsigned)(R * K + C) * 2u; }
  const size_t kstep = (size_t)(G_BK * 2);
  const size_t hstep = (size_t)G_HALF * K * 2;
  const size_t tstep = 2 * hstep;
  const unsigned ldsw = (unsigned)wid * 1024u;
  const int aoff = lds_byte(wr * 64 + fr, fq * 8), boff = lds_byte(wc * 32 + fr, fq * 8);
#define PG8_SA(b, h) (((b) * 2 + (h)) * G_HTB)
#define PG8_SB(b, h) ((4 + (b) * 2 + (h)) * G_HTB)
#define PG8_STAGE(bufoff, gbase) do { _Pragma("unroll") for (int _i = 0; _i < 2; ++_i) \
    __builtin_amdgcn_global_load_lds((const unsigned*)((const char*)(gbase) + voff[_i]), (LAS unsigned*)(lds + (bufoff) + ldsw + _i * 8192), 16, 0, 0); } while (0)
#define PG8_LDA(dst, b, h) do { _Pragma("unroll") for (int m = 0; m < 4; ++m) _Pragma("unroll") for (int k = 0; k < 2; ++k) dst[m][k] = *(const LAS bf16x8*)(lds + PG8_SA(b, h) + aoff + m * 2048 + k * 1024); } while (0)
#define PG8_LDB(dst, b, h) do { _Pragma("unroll") for (int n = 0; n < 2; ++n) _Pragma("unroll") for (int k = 0; k < 2; ++k) dst[n][k] = *(const LAS bf16x8*)(lds + PG8_SB(b, h) + boff + n * 2048 + k * 1024); } while (0)
#define PG8_MMA(ai, bj, At, Bt_) do { __builtin_amdgcn_s_setprio(1); _Pragma("unroll") for (int m = 0; m < 4; ++m) _Pragma("unroll") for (int n = 0; n < 2; ++n) _Pragma("unroll") for (int k = 0; k < 2; ++k) \
    acc[ai][bj][m][n] = __builtin_amdgcn_mfma_f32_16x16x32_bf16(Bt_[n][k], At[m][k], acc[ai][bj][m][n], 0, 0, 0); __builtin_amdgcn_s_setprio(0); } while (0)
#define PG8_WAIT_V(n) asm volatile("s_waitcnt vmcnt(" #n ")" ::: "memory")
#define PG8_WAIT_L(n) asm volatile("s_waitcnt lgkmcnt(" #n ")" ::: "memory")
#define PG8_BAR __builtin_amdgcn_s_barrier()
#define PG8_SCHED __builtin_amdgcn_sched_barrier(0)
#define PG8_AROW(pm) ((size_t)(asplit < 0 ? (pm) * 256 : (((pm) >> 4) << 13) + asplit + (((pm) & 15) << 8)))
  UnitOrder S; S.init(M, N, gG < 0 ? G_ : gG, gG < 0 ? bx_ : gC);
  int cpm, cpn, npm = 0, npn = 0, ui = 0;
  if (!S.next(0, cpm, cpn)) return;
  f32x4 acc[2][2][4][2];
#pragma unroll
  for (int a = 0; a < 2; ++a)
#pragma unroll
    for (int b = 0; b < 2; ++b)
#pragma unroll
      for (int m = 0; m < 4; ++m)
#pragma unroll
        for (int n = 0; n < 2; ++n) acc[a][b][m][n] = (f32x4){0.f, 0.f, 0.f, 0.f};
  bf16x8 At[4][2], B0[2][2], B1[2][2];
  const char* cA = (const char*)A + PG8_AROW(cpm) * K * 2; const char* cB = (const char*)Bt + (size_t)cpn * tstep;
  PG8_STAGE(PG8_SB(0, 0), cB); PG8_STAGE(PG8_SA(0, 0), cA); PG8_STAGE(PG8_SB(0, 1), cB + hstep); PG8_STAGE(PG8_SA(0, 1), cA + hstep);
  if (wr == 1) PG8_BAR;
  PG8_WAIT_V(4); PG8_BAR;
  PG8_STAGE(PG8_SB(1, 0), cB + kstep); PG8_STAGE(PG8_SA(1, 0), cA + kstep); PG8_STAGE(PG8_SB(1, 1), cB + hstep + kstep);
  PG8_WAIT_V(6); PG8_BAR;
  for (;;) {
    const bool has_next = S.next(ui + 1, npm, npn);
    const char* nA = has_next ? (const char*)A + PG8_AROW(npm) * K * 2 : cA; const char* nB = has_next ? (const char*)Bt + (size_t)npn * tstep : cB;
    for (int t = 0; t < nt; t += 2) {
      const bool last = (t == nt - 2);
      const char* a1 = cA + (size_t)(t + 1) * kstep;
      const char* a2 = last ? nA : cA + (size_t)(t + 2) * kstep; const char* b2 = last ? nB : cB + (size_t)(t + 2) * kstep;
      const char* a3 = a2 + kstep; const char* b3 = b2 + kstep;
      PG8_LDB(B0, 0, 0); PG8_SCHED; PG8_LDA(At, 0, 0); PG8_STAGE(PG8_SA(1, 1), a1 + hstep);
      PG8_WAIT_L(8); PG8_BAR; PG8_WAIT_L(0); PG8_MMA(0, 0, At, B0); PG8_BAR; PG8_SCHED;
      PG8_LDB(B1, 0, 1); PG8_STAGE(PG8_SB(0, 0), b2);
      PG8_BAR; PG8_WAIT_L(0); PG8_MMA(0, 1, At, B1); PG8_BAR;
      PG8_LDA(At, 0, 1); PG8_STAGE(PG8_SA(0, 0), a2);
      PG8_BAR; PG8_WAIT_L(0); PG8_MMA(1, 0, At, B0); PG8_BAR; PG8_SCHED;
      PG8_STAGE(PG8_SB(0, 1), b2 + hstep);
      PG8_WAIT_V(6); PG8_BAR; PG8_MMA(1, 1, At, B1); PG8_BAR;
      PG8_LDB(B0, 1, 0); PG8_SCHED; PG8_LDA(At, 1, 0); PG8_STAGE(PG8_SA(0, 1), a2 + hstep);
      PG8_WAIT_L(8); PG8_BAR; PG8_WAIT_L(0); PG8_MMA(0, 0, At, B0); PG8_BAR; PG8_SCHED;
      PG8_LDB(B1, 1, 1); PG8_STAGE(PG8_SB(1, 0), b3);
      PG8_BAR; PG8_WAIT_L(0); PG8_MMA(0, 1, At, B1); PG8_BAR;
      PG8_LDA(At, 1, 1); PG8_STAGE(PG8_SA(1, 0), a3);
      PG8_BAR; PG8_WAIT_L(0); PG8_MMA(1, 0, At, B0); PG8_BAR; PG8_SCHED;
      PG8_STAGE(PG8_SB(1, 1), b3 + hstep);
      PG8_WAIT_V(6); PG8_BAR; PG8_MMA(1, 1, At, B1); PG8_BAR;
    }
    if constexpr (Epi::PRELOAD) {
#pragma unroll
      for (int ai = 0; ai < 2; ++ai) {
        u32x4 pre[4][2][2];
#pragma unroll
        for (int m = 0; m < 4; ++m)
#pragma unroll
          for (int bj = 0; bj < 2; ++bj)
#pragma unroll
            for (int n = 0; n < 2; ++n)
              pre[m][bj][n] = epi.pre(cpm * 256 + ai * 128 + wr * 64 + m * 16 + fr, cpn * 256 + bj * 128 + wc * 32 + n * 16 + fq * 4);
        __builtin_amdgcn_sched_barrier(0);
#pragma unroll
        for (int m = 0; m < 4; ++m)
#pragma unroll
          for (int bj = 0; bj < 2; ++bj)
#pragma unroll
            for (int n = 0; n < 2; ++n)
              epi.fin(cpm * 256 + ai * 128 + wr * 64 + m * 16 + fr, cpn * 256 + bj * 128 + wc * 32 + n * 16 + fq * 4, acc[ai][bj][m][n], pre[m][bj][n]);
      }
    } else {
#pragma unroll
    for (int ai = 0; ai < 2; ++ai)
#pragma unroll
      for (int m = 0; m < 4; ++m)
#pragma unroll
        for (int bj = 0; bj < 2; ++bj)
#pragma unroll
          for (int n = 0; n < 2; ++n)
            epi(cpm * 256 + ai * 128 + wr * 64 + m * 16 + fr, cpn * 256 + bj * 128 + wc * 32 + n * 16 + fq * 4, acc[ai][bj][m][n]);
    }
    if (!has_next) break;
#pragma unroll
    for (int a = 0; a < 2; ++a)
#pragma unroll
      for (int b = 0; b < 2; ++b)
#pragma unroll
        for (int m = 0; m < 4; ++m)
#pragma unroll
          for (int n = 0; n < 2; ++n) acc[a][b][m][n] = (f32x4){0.f, 0.f, 0.f, 0.f};
    cpm = npm; cpn = npn; cA = nA; cB = nB; ++ui;
  }
  PG8_WAIT_V(0);
  if (wr == 0) PG8_BAR;
  PG8_BAR;
#undef PG8_SA
#undef PG8_SB
#undef PG8_STAGE
#undef PG8_LDA
#undef PG8_LDB
#undef PG8_MMA
#undef PG8_WAIT_V
#undef PG8_WAIT_L
#undef PG8_BAR
#undef PG8_SCHED
#undef PG8_AROW
}

struct EpiMem {
  static constexpr bool PRELOAD = false;
  bf16_t *kimg, *vimg;
  DI void operator()(int row, int col, f32x4 v) const {
    const int b = row >> 8, m = row & 255;
    const int cb = __builtin_amdgcn_readfirstlane(col & ~127);
    if (cb < 512) {
      const int head = col >> 7, d = col & 127;
      const int mt = m >> 4, n = m & 15, ks = d >> 5, jq = (d & 31) >> 3, j = d & 7;
      bf16_t* p = kimg + (size_t)(b * 4 + head) * 32768 + ((mt * 4 + ks) * 64 + jq * 16 + n) * 8 + j;
      *(u32x2*)p = (u32x2){pk2(v[0], v[1]), pk2(v[2], v[3])};
    } else {
      const int c2 = col - 512, head = c2 >> 7, d0 = c2 & 127;
      const int kk = m >> 5, mm = m & 31, j = 4 * (mm >> 4) + (mm & 3), jq = (mm & 15) >> 2;
#pragma unroll
      for (int i = 0; i < 4; i++) {
        const int d = d0 + i, dt = d >> 4, r = d & 15;
        vimg[(size_t)(b * 4 + head) * 32768 + ((dt * 8 + kk) * 64 + jq * 16 + r) * 8 + j] = f2bf(v[i]);
      }
    }
  }
};
struct EpiA1 {
  static constexpr bool PRELOAD = false;
  bf16_t *U, *VT, *QX;
  DI void operator()(int row, int col, f32x4 v) const {
    const int cb = __builtin_amdgcn_readfirstlane(col & ~127);
    if (cb < 1024) {
      *(u32x2*)(U + (size_t)row * 1024 + col) = (u32x2){pk2(geluf_(v[0]), geluf_(v[1])), pk2(geluf_(v[2]), geluf_(v[3]))};
    } else if (cb < 2048) {
      const int c = col - 1024, chunk = row >> 7, s = row & 127;
#pragma unroll
      for (int i = 0; i < 4; i++) VT[(((size_t)chunk * 1024 + c + i) << 7) + s] = f2bf(geluf_(v[i]));
    } else {
      *(u32x2*)(QX + (size_t)row * 512 + (col - 2048)) = (u32x2){pk2(v[0], v[1]), pk2(v[2], v[3])};
    }
  }
};
struct EpiPlain {
  static constexpr bool PRELOAD = false;
  bf16_t* R; int ld;
  DI void operator()(int row, int col, f32x4 v) const { *(u32x2*)(R + (size_t)row * ld + col) = (u32x2){pk2(v[0], v[1]), pk2(v[2], v[3])}; }
};
struct EpiC1 {
  static constexpr bool PRELOAD = false;
  bf16_t* R; float* ab; int hfoff;
  DI void operator()(int row, int col, f32x4 v) const {
    const int cb = __builtin_amdgcn_readfirstlane(col & ~127);
    if (cb < 3584) *(u32x2*)(R + (size_t)row * 3584 + col) = (u32x2){pk2(v[0], v[1]), pk2(v[2], v[3])};
    else if (cb == 3584 && col < 3600) *(f32x4*)(ab + (size_t)(((row >> 12) << 13) + hfoff + (row & 4095)) * 16 + (col - 3584)) = v;
  }
};
struct EpiGate {
  static constexpr bool PRELOAD = true;
  bf16_t* Y; const float* __restrict__ ssq; const float* __restrict__ onw; int isC, col0, hfoff;
  DI int tokof(int row) const { return hfoff < 0 ? row : ((row >> 12) << 13) + hfoff + (row & 4095); }
  DI u32x4 pre(int row, int col) const {
    const int tok = tokof(row), yc = col + col0;
    const u32x2 m = *(const u32x2*)(Y + (size_t)tok * 1536 + yc);
    float r = 1.f;
    if (isC && __builtin_amdgcn_readfirstlane(yc & ~127) < 1024) r = rsqrtf(ssq[(size_t)tok * 8 + (yc >> 7)] * (1.f / 128.f) + EPS);
    return (u32x4){m[0], m[1], __float_as_uint(r), 0u};
  }
  DI void fin(int row, int col, f32x4 v, u32x4 pr) const {
    const int tok = tokof(row), yc = col + col0;
    float a0 = lo2f(pr[0]), a1 = hi2f(pr[0]), a2 = lo2f(pr[1]), a3 = hi2f(pr[1]);
    if (isC && __builtin_amdgcn_readfirstlane(yc & ~127) < 1024) {
      const float r = __uint_as_float(pr[2]);
      const f32x4 w = *(const f32x4*)(onw + (yc & 127));
      a0 *= r * w[0]; a1 *= r * w[1]; a2 *= r * w[2]; a3 *= r * w[3];
    }
    *(u32x2*)(Y + (size_t)tok * 1536 + yc) = (u32x2){pk2(a0 * siluf_(v[0]), a1 * siluf_(v[1])), pk2(a2 * siluf_(v[2]), a3 * siluf_(v[3]))};
  }
  DI void operator()(int row, int col, f32x4 v) const { fin(row, col, v, pre(row, col)); }
};
struct EpiOut {
  static constexpr bool PRELOAD = false;
  bf16_t* O;
  DI void operator()(int row, int col, f32x4 v) const { *(u32x2*)(O + (size_t)row * 1024 + col) = (u32x2){pk2(v[0], v[1]), pk2(v[2], v[3])}; }
};

DI void conv_seg(const float* __restrict__ src, int ld, int col0, int ncols, bf16_t* __restrict__ dst, int K, char* smem) {
  const int bx_ = obid(), G_ = ogrid(); (void)bx_; (void)G_;
  src = lp(src);
  dst = lp(dst);
  smem += zoff();
  float* tile = (float*)smem;
  const int tid = otid();
  const int ntj = (ncols + 63) >> 6, ntk = K >> 6;
  for (int t = bx_; t < ntj * ntk; t += G_) {
    const int tj = t % ntj, tk = t / ntj;
    {
      const int jj = tid & 63, k0 = tid >> 6;
      const bool ok = (tj * 64 + jj) < ncols;
#pragma unroll
      for (int i = 0; i < 8; i++) {
        const int kk = k0 + 8 * i;
        tile[kk * 65 + jj] = ok ? src[(size_t)(tk * 64 + kk) * ld + col0 + tj * 64 + jj] : 0.f;
      }
    }
    __syncthreads();
    {
      const int kk2 = (tid & 31) * 2, j2 = tid >> 5;
#pragma unroll
      for (int i = 0; i < 4; i++) {
        const int jj = j2 + 16 * i;
        if (tj * 64 + jj < ncols) *(unsigned*)(dst + (size_t)(tj * 64 + jj) * K + tk * 64 + kk2) = pk2(tile[kk2 * 65 + jj], tile[(kk2 + 1) * 65 + jj]);
      }
    }
    __syncthreads();
  }
}

DI void rmsnorm_rows(const float* __restrict__ x, const float* __restrict__ w, bf16_t* __restrict__ h, int nrows) {
  const int bx_ = obid(), G_ = ogrid(); (void)bx_; (void)G_;
  x = lp(x);
  w = lp(w);
  h = lp(h);
  const int lane = otid() & 63, wid = otid() >> 6;
  f32x4 wv[4];
#pragma unroll
  for (int i = 0; i < 4; i++) wv[i] = *(const f32x4*)(w + i * 256 + lane * 4);
  for (int row = bx_ * 8 + wid; row < nrows; row += G_ * 8) {
    f32x4 v[4]; float ss = 0.f;
#pragma unroll
    for (int i = 0; i < 4; i++) { v[i] = *(const f32x4*)(x + (size_t)row * 1024 + i * 256 + lane * 4); ss += v[i][0] * v[i][0] + v[i][1] * v[i][1] + v[i][2] * v[i][2] + v[i][3] * v[i][3]; }
    ss = wsum(ss);
    const float r = rsqrtf(ss * (1.f / 1024.f) + EPS);
#pragma unroll
    for (int i = 0; i < 4; i++)
      *(u32x2*)(h + (size_t)row * 1024 + i * 256 + lane * 4) = (u32x2){pk2(v[i][0] * r * wv[i][0], v[i][1] * r * wv[i][1]), pk2(v[i][2] * r * wv[i][2], v[i][3] * r * wv[i][3])};
  }
}

DI void norm_phase(const bf16_t* __restrict__ O, const float* xin, float* xout, const float* __restrict__ wpost, const float* __restrict__ wpre, bf16_t* __restrict__ h) {
  const int bx_ = obid(), G_ = ogrid(); (void)bx_; (void)G_;
  O = lp(O);
  xin = lp(xin);
  xout = lp(xout);
  wpost = lp(wpost);
  wpre = lp(wpre);
  h = lp(h);
  const int lane = otid() & 63, wid = otid() >> 6;
  f32x4 wp[4], wq[4];
#pragma unroll
  for (int i = 0; i < 4; i++) { wp[i] = *(const f32x4*)(wpost + i * 256 + lane * 4); wq[i] = wpre ? *(const f32x4*)(wpre + i * 256 + lane * 4) : (f32x4){0.f, 0.f, 0.f, 0.f}; }
  for (int row = bx_ * 8 + wid; row < NTOK; row += G_ * 8) {
    f32x4 o[4], xv[4]; float ss = 0.f;
#pragma unroll
    for (int i = 0; i < 4; i++) {
      { const u32x2 ob = *(const u32x2*)(O + (size_t)row * 1024 + i * 256 + lane * 4); o[i] = (f32x4){lo2f(ob[0]), hi2f(ob[0]), lo2f(ob[1]), hi2f(ob[1])}; }
      xv[i] = *(const f32x4*)(xin + (size_t)row * 1024 + i * 256 + lane * 4);
      ss += o[i][0] * o[i][0] + o[i][1] * o[i][1] + o[i][2] * o[i][2] + o[i][3] * o[i][3];
    }
    ss = wsum(ss);
    const float r = rsqrtf(ss * (1.f / 1024.f) + EPS);
    float s2 = 0.f;
#pragma unroll
    for (int i = 0; i < 4; i++) {
#pragma unroll
      for (int j = 0; j < 4; j++) { xv[i][j] += o[i][j] * r * wp[i][j]; s2 += xv[i][j] * xv[i][j]; }
      *(f32x4*)(xout + (size_t)row * 1024 + i * 256 + lane * 4) = xv[i];
    }
    if (wpre) {
      s2 = wsum(s2);
      const float r2 = rsqrtf(s2 * (1.f / 1024.f) + EPS);
#pragma unroll
      for (int i = 0; i < 4; i++)
        *(u32x2*)(h + (size_t)row * 1024 + i * 256 + lane * 4) = (u32x2){pk2(xv[i][0] * r2 * wq[i][0], xv[i][1] * r2 * wq[i][1]), pk2(xv[i][2] * r2 * wq[i][2], xv[i][3] * r2 * wq[i][3])};
    }
  }
}

DI void attn_phase(const bf16_t* __restrict__ Q, int ldq, int hfoff  , int nrows, const bf16_t* __restrict__ Kimg, const bf16_t* __restrict__ Vimg,
                   bf16_t* __restrict__ mix, int bid, int nb, char* smem) {
  const int bx_ = obid(), G_ = ogrid(); (void)bx_; (void)G_;
  Q = lp(Q);
  Kimg = lp(Kimg);
  Vimg = lp(Vimg);
  mix = lp(mix);
  smem += zoff();
  const int tid = otid(), lane = tid & 63, wid = tid >> 6, fr = lane & 15, fq = lane >> 4;
  const int items = (nrows >> 9) * 4;
  for (int it = bid; it < items; it += nb) {
    const int head = it & 3, span = it >> 2, lrow0 = span * 512;
    const int tokb = hfoff < 0 ? lrow0 : ((lrow0 >> 12) << 13) + hfoff + (lrow0 & 4095);
    const int b = tokb >> 13;
    const u32x4* ksrc = (const u32x4*)(Kimg + (size_t)(b * 4 + head) * 32768);
    const u32x4* vsrc = (const u32x4*)(Vimg + (size_t)(b * 4 + head) * 32768);
#pragma unroll
    for (int i = 0; i < 8; i++) ((u32x4*)smem)[tid + 512 * i] = ksrc[tid + 512 * i];
#pragma unroll
    for (int i = 0; i < 8; i++) ((u32x4*)(smem + 65536))[tid + 512 * i] = vsrc[tid + 512 * i];
    __syncthreads();
    for (int qi = 0; qi < 4; qi++) {
      const int lr = lrow0 + qi * 128 + wid * 16;
      bf16x8 qf[4];
#pragma unroll
      for (int ks = 0; ks < 4; ks++) qf[ks] = *(const bf16x8*)(Q + (size_t)(lr + fr) * ldq + head * 128 + ks * 32 + fq * 8);
      f32x4 st[16];
#pragma unroll
      for (int mt = 0; mt < 16; mt++) {
        f32x4 a = (f32x4){0.f, 0.f, 0.f, 0.f};
#pragma unroll
        for (int ks = 0; ks < 4; ks++) a = mfma16(*(const bf16x8*)(smem + ((mt * 4 + ks) * 64 + lane) * 16), qf[ks], a);
        st[mt] = a;
        if (mt & 1) __builtin_amdgcn_sched_barrier(0);
      }
      float mx = -3.0e38f;
#pragma unroll
      for (int mt = 0; mt < 16; mt++)
#pragma unroll
        for (int i = 0; i < 4; i++) mx = fmaxf(mx, st[mt][i]);
      mx = fmaxf(mx, __shfl_xor(mx, 16)); mx = fmaxf(mx, __shfl_xor(mx, 32));
      const float sc = 0.08838834764831845f * 1.4426950408889634f;
      float sum = 0.f;
#pragma unroll
      for (int mt = 0; mt < 16; mt++)
#pragma unroll
        for (int i = 0; i < 4; i++) { const float pz = __builtin_amdgcn_exp2f((st[mt][i] - mx) * sc); st[mt][i] = pz; sum += pz; }
      sum += __shfl_xor(sum, 16); sum += __shfl_xor(sum, 32);
      bf16x8 pf[8];
#pragma unroll
      for (int kk = 0; kk < 8; kk++) pf[kk] = pack8(st[2 * kk], st[2 * kk + 1]);
      const float inv = 1.f / sum;
      bf16_t* op = mix + (size_t)(tokb + (lr - lrow0) + fr) * 1536 + 1024 + head * 128 + fq * 4;
#pragma unroll
      for (int dt = 0; dt < 8; dt++) {
        f32x4 o = (f32x4){0.f, 0.f, 0.f, 0.f};
#pragma unroll
        for (int kk = 0; kk < 8; kk++) o = mfma16(*(const bf16x8*)(smem + 65536 + ((dt * 8 + kk) * 64 + lane) * 16), pf[kk], o);
        *(u32x2*)(op + dt * 16) = (u32x2){pk2(o[0] * inv, o[1] * inv), pk2(o[2] * inv, o[3] * inv)};
        __builtin_amdgcn_sched_barrier(0);
      }
    }
    __syncthreads();
  }
}

DI void gmlp_phase(const bf16_t* __restrict__ U, const bf16_t* __restrict__ VT, const bf16_t* __restrict__ Wsb, const float* __restrict__ ln_w,
                   const float* __restrict__ ln_b, const float* __restrict__ b_s, bf16_t* __restrict__ mix, char* smem) {
  const int bx_ = obid(), G_ = ogrid(); (void)bx_; (void)G_;
  U = lp(U);
  VT = lp(VT);
  Wsb = lp(Wsb);
  ln_w = lp(ln_w);
  ln_b = lp(ln_b);
  b_s = lp(b_s);
  mix = lp(mix);
  smem += zoff();
  float* red = (float*)smem;
  float* stats = (float*)(smem + 32768);
  for (int chunk = bx_; chunk < 256; chunk += G_) {
    const int tid = otid(), lane = tid & 63, wid = tid >> 6, fr = lane & 15, fq = lane >> 4;
    {
      const int s8 = tid & 15, cgp = tid >> 4;
      float sm[8], sq[8];
#pragma unroll
      for (int j = 0; j < 8; j++) { sm[j] = 0.f; sq[j] = 0.f; }
#pragma unroll 8
      for (int cc = 0; cc < 32; cc++) {
        const u32x4 raw = *(const u32x4*)(VT + (((size_t)chunk * 1024 + cgp * 32 + cc) << 7) + s8 * 8);
        float v[8]; unpack8(raw, v);
#pragma unroll
        for (int j = 0; j < 8; j++) { sm[j] += v[j]; sq[j] += v[j] * v[j]; }
      }
#pragma unroll
      for (int j = 0; j < 8; j++) { red[(cgp * 128 + s8 * 8 + j) * 2] = sm[j]; red[(cgp * 128 + s8 * 8 + j) * 2 + 1] = sq[j]; }
    }
    __syncthreads();
    if (tid < 128) {
      float S = 0.f, Q = 0.f;
      for (int g2 = 0; g2 < 32; g2++) { S += red[(g2 * 128 + tid) * 2]; Q += red[(g2 * 128 + tid) * 2 + 1]; }
      const float mean = S * (1.f / 1024.f), var = Q * (1.f / 1024.f) - mean * mean;
      stats[tid * 2] = mean; stats[tid * 2 + 1] = rsqrtf(fmaxf(var, 0.f) + EPS);
    }
    __syncthreads();
    const int g = wid;
    float lwv[8], lbv[8];
#pragma unroll
    for (int ct = 0; ct < 8; ct++) { lwv[ct] = ln_w[g * 128 + 16 * ct + fr]; lbv[ct] = ln_b[g * 128 + 16 * ct + fr]; }
#pragma unroll
    for (int tq = 0; tq < 4; tq++) {
      f32x4 acc[8][2];
#pragma unroll
      for (int ct = 0; ct < 8; ct++)
#pragma unroll
        for (int tt = 0; tt < 2; tt++) acc[ct][tt] = (f32x4){0.f, 0.f, 0.f, 0.f};
#pragma unroll
      for (int ks = 0; ks < 4; ks++) {
        if (ks <= tq) {
          float mean8[8], rstd8[8];
#pragma unroll
          for (int j = 0; j < 8; j++) { mean8[j] = stats[(32 * ks + 8 * fq + j) * 2]; rstd8[j] = stats[(32 * ks + 8 * fq + j) * 2 + 1]; }
          bf16x8 bfr[2];
#pragma unroll
          for (int tt = 0; tt < 2; tt++) bfr[tt] = *(const bf16x8*)(Wsb + ((size_t)g * 128 + 32 * tq + 16 * tt + fr) * 128 + 32 * ks + 8 * fq);
          u32x4 rawv[8];
#pragma unroll
          for (int ct = 0; ct < 8; ct++) rawv[ct] = *(const u32x4*)(VT + (((size_t)chunk * 1024 + g * 128 + 16 * ct + fr) << 7) + 32 * ks + 8 * fq);
#pragma unroll
          for (int ct = 0; ct < 8; ct++) {
            const float lw = lwv[ct], lb = lbv[ct];
            float v[8]; unpack8(rawv[ct], v);
#pragma unroll
            for (int j = 0; j < 8; j++) v[j] = (v[j] - mean8[j]) * rstd8[j] * lw + lb;
            u32x4 pa; pa[0] = pk2(v[0], v[1]); pa[1] = pk2(v[2], v[3]); pa[2] = pk2(v[4], v[5]); pa[3] = pk2(v[6], v[7]);
            const bf16x8 af = __builtin_bit_cast(bf16x8, pa);
#pragma unroll
            for (int tt = 0; tt < 2; tt++) acc[ct][tt] = mfma16(af, bfr[tt], acc[ct][tt]);
            if (ct & 1) __builtin_amdgcn_sched_barrier(0);
          }
        }
      }
#pragma unroll
      for (int tt = 0; tt < 2; tt++) {
        const int t = 32 * tq + 16 * tt + fr;
        const size_t tok = (size_t)chunk * 128 + t;
        const float bs = b_s[g * 128 + t];
        u32x2 uuv[8];
#pragma unroll
        for (int ct = 0; ct < 8; ct++) uuv[ct] = *(const u32x2*)(U + tok * 1024 + g * 128 + 16 * ct + 4 * fq);
#pragma unroll
        for (int ct = 0; ct < 8; ct++) {
          const int col = g * 128 + 16 * ct + 4 * fq;
          const u32x2 uu = uuv[ct];
          const f32x4 a = acc[ct][tt];
          *(u32x2*)(mix + tok * 1536 + col) = (u32x2){pk2(lo2f(uu[0]) * (a[0] + bs), hi2f(uu[0]) * (a[1] + bs)), pk2(lo2f(uu[1]) * (a[2] + bs), hi2f(uu[1]) * (a[3] + bs))};
        }
      }
      __builtin_amdgcn_sched_barrier(0);
    }
    __syncthreads();
  }
}

DI void sconv_phase(const bf16_t* __restrict__ R, const float* __restrict__ cw, bf16_t* __restrict__ mix) {
  const int bx_ = obid(), G_ = ogrid(); (void)bx_; (void)G_;
  R = lp(R);
  cw = lp(cw);
  mix = lp(mix);
  for (int idx = bx_ * 512 + otid(); idx < NTOK * 128; idx += G_ * 512) {
    const int row = idx >> 7, c = (idx & 127) * 8, s = row & 8191;
    float acc[8];
#pragma unroll
    for (int j = 0; j < 8; j++) acc[j] = 0.f;
#pragma unroll
    for (int k = 0; k < 3; k++) {
      if (s - 2 + k >= 0) {
        const size_t r2 = (size_t)(row - 2 + k);
        float a[8], b[8]; unpack8(*(const u32x4*)(R + r2 * 3584 + 1024 + c), a); unpack8(*(const u32x4*)(R + r2 * 3584 + 2048 + c), b);
        const f32x4 w0 = *(const f32x4*)(cw + k * 1024 + c), w1 = *(const f32x4*)(cw + k * 1024 + c + 4);
#pragma unroll
        for (int j = 0; j < 4; j++) { acc[j] += w0[j] * a[j] * b[j]; acc[4 + j] += w1[j] * a[4 + j] * b[4 + j]; }
      }
    }
    float g[8]; unpack8(*(const u32x4*)(R + (size_t)row * 3584 + c), g);
    u32x4 o;
#pragma unroll
    for (int j = 0; j < 4; j++) o[j] = pk2(g[2 * j] * acc[2 * j], g[2 * j + 1] * acc[2 * j + 1]);
    *(u32x4*)(mix + (size_t)row * 1536 + c) = o;
  }
}

constexpr int P_SET = 1024 + 3 * 17408;
constexpr int P_AF = 0, P_SET0 = 16384, P_WB = P_SET0 + 2 * P_SET, P_QK = P_WB + 17408, P_END = P_QK + 9216;
constexpr int P_WL = P_END;
constexpr int XST_OFF = P_END + 2 * 6144;
static_assert(XST_OFF + 64 <= LDS_BYTES, "prep lds");

DI void prep_loadw(const float* __restrict__ cw, int ci, float* wl, int t0, int nth) {
  const int hh = (ci >> 6) & 7;
  for (int i = t0; i < 384; i += nth) {
    const int sec = i >> 7, kk = (i >> 5) & 3, c4 = i & 31;
    *(f32x4*)(wl + i * 4) = *(const f32x4*)(cw + (size_t)kk * 3072 + sec * 1024 + hh * 128 + c4 * 4);
  }
}
DI void prep_conv(const bf16_t* __restrict__ R, const float* __restrict__ ab, const float* wl, const float* __restrict__ a_log,
                  const float* __restrict__ dt_bias, float* __restrict__ glbuf, bf16_t* __restrict__ stash, int half, int ci, char* sb, int t0, int nth) {
  float* gc = (float*)sb; float* be = gc + 64; float* eg = gc + 128; float* ek = gc + 192;
  bf16_t* Kb = (bf16_t*)(sb + 1024); bf16_t* Qb = Kb + 64 * 136; bf16_t* Vb = Qb + 64 * 136;
  const int bl = ci >> 9, hh = (ci >> 6) & 7, n = ci & 63;
  const int tokg = bl * 8192 + half * 4096 + n * 64;
  if (t0 < 64) {
    const int lane = t0;
    const float a = ab[(size_t)(tokg + lane) * 16 + hh], bb = ab[(size_t)(tokg + lane) * 16 + 8 + hh];
    const float xs = a + dt_bias[hh];
    const float sp = xs > 20.f ? xs : log1pf(__expf(xs));
    float g = -__expf(a_log[hh]) * sp;
#pragma unroll
    for (int o = 1; o < 64; o <<= 1) { const float t = __shfl_up(g, o); if (lane >= o) g += t; }
    const float gl = __shfl(g, 63);
    gc[lane] = g; be[lane] = sigmoidf_(bb); eg[lane] = __expf(g); ek[lane] = __expf(gl - g);
    if (lane == 63) glbuf[ci] = __expf(gl);
  }
  for (int idx = t0; idx < 512; idx += nth) {
    const int t = idx >> 3, sub = idx & 7;
    u32x4 raw[3][4][2];
#pragma unroll
    for (int sec = 0; sec < 3; sec++)
#pragma unroll
      for (int kk = 0; kk < 4; kk++) {
        const int sl = n * 64 + t - 3 + kk;
        if (sl >= 0 || half == 1) {
          const bf16_t* src = sl >= 0 ? R + (size_t)(bl * 4096 + sl) * 3584 + sec * 1024 + hh * 128 + sub * 16
                                      : stash + (size_t)((bl * 8 + hh) * 3 + (sl + 3)) * 384 + sec * 128 + sub * 16;
          raw[sec][kk][0] = *(const u32x4*)src; raw[sec][kk][1] = *(const u32x4*)(src + 8);
        } else {
          raw[sec][kk][0] = (u32x4){0u, 0u, 0u, 0u}; raw[sec][kk][1] = (u32x4){0u, 0u, 0u, 0u};
        }
      }
#pragma unroll
    for (int sec = 0; sec < 3; sec++) {
      float acc[16];
#pragma unroll
      for (int j = 0; j < 16; j++) acc[j] = 0.f;
#pragma unroll
      for (int kk = 0; kk < 4; kk++) {
        float xv[16]; unpack8(raw[sec][kk][0], xv); unpack8(raw[sec][kk][1], xv + 8);
#pragma unroll
        for (int q4 = 0; q4 < 4; q4++) {
          const f32x4 w = *(const f32x4*)(wl + (sec * 4 + kk) * 128 + sub * 16 + q4 * 4);
#pragma unroll
          for (int j = 0; j < 4; j++) acc[q4 * 4 + j] += w[j] * xv[q4 * 4 + j];
        }
      }
      float ss = 0.f;
#pragma unroll
      for (int j = 0; j < 16; j++) { acc[j] = siluf_(acc[j]); ss += acc[j] * acc[j]; }
      float scale = 1.f;
      if (sec < 2) {
        ss += __shfl_xor(ss, 1); ss += __shfl_xor(ss, 2); ss += __shfl_xor(ss, 4);
        scale = rsqrtf(ss + EPS) * (sec == 0 ? 0.08838834764831845f : 1.f);
      }
      bf16_t* dst = (sec == 0 ? Qb : (sec == 1 ? Kb : Vb)) + t * 136 + sub * 16;
      u32x4 p0, p1;
#pragma unroll
      for (int j = 0; j < 4; j++) { p0[j] = pk2(acc[2 * j] * scale, acc[2 * j + 1] * scale); p1[j] = pk2(acc[8 + 2 * j] * scale, acc[9 + 2 * j] * scale); }
      *(u32x4*)dst = p0; *(u32x4*)(dst + 8) = p1;
    }
    __builtin_amdgcn_sched_barrier(0);
  }
  if (half == 0 && n == 63 && t0 < 144) {
    const int r = t0 / 48, piece = t0 % 48, sec = piece >> 4, c16 = piece & 15;
    *(u32x4*)(stash + (size_t)((bl * 8 + hh) * 3 + r) * 384 + sec * 128 + c16 * 8) =
        *(const u32x4*)(R + (size_t)(bl * 4096 + 4093 + r) * 3584 + sec * 1024 + hh * 128 + c16 * 8);
  }
}

#define LDS_BAR() do { asm volatile("s_waitcnt lgkmcnt(0)" ::: "memory"); __builtin_amdgcn_s_barrier(); asm volatile("" ::: "memory"); } while (0)

DI void prep_phase(const bf16_t* __restrict__ R, const float* __restrict__ ab, const float* __restrict__ cw, const float* __restrict__ a_log,
                   const float* __restrict__ dt_bias, char* __restrict__ ops, float* __restrict__ glbuf, bf16_t* __restrict__ stash, int half, char* smem) {
  const int bx_ = obid(), G_ = ogrid(); (void)bx_; (void)G_;
  R = lp(R);
  ab = lp(ab);
  cw = lp(cw);
  a_log = lp(a_log);
  dt_bias = lp(dt_bias);
  ops = lp(ops);
  glbuf = lp(glbuf);
  stash = lp(stash);
  smem += zoff();
  float* Af = (float*)(smem + P_AF); bf16_t* Wb = (bf16_t*)(smem + P_WB); bf16_t* QKb = (bf16_t*)(smem + P_QK);
  float* WL = (float*)(smem + P_WL);
  if (bx_ < 2048) prep_loadw(cw, bx_, WL, otid(), 512);
  LDS_BAR();
  int k = -1;
  for (int ci = bx_ - G_; ci < 2048; ci += G_, k++) {
    const bool live = ci >= 0;
    const int tid = otid(), lane = tid & 63, wid = tid >> 6, fr = lane & 15, fq = lane >> 4;
    char* sb = smem + P_SET0 + (k & 1) * P_SET;
    const float* gc = (const float*)sb; const float* be = gc + 64; const float* eg = gc + 128; const float* ek = gc + 192;
    const bf16_t* Kb = (const bf16_t*)(sb + 1024); const bf16_t* Qb = Kb + 64 * 136; const bf16_t* Vb = Qb + 64 * 136;
    char* op = ops + (size_t)ci * OPS_STRIDE;
    if (live) {
      const int it = wid & 3, which = wid >> 2;
      const bf16_t* X = which ? Qb : Kb;
      bf16x8 af[4];
#pragma unroll
      for (int ks = 0; ks < 4; ks++) af[ks] = *(const bf16x8*)(X + (16 * it + fr) * 136 + 32 * ks + 8 * fq);
#pragma unroll
      for (int jt = 0; jt < 4; jt++) {
        f32x4 a = (f32x4){0.f, 0.f, 0.f, 0.f};
#pragma unroll
        for (int ks = 0; ks < 4; ks++) a = mfma16(af[ks], *(const bf16x8*)(Kb + (16 * jt + fr) * 136 + 32 * ks + 8 * fq), a);
        const int j = 16 * jt + fr;
        const float gj = gc[j];
#pragma unroll
        for (int ii = 0; ii < 4; ii++) {
          const int i = 16 * it + 4 * fq + ii;
          const float dec = __expf(fminf(gc[i] - gj, 0.f));
          if (which == 0) Af[i * 64 + j] = (j < i) ? be[i] * a[ii] * dec : 0.f;
          else QKb[i * 72 + j] = f2bf((j <= i) ? a[ii] * dec : 0.f);
        }
      }
    }
    LDS_BAR();
    if (tid < 256) {
      if (live) {
      const int col = tid;
      float Uv[64];
      const bool isv = col < 128;
      const bf16_t* xs = isv ? (Vb + col) : (Kb + (col - 128));
#pragma unroll
      for (int i = 0; i < 64; i++) { Uv[i] = bf2f(xs[i * 136]) * (be[i] * (isv ? 1.f : eg[i])); asm volatile("" : "+v"(Uv[i])); }
      __builtin_amdgcn_sched_barrier(0);
      f32x4 ac[16], an[16];
      ac[0] = *(const f32x4*)(Af + 1 * 64);
#pragma unroll
      for (int i = 1; i < 64; i++) {
        if (i + 1 < 64) {
#pragma unroll
          for (int j4 = 0; j4 < (i + 1 + 3) / 4; j4++) an[j4] = *(const f32x4*)(Af + (i + 1) * 64 + j4 * 4);
        }
        __builtin_amdgcn_sched_barrier(0);
        float xv = Uv[i], xw = 0.f, xy = 0.f, xz = 0.f;
#pragma unroll
        for (int j4 = 0; j4 < (i + 3) / 4; j4++) {
          const f32x4 a = ac[j4];
          if (j4 * 4 + 0 < i) xv -= a[0] * Uv[j4 * 4 + 0];
          if (j4 * 4 + 1 < i) xw -= a[1] * Uv[j4 * 4 + 1];
          if (j4 * 4 + 2 < i) xy -= a[2] * Uv[j4 * 4 + 2];
          if (j4 * 4 + 3 < i) xz -= a[3] * Uv[j4 * 4 + 3];
        }
        Uv[i] = (xv + xw) + (xy + xz);
        __builtin_amdgcn_sched_barrier(0);
        if (i + 1 < 64) {
#pragma unroll
          for (int j4 = 0; j4 < (i + 1 + 3) / 4; j4++) ac[j4] = an[j4];
        }
      }
      if (col < 128) {
        const int w8 = col >> 4, lo = col & 15;
#pragma unroll
        for (int ct = 0; ct < 4; ct++)
#pragma unroll
          for (int jq = 0; jq < 4; jq++)
            *(u32x2*)(op + 57344 + (((w8 * 4 + ct) * 64 + jq * 16 + lo) * 8)) = (u32x2){pk2(Uv[16 * ct + 4 * jq], Uv[16 * ct + 4 * jq + 1]), pk2(Uv[16 * ct + 4 * jq + 2], Uv[16 * ct + 4 * jq + 3])};
      } else {
#pragma unroll
        for (int i = 0; i < 64; i++) Wb[i * 136 + col - 128] = f2bf(Uv[i]);
      }
      }
    } else {
      const int t2 = tid - 256;
      if (live) {
#pragma unroll
      for (int i = 0; i < 4; i++) {
        const int idx = t2 + 256 * i, frag = idx >> 6, ln = idx & 63, ct = frag >> 2, m = frag & 3, r = ln & 15, jq = ln >> 4;
        const int c = 16 * ct + r, d0 = 32 * m + 4 * jq;
        const u32x2 lo = *(const u32x2*)(Qb + c * 136 + d0), hi = *(const u32x2*)(Qb + c * 136 + d0 + 16);
        const float e = eg[c];
        *(u32x4*)(op + 16384 + idx * 16) = (u32x4){pk2(lo2f(lo[0]) * e, hi2f(lo[0]) * e), pk2(lo2f(lo[1]) * e, hi2f(lo[1]) * e), pk2(lo2f(hi[0]) * e, hi2f(hi[0]) * e), pk2(lo2f(hi[1]) * e, hi2f(hi[1]) * e)};
      }
#pragma unroll
      for (int i = 0; i < 4; i++) {
        const int idx = t2 + 256 * i, frag = idx >> 6, ln = idx & 63, dt = frag >> 1, kk = frag & 1, r = ln & 15, jq = ln >> 4;
        const int d = 16 * dt + r;
        float v[8];
#pragma unroll
        for (int j = 0; j < 8; j++) { const int c = 32 * kk + 16 * (j >> 2) + 4 * jq + (j & 3); v[j] = bf2f(Kb[c * 136 + d]) * ek[c]; }
        *(u32x4*)(op + 40960 + idx * 16) = (u32x4){pk2(v[0], v[1]), pk2(v[2], v[3]), pk2(v[4], v[5]), pk2(v[6], v[7])};
      }
#pragma unroll
      for (int i = 0; i < 2; i++) {
        const int idx = t2 + 256 * i, frag = idx >> 6, ln = idx & 63, ct = frag >> 1, kk = frag & 1, r = ln & 15, jq = ln >> 4;
        const int row = 16 * ct + r, c0 = 32 * kk + 4 * jq;
        const u32x2 lo = *(const u32x2*)(QKb + row * 72 + c0), hi = *(const u32x2*)(QKb + row * 72 + c0 + 16);
        *(u32x4*)(op + 32768 + idx * 16) = (u32x4){lo[0], lo[1], hi[0], hi[1]};
      }
      }
      if (ci + G_ < 2048) prep_conv(R, ab, WL + ((k + 1) & 1) * 1536, a_log, dt_bias, glbuf, stash, half, ci + G_, smem + P_SET0 + ((k + 1) & 1) * P_SET, t2, 256);
      if (ci + 2 * G_ < 2048) prep_loadw(cw, ci + 2 * G_, WL + (k & 1) * 1536, t2, 256);
    }
    LDS_BAR();
    if (live)
#pragma unroll
    for (int i = 0; i < 2; i++) {
      const int idx = tid + 512 * i, frag = idx >> 6, ln = idx & 63, ct = frag >> 2, m = frag & 3, r = ln & 15, jq = ln >> 4;
      const int c = 16 * ct + r, d0 = 32 * m + 4 * jq;
      const u32x2 lo = *(const u32x2*)(Wb + c * 136 + d0), hi = *(const u32x2*)(Wb + c * 136 + d0 + 16);
      *(u32x4*)(op + idx * 16) = (u32x4){lo[0], lo[1], hi[0], hi[1]};
    }
  }
  LDS_BAR();
}

DI void scan_block(const char* __restrict__ ops, const float* __restrict__ glbuf, bf16_t* __restrict__ mix, float* __restrict__ ssq,
                   f32x4* __restrict__ stbuf, int half, char* smem) {
  const int bx_ = obid(), G_ = ogrid(); (void)bx_; (void)G_;
  ops = lp(ops);
  glbuf = lp(glbuf);
  mix = lp(mix);
  ssq = lp(ssq);
  stbuf = lp(stbuf);
  smem += zoff();
  const int tid = otid(), lane = tid & 63, w = tid >> 6, fr = lane & 15, fq = lane >> 4;
  const bool comp = w < 4;
  const int blk = bx_, bl = blk >> 3, hh = blk & 7;
  const int chunk0 = (bl * 8 + hh) * 64;
  const int tokbase = bl * 8192 + half * 4096;
  const char* cp = ops + (size_t)chunk0 * OPS_STRIDE;
  float* part = (float*)(smem + 114688);
#pragma unroll
  for (int i = 0; i < 7; i++) ((u32x4*)smem)[tid + 512 * i] = ((const u32x4*)cp)[tid + 512 * i];
  __syncthreads();
  if (!comp) {
    const int t2 = tid - 256;
    u32x4 sx[14], sy[14];
    {
      const u32x4* np = (const u32x4*)(cp + (size_t)1 * OPS_STRIDE);
#pragma unroll
      for (int i = 0; i < 14; i++) sy[i] = np[t2 + 256 * i];
    }
    for (int n = 0; n < 64; n += 2) {
      if (n + 2 < 64) {
        const u32x4* np = (const u32x4*)(cp + (size_t)(n + 2) * OPS_STRIDE);
#pragma unroll
        for (int i = 0; i < 14; i++) sx[i] = np[t2 + 256 * i];
      }
      {
        u32x4* nb = (u32x4*)(smem + 57344);
#pragma unroll
        for (int i = 0; i < 14; i++) nb[t2 + 256 * i] = sy[i];
      }
      asm volatile("s_waitcnt lgkmcnt(0)" ::: "memory");
      __builtin_amdgcn_s_barrier();
      asm volatile("" ::: "memory");
      if (n + 3 < 64) {
        const u32x4* np = (const u32x4*)(cp + (size_t)(n + 3) * OPS_STRIDE);
#pragma unroll
        for (int i = 0; i < 14; i++) sy[i] = np[t2 + 256 * i];
      }
      if (n + 2 < 64) {
        u32x4* nb = (u32x4*)smem;
#pragma unroll
        for (int i = 0; i < 14; i++) nb[t2 + 256 * i] = sx[i];
      }
      asm volatile("s_waitcnt lgkmcnt(0)" ::: "memory");
      __builtin_amdgcn_s_barrier();
      asm volatile("" ::: "memory");
    }
  } else {
    f32x4* stp = stbuf + ((size_t)(blk * 4 + w) * 16) * 64 + lane;
    f32x4 S[8][2]; bf16x8 sB[4][2];
#pragma unroll
    for (int i = 0; i < 8; i++)
#pragma unroll
      for (int nt = 0; nt < 2; nt++) S[i][nt] = half ? stp[(i * 2 + nt) * 64] : (f32x4){0.f, 0.f, 0.f, 0.f};
#pragma unroll
    for (int m = 0; m < 4; m++)
#pragma unroll
      for (int nt = 0; nt < 2; nt++) sB[m][nt] = pack8(S[2 * m][nt], S[2 * m + 1][nt]);
    u32x2 uf[4][2];
#pragma unroll
    for (int ct = 0; ct < 4; ct++)
#pragma unroll
      for (int nt = 0; nt < 2; nt++) uf[ct][nt] = *(const u32x2*)(cp + 57344 + (((2 * w + nt) * 4 + ct) * 64 + lane) * 8);
    float gl = glbuf[chunk0];
    for (int n = 0; n < 64; n++) {
      const char* buf = smem + (n & 1) * 57344;
      if (n > 0 && lane < 16) {
        const float* pp = part + ((n - 1) & 1) * 256 + 16 * w + lane;
        ssq[(size_t)(tokbase + (n - 1) * 64 + 16 * w + lane) * 8 + hh] = pp[0] + pp[64] + pp[128] + pp[192];
      }
      bf16x8 vB[2][2];
      {
        f32x4 vn[4][2];
#pragma unroll
        for (int ct = 0; ct < 4; ct++) {
          f32x4 t0 = (f32x4){0.f, 0.f, 0.f, 0.f}, t1 = t0;
#pragma unroll
          for (int m = 0; m < 4; m++) {
            const bf16x8 a = *(const bf16x8*)(buf + ((ct * 4 + m) * 64 + lane) * 16);
            t0 = mfma16(a, sB[m][0], t0); t1 = mfma16(a, sB[m][1], t1);
          }
          vn[ct][0] = (f32x4){lo2f(uf[ct][0][0]) - t0[0], hi2f(uf[ct][0][0]) - t0[1], lo2f(uf[ct][0][1]) - t0[2], hi2f(uf[ct][0][1]) - t0[3]};
          vn[ct][1] = (f32x4){lo2f(uf[ct][1][0]) - t1[0], hi2f(uf[ct][1][0]) - t1[1], lo2f(uf[ct][1][1]) - t1[2], hi2f(uf[ct][1][1]) - t1[3]};
        }
#pragma unroll
        for (int kk = 0; kk < 2; kk++)
#pragma unroll
          for (int nt = 0; nt < 2; nt++) vB[kk][nt] = pack8(vn[2 * kk][nt], vn[2 * kk + 1][nt]);
      }
      const float glc = gl;
      if (n + 1 < 64) {
        const char* np = cp + (size_t)(n + 1) * OPS_STRIDE;
#pragma unroll
        for (int ct = 0; ct < 4; ct++)
#pragma unroll
          for (int nt = 0; nt < 2; nt++) uf[ct][nt] = *(const u32x2*)(np + 57344 + (((2 * w + nt) * 4 + ct) * 64 + lane) * 8);
        gl = glbuf[chunk0 + n + 1];
      }
      __builtin_amdgcn_sched_barrier(0);
      float v[16];
      {
        bf16_t* mp = mix + (size_t)(tokbase + n * 64) * 1536 + hh * 128 + 32 * w + fr;
#pragma unroll
        for (int ct = 0; ct < 4; ct++) {
          f32x4 t0 = (f32x4){0.f, 0.f, 0.f, 0.f}, t1 = t0;
#pragma unroll
          for (int m = 0; m < 4; m++) {
            const bf16x8 a = *(const bf16x8*)(buf + 16384 + ((ct * 4 + m) * 64 + lane) * 16);
            t0 = mfma16(a, sB[m][0], t0); t1 = mfma16(a, sB[m][1], t1);
          }
#pragma unroll
          for (int kk = 0; kk < 2; kk++) {
            const bf16x8 a = *(const bf16x8*)(buf + 32768 + ((ct * 2 + kk) * 64 + lane) * 16);
            t0 = mfma16(a, vB[kk][0], t0); t1 = mfma16(a, vB[kk][1], t1);
          }
#pragma unroll
          for (int ii = 0; ii < 4; ii++) {
            const bf16_t b0 = f2bf(t0[ii]), b1 = f2bf(t1[ii]);
            bf16_t* rp = mp + (size_t)(16 * ct + 4 * fq + ii) * 1536;
            rp[0] = b0; rp[16] = b1;
            const float f0 = bf2f(b0), f1 = bf2f(b1);
            v[ct * 4 + ii] = f0 * f0 + f1 * f1;
          }
        }
      }
      __builtin_amdgcn_sched_barrier(0);
#pragma unroll
      for (int dt = 0; dt < 8; dt++) {
        f32x4 t0 = S[dt][0] * glc, t1 = S[dt][1] * glc;
#pragma unroll
        for (int kk = 0; kk < 2; kk++) {
          const bf16x8 a = *(const bf16x8*)(buf + 40960 + ((dt * 2 + kk) * 64 + lane) * 16);
          t0 = mfma16(a, vB[kk][0], t0); t1 = mfma16(a, vB[kk][1], t1);
        }
        S[dt][0] = t0; S[dt][1] = t1;
      }
#pragma unroll
      for (int m = 0; m < 4; m++)
#pragma unroll
        for (int nt = 0; nt < 2; nt++) sB[m][nt] = pack8(S[2 * m][nt], S[2 * m + 1][nt]);
      __builtin_amdgcn_sched_barrier(0);
#pragma unroll
      for (int st = 8; st >= 1; st >>= 1) {
        const bool hiL = (fr & st) != 0;
#pragma unroll
        for (int k = 0; k < st; k++) {
          const float keep = hiL ? v[k + st] : v[k];
          const float send = hiL ? v[k] : v[k + st];
          v[k] = keep + __shfl_xor(send, st);
        }
      }
      part[(n & 1) * 256 + w * 64 + 16 * (fr >> 2) + 4 * fq + (fr & 3)] = v[0];
      asm volatile("s_waitcnt lgkmcnt(0)" ::: "memory");
      __builtin_amdgcn_s_barrier();
      asm volatile("" ::: "memory");
    }
    if (lane < 16) {
      const float* pp = part + (63 & 1) * 256 + 16 * w + lane;
      ssq[(size_t)(tokbase + 63 * 64 + 16 * w + lane) * 8 + hh] = pp[0] + pp[64] + pp[128] + pp[192];
    }
    if (half == 0) {
#pragma unroll
      for (int i = 0; i < 8; i++)
#pragma unroll
        for (int nt = 0; nt < 2; nt++) stp[(i * 2 + nt) * 64] = S[i][nt];
    }
  }
  __syncthreads();
}

#define XB_TMO      128
#define XB_XCNT(j)  (256  + 64 * (j))
#define XB_XSUB(j)  (1280 + 64 * (j))
#define XB_XGEN(j)  (2304 + 64 * (j))
#define XB_TOP      3328
#define XB_TOPGEN   3392
#define XCD_BAR_WORDS 3456
#define XB_SPIN_CAP (1u << 18)

__device__ __forceinline__ unsigned xb_ld(unsigned* p)              { return __hip_atomic_load(p, __ATOMIC_RELAXED, __HIP_MEMORY_SCOPE_AGENT); }
__device__ __forceinline__ unsigned xb_add(unsigned* p, unsigned v) { return __hip_atomic_fetch_add(p, v, __ATOMIC_RELAXED, __HIP_MEMORY_SCOPE_AGENT); }
__device__ __forceinline__ unsigned xb_xcc_id() { return (unsigned)__builtin_amdgcn_s_getreg((3 << 11) | 20) & 0xFu; }
#define XB_SPIN(cond, bar) do { unsigned _sp = 0; while (cond) { __builtin_amdgcn_s_sleep(1); \
    if ((++_sp & 255u) == 0u) { if (xb_ld(&(bar)[XB_TMO])) break; if (_sp > XB_SPIN_CAP) { atomicAdd(&(bar)[XB_TMO], 1u); break; } } } } while (0)

struct XcdBarrier {
    unsigned* bar; unsigned x;
    volatile LAS unsigned* st;
};

__device__ __forceinline__ XcdBarrier xcd_barrier_post(unsigned* bar, volatile LAS unsigned* st) {
    XcdBarrier b; b.bar = bar; b.x = xb_xcc_id(); b.st = st;
    if (threadIdx.x == 0) (void)xb_add(&bar[XB_XCNT(b.x)], 1u);
    return b;
}
__device__ __forceinline__ void xcd_barrier_complete(unsigned* bar, unsigned x, unsigned& nloc, unsigned& nx) {
    const unsigned G = gridDim.x * gridDim.y * gridDim.z;
    unsigned sum, cnt, mine, sp = 0u;
    for (;;) {
        sum = 0u; cnt = 0u; mine = 0u;
#pragma unroll
        for (unsigned j = 0; j < 16; ++j) { const unsigned c = xb_ld(&bar[XB_XCNT(j)]); sum += c; cnt += (c > 0u) ? 1u : 0u; mine = (j == x) ? c : mine; }
        if (sum == G) break;
        __builtin_amdgcn_s_sleep(1);
        if ((++sp & 255u) == 0u) { if (xb_ld(&bar[XB_TMO])) break; if (sp > XB_SPIN_CAP) { atomicAdd(&bar[XB_TMO], 1u); break; } }
    }
    nloc = mine > 0u ? mine : 1u; nx = cnt > 0u ? cnt : 1u;
}

__device__ __forceinline__ void xcd_barrier(const XcdBarrier& b) {
    asm volatile("s_waitcnt vmcnt(0)" ::: "memory");
    __syncthreads();
    if (threadIdx.x == 0) {
        unsigned* bar = b.bar;
        __builtin_amdgcn_s_waitcnt(0);
        unsigned nloc = b.st[0], nx = b.st[1];
        if (nloc == 0u) { xcd_barrier_complete(bar, b.x, nloc, nx); b.st[0] = nloc; b.st[1] = nx; }
        const unsigned old = xb_add(&bar[XB_XSUB(b.x)], 1u);
        const unsigned gen = old / nloc;
        if (old + 1u == (gen + 1u) * nloc) {
            __builtin_amdgcn_fence(__ATOMIC_RELEASE, "agent");
            asm volatile("s_waitcnt vmcnt(0)" ::: "memory");
            const unsigned og = xb_add(&bar[XB_TOP], 1u);
            const unsigned tg = og / nx;
            if (og + 1u == (tg + 1u) * nx) xb_add(&bar[XB_TOPGEN], 1u);
            else XB_SPIN(xb_ld(&bar[XB_TOPGEN]) == tg, bar);
            __builtin_amdgcn_fence(__ATOMIC_ACQUIRE, "agent");
            xb_add(&bar[XB_XGEN(b.x)], 1u);
            asm volatile("s_waitcnt vmcnt(0)" ::: "memory");
        } else {
            XB_SPIN(xb_ld(&bar[XB_XGEN(b.x)]) == gen, bar);
            __builtin_amdgcn_fence(__ATOMIC_ACQUIRE, "agent");
            asm volatile("s_waitcnt vmcnt(0)" ::: "memory");
        }
    }
    __syncthreads();
}

constexpr int PRM_NPRE = 0, PRM_NPOST = 4096, PRM_ALNW = 8192, PRM_ALNB = 10240, PRM_ABS = 12288, PRM_BCW = 14336, PRM_CCW = 17408, PRM_CALOG = 29696, PRM_CDT = 29704, PRM_CONW = 29712;
#define WS_PTRS(ws) \
  const float* PRM = (const float*)(ws + OFF_PRM); \
  bf16_t* W2 = (bf16_t*)(ws + OFF_W2); \
  bf16_t* WO = (bf16_t*)(ws + OFF_WO); \
  bf16_t* WM = (bf16_t*)(ws + OFF_WM); \
  bf16_t* WS = (bf16_t*)(ws + OFF_WS); \
  bf16_t* HMEM = (bf16_t*)(ws + OFF_HMEM); \
  bf16_t* KIMG = (bf16_t*)(ws + OFF_KIMG); \
  bf16_t* VIMG = (bf16_t*)(ws + OFF_VIMG); \
  float* AB = (float*)(ws + OFF_AB); \
  float* SSQ = (float*)(ws + OFF_SSQ); \
  float* GL = (float*)(ws + OFF_GL); \
  f32x4* STB = (f32x4*)(ws + OFF_ST); \
  bf16_t* STASH = (bf16_t*)(ws + OFF_STASH); \
  bf16_t* H = (bf16_t*)(ws + OFF_H); \
  bf16_t* MIX = (bf16_t*)(ws + OFF_MIX); \
  char* BIG = ws + OFF_BIG;
__global__ void __launch_bounds__(512) mega_kernel(Params p) {
  __shared__ __attribute__((aligned(16))) char smem[LDS_BYTES];
  cg::grid_group grid = cg::this_grid();
  char* ws0 = p.ws;
  volatile LAS unsigned* xst = (volatile LAS unsigned*)(LAS unsigned char*)(smem + XST_OFF);
  if (threadIdx.x < 2) xst[threadIdx.x] = 0u;
  __syncthreads();
  const XcdBarrier xb = xcd_barrier_post((unsigned*)(ws0 + OFF_BAR), xst);

  {
  char* ws = lp(ws0);
  WS_PTRS(ws)
  conv_seg(p.a_w_in, 4096, 0, 2560, (bf16_t*)(ws + OFF_W1_0), 1024, smem);
  conv_seg(p.a_w_in, 4096, 2560, 1536, W2, 1024, smem);
  conv_seg(p.a_w_in + 1024 * 4096, 4096, 0, 2560, (bf16_t*)(ws + OFF_W1_3), 1024, smem);
  conv_seg(p.a_w_in + 1024 * 4096, 4096, 2560, 1536, W2 + 3 * 1536 * 1024, 1024, smem);
  conv_seg(p.b_w_in, 5120, 0, 3584, (bf16_t*)(ws + OFF_W1_1), 1024, smem);
  conv_seg(p.b_w_in, 5120, 3584, 1536, W2 + 1 * 1536 * 1024, 1024, smem);
  conv_seg(p.c_w_in, 5136, 0, 3072, ((bf16_t*)(ws + OFF_W1_2)), 1024, smem);
  conv_seg(p.c_w_in, 5136, 3088, 512, ((bf16_t*)(ws + OFF_W1_2)) + 3072 * 1024, 1024, smem);
  conv_seg(p.c_w_in, 5136, 3072, 16, ((bf16_t*)(ws + OFF_W1_2)) + 3584 * 1024, 1024, smem);
  conv_seg(p.c_w_in, 5136, 3600, 1536, W2 + 2 * 1536 * 1024, 1024, smem);
  for (int l = 0; l < 4; l++) conv_seg(p.w_out + (size_t)l * 1536 * 1024, 1024, 0, 1024, WO + (size_t)l * 1024 * 1536, 1536, smem);
  conv_seg(p.w_mem_kv, 1024, 0, 1024, WM, 1024, smem);
  for (int i = blockIdx.x * 512 + otid(); i < 240 * 1024 / 2; i += gridDim.x * 512) ((unsigned*)(((bf16_t*)(ws + OFF_W1_2)) + 3600 * 1024))[i] = 0u;
  for (int i = blockIdx.x * 512 + otid(); i < 2 * 8 * 128 * 128; i += gridDim.x * 512) {
    const int s = i & 127, t = (i >> 7) & 127;
    WS[i] = (s <= t) ? f2bf(p.a_w_s[i]) : (bf16_t)0;
  }
  {
    float* prm = (float*)(ws + OFF_PRM);
    const int gt = blockIdx.x * 512 + otid(), gs = gridDim.x * 512;
    for (int i = gt; i < 4096; i += gs) { prm[PRM_NPRE + i] = p.norm_pre[i]; prm[PRM_NPOST + i] = p.norm_post[i]; }
    for (int i = gt; i < 2048; i += gs) { prm[PRM_ALNW + i] = p.a_ln_w[i]; prm[PRM_ALNB + i] = p.a_ln_b[i]; prm[PRM_ABS + i] = p.a_b_s[i]; }
    for (int i = gt; i < 3072; i += gs) prm[PRM_BCW + i] = p.b_conv_w[i];
    for (int i = gt; i < 12288; i += gs) prm[PRM_CCW + i] = p.c_conv_w[i];
    for (int i = gt; i < 8; i += gs) { prm[PRM_CALOG + i] = p.c_a_log[i]; prm[PRM_CDT + i] = p.c_dt_bias[i]; }
    for (int i = gt; i < 128; i += gs) prm[PRM_CONW + i] = p.c_o_norm_w[i];
  }
  rmsnorm_rows(p.x, p.norm_pre, H, NTOK);
  rmsnorm_rows(p.mem, p.mem_norm_w, HMEM, 1024);
  }
  grid.sync();

  for (int ph = 0; ph < 23; ph++) {
    char* ws = lp(ws0);
    WS_PTRS(ws)
    int l, q;
    if (ph < 5) { l = 0; q = ph; } else if (ph < 10) { l = 1; q = ph - 5; } else if (ph < 18) { l = 2; q = ph - 10; } else { l = 3; q = ph - 18; }
    const int kind = l % 3;
    int op, hf = 0;
    if (kind == 2) { op = q == 0 ? 0 : q == 1 ? 1 : q == 2 ? 6 : q == 3 ? 1 : q == 4 ? 7 : q == 5 ? 8 : q == 6 ? 4 : 5; hf = q >= 3 ? 1 : 0; }
    else op = q == 0 ? 0 : (q == 1 ? 2 : q + 1);
    const int bx = blockIdx.x, G = gridDim.x;
    const bool scanblk = (op == 6 || op == 7) && bx < 32;
    if (op == 0 || (op == 6 && !scanblk)) {
      const bf16_t* W1l = (const bf16_t*)(ws + (l == 0 ? OFF_W1_0 : l == 1 ? OFF_W1_1 : l == 2 ? OFF_W1_2 : OFF_W1_3));
      if (kind == 0) {
        EpiA1 e{(bf16_t*)BIG, (bf16_t*)(BIG + BIG_VT), (bf16_t*)(BIG + BIG_QX)};
        gemm_phase(H, W1l, NTOK, 2560, 1024, e, smem);
      } else if (kind == 1) {
        EpiPlain e{(bf16_t*)BIG, 3584};
        gemm_phase(H, W1l, NTOK, 3584, 1024, e, smem);
      } else {
        const int g1h = op == 6 ? 1 : 0;
        EpiC1 e{(bf16_t*)BIG, AB, g1h * 4096};
        gemm_phase(H, W1l, 16384, 3840, 1024, e, smem, g1h * 4096, op == 6 ? G - 32 : -1, bx - 32);
      }
      if (l == 0) {
        EpiMem e{KIMG, VIMG};
        gemm_phase(HMEM, WM, 1024, 1024, 1024, e, smem);
      }
    }
    if (op == 1) prep_phase((const bf16_t*)BIG, AB, PRM + PRM_CCW, PRM + PRM_CALOG, PRM + PRM_CDT, BIG + BIG_OPS, GL, STASH, hf, smem);
    if (op == 2) {
      if (kind == 0) {
        const int j = l / 3;
        gmlp_phase((const bf16_t*)BIG, (const bf16_t*)(BIG + BIG_VT), WS + (size_t)j * 8 * 128 * 128, PRM + PRM_ALNW + j * 1024, PRM + PRM_ALNB + j * 1024,
                   PRM + PRM_ABS + j * 1024, MIX, smem);
      } else {
        sconv_phase((const bf16_t*)BIG, PRM + PRM_BCW, MIX);
      }
    }
    if (scanblk) scan_block(BIG + BIG_OPS, GL, MIX, SSQ, STB, op == 6 ? 0 : 1, smem);
    if (op == 1 || op == 2) {
      const bf16_t* Q; int ldq, tok0, nrows;
      if (kind == 0) { Q = (const bf16_t*)(BIG + BIG_QX); ldq = 512; tok0 = -1; nrows = NTOK; }
      else if (kind == 1) { Q = (const bf16_t*)BIG + 3072; ldq = 3584; tok0 = -1; nrows = NTOK; }
      else { Q = (const bf16_t*)BIG + 3072; ldq = 3584; tok0 = hf * 4096; nrows = 16384; }
      attn_phase(Q, ldq, tok0, nrows, KIMG, VIMG, MIX, bx, G, smem);
    }
    if (op == 3 || op == 8 || (op == 7 && !scanblk)) {
      const int nv = op == 7 ? 2 : 1;
      for (int v = 0; v < nv; v++) {
        const bf16_t* Bz = W2 + (size_t)l * 1536 * 1024;
        int M = NTOK, N = 1536, asplit = -1, col0 = 0;
        if (op == 7 && v == 0) { Bz += (size_t)1024 * 1024; N = 512; col0 = 1024; }
        if ((op == 7 && v == 1) || op == 8) { M = 16384; N = 1024; asplit = op == 8 ? 4096 : 0; }
        EpiGate e{MIX, SSQ, PRM + PRM_CONW, kind == 2 ? 1 : 0, col0, asplit};
        gemm_phase(H, Bz, M, N, 1024, e, smem, asplit, op == 7 ? G - 32 : -1, bx - 32);
      }
    }
    if (op == 4) {
      EpiOut e{(bf16_t*)BIG};
      gemm_phase(MIX, WO + (size_t)l * 1024 * 1536, NTOK, 1024, 1536, e, smem);
    }
    if (op == 5) {
      norm_phase((const bf16_t*)BIG, l == 0 ? p.x : p.out, p.out, PRM + PRM_NPOST + l * 1024, l < 3 ? PRM + PRM_NPRE + (l + 1) * 1024 : nullptr, H);
    }
    xcd_barrier(xb);
  }
}

extern "C" void kernel_launch(void* const* d_in, const int* in_sizes, int n_in, void* d_out, int out_size, void* d_ws, size_t ws_size,
                              hipStream_t stream) {
  static int grid_blocks = 0;
  if (!grid_blocks) {
    int dev = 0, cus = 0, per_cu = 0;
    (void)hipGetDevice(&dev);
    (void)hipDeviceGetAttribute(&cus, hipDeviceAttributeMultiprocessorCount, dev);
    (void)hipOccupancyMaxActiveBlocksPerMultiprocessor(&per_cu, mega_kernel, 512, 0);
    if (per_cu > 1) per_cu = 1;
    if (per_cu < 1) per_cu = 1;
    grid_blocks = cus * per_cu;
  }
  Params p{};
  p.x = (const float*)d_in[0]; p.mem = (const float*)d_in[1]; p.mem_norm_w = (const float*)d_in[2]; p.w_mem_kv = (const float*)d_in[3];
  p.norm_pre = (const float*)d_in[4]; p.norm_post = (const float*)d_in[5]; p.w_out = (const float*)d_in[6]; p.a_w_in = (const float*)d_in[7];
  p.a_ln_w = (const float*)d_in[8]; p.a_ln_b = (const float*)d_in[9]; p.a_w_s = (const float*)d_in[10]; p.a_b_s = (const float*)d_in[11];
  p.b_w_in = (const float*)d_in[12]; p.b_conv_w = (const float*)d_in[13]; p.c_w_in = (const float*)d_in[14]; p.c_conv_w = (const float*)d_in[15];
  p.c_a_log = (const float*)d_in[16]; p.c_dt_bias = (const float*)d_in[17]; p.c_o_norm_w = (const float*)d_in[18];
  p.out = (float*)d_out;
  p.ws = (char*)d_ws;
  (void)hipMemsetAsync((char*)d_ws + OFF_BAR, 0, XCD_BAR_WORDS * sizeof(unsigned), stream);
  void* args[] = {&p};
  hipError_t e = hipLaunchCooperativeKernel((void*)mega_kernel, dim3(grid_blocks), dim3(512), args, 0, stream);
  if (e != hipSuccess) fprintf(stderr, "cooperative launch failed: %s (grid %d)\n", hipGetErrorString(e), grid_blocks);
}
```

```cpp
#include <hip/hip_runtime.h>
#include <hip/hip_cooperative_groups.h>
#include <cstdio>
namespace cg = cooperative_groups;

#define DI __device__ __forceinline__
typedef unsigned short bf16_t;
typedef short bf16x8 __attribute__((ext_vector_type(8)));
typedef float f32x4 __attribute__((ext_vector_type(4)));
typedef unsigned u32x4 __attribute__((ext_vector_type(4)));
typedef unsigned u32x2 __attribute__((ext_vector_type(2)));

constexpr int NTOK = 32768;
constexpr float EPS = 1e-6f;
constexpr int LDS_BYTES = 161856;
constexpr int OPS_STRIDE = 73728;

constexpr size_t SZ_W1A = 2560ull * 1024 * 2, SZ_W1B = 3584ull * 1024 * 2, SZ_W1C = 3840ull * 1024 * 2;
constexpr size_t OFF_W1_0 = 0;
constexpr size_t OFF_W1_1 = OFF_W1_0 + SZ_W1A;
constexpr size_t OFF_W1_2 = OFF_W1_1 + SZ_W1B;
constexpr size_t OFF_W1_3 = OFF_W1_2 + SZ_W1C;
constexpr size_t SZ_W2 = 1536ull * 1024 * 2;
constexpr size_t OFF_W2 = OFF_W1_3 + SZ_W1A;
constexpr size_t OFF_WO = OFF_W2 + 4 * SZ_W2;
constexpr size_t OFF_WM = OFF_WO + 4 * SZ_W2;
constexpr size_t OFF_WS = OFF_WM + 2097152;
constexpr size_t OFF_HMEM = OFF_WS + 524288;
constexpr size_t OFF_KIMG = OFF_HMEM + 2097152;
constexpr size_t OFF_VIMG = OFF_KIMG + 1048576;
constexpr size_t OFF_AB = OFF_VIMG + 1048576;
constexpr size_t OFF_SSQ = OFF_AB + 2097152;
constexpr size_t OFF_GL = OFF_SSQ + 1048576;
constexpr size_t OFF_ST = OFF_GL + 65536;
constexpr size_t OFF_STASH = OFF_ST + 2097152;
constexpr size_t OFF_BAR = OFF_STASH + 131072;
constexpr size_t OFF_PRM = OFF_BAR + 65536;
constexpr size_t OFF_H = OFF_PRM + 131072;
constexpr size_t OFF_MIX = OFF_H + 67108864;
constexpr size_t OFF_BIG = OFF_MIX + 100663296;
constexpr size_t BIG_VT = 67108864, BIG_QX = 134217728, BIG_OPS = 117440512;
static_assert(OFF_BIG + 268435456ull <= 536870912ull, "workspace overflow");

struct Params {
  const float *x, *mem, *mem_norm_w, *w_mem_kv, *norm_pre, *norm_post, *w_out, *a_w_in, *a_ln_w, *a_ln_b, *a_w_s, *a_b_s,
      *b_w_in, *b_conv_w, *c_w_in, *c_conv_w, *c_a_log, *c_dt_bias, *c_o_norm_w;
  float* out;
  char* ws;
};

typedef float f32x2 __attribute__((ext_vector_type(2)));
typedef __bf16 bf16x2_t __attribute__((ext_vector_type(2)));
DI unsigned pk2(float lo, float hi) { f32x2 v = {lo, hi}; bf16x2_t b = __builtin_convertvector(v, bf16x2_t); return __builtin_bit_cast(unsigned, b); }
DI float lo2f(unsigned p) { return __uint_as_float(p << 16); }
DI float hi2f(unsigned p) { return __uint_as_float(p & 0xffff0000u); }
DI float bf2f(bf16_t v) { return __uint_as_float(((unsigned)v) << 16); }
DI bf16_t f2bf(float f) { return (bf16_t)(pk2(f, 0.f) & 0xffffu); }
DI int zoff() { int z; asm volatile("s_mov_b32 %0, 0" : "=s"(z)); return z; }
DI int obid() { int r; asm volatile("s_mov_b32 %0, %1" : "=s"(r) : "s"(blockIdx.x)); return r; }
DI int ogrid() { int r; asm volatile("s_mov_b32 %0, %1" : "=s"(r) : "s"(gridDim.x)); return r; }
template <class T> DI T* lp(T* p) { return (T*)((char*)p + zoff()); }
DI int otid() { int t; asm volatile("v_mov_b32 %0, %1" : "=v"(t) : "v"(threadIdx.x)); return t; }
DI float wsum(float v) {
#pragma unroll
  for (int o = 32; o; o >>= 1) v += __shfl_xor(v, o);
  return v;
}
DI float sigmoidf_(float x) { return __builtin_amdgcn_rcpf(1.f + __expf(-x)); }
DI float siluf_(float x) { return x * sigmoidf_(x); }
DI float geluf_(float x) { const float u = 0.7978845608028654f * (x + 0.044715f * x * x * x); return x * sigmoidf_(2.f * u); }
DI f32x4 mfma16(bf16x8 a, bf16x8 b, f32x4 c) { return __builtin_amdgcn_mfma_f32_16x16x32_bf16(a, b, c, 0, 0, 0); }
DI bf16x8 pack8(f32x4 a, f32x4 b) {
  u32x4 p; p[0] = pk2(a[0], a[1]); p[1] = pk2(a[2], a[3]); p[2] = pk2(b[0], b[1]); p[3] = pk2(b[2], b[3]);
  return __builtin_bit_cast(bf16x8, p);
}
DI void unpack8(u32x4 p, float* v) {
#pragma unroll
  for (int i = 0; i < 4; i++) { v[2 * i] = lo2f(p[i]); v[2 * i + 1] = hi2f(p[i]); }
}

#define LAS __attribute__((address_space(3)))
constexpr int G_BM = 256, G_BK = 64, G_HALF = 128, G_HTB = G_HALF * G_BK * 2, G_NXCD = 8, G_WGM = 8;
DI int lds_byte(int r, int c) { const int st = (r >> 4) * 2 + (c >> 5), rr = r & 15, cc = c & 31, ob = rr * 64 + cc * 2; return st * 1024 + (ob ^ (((ob >> 9) & 1) << 5)); }
DI void stage_rc(int b, int& R, int& C) { const int st = b / 1024, sb = b % 1024, swz = sb ^ (((sb >> 9) & 1) << 5); R = (st >> 1) * 16 + swz / 64; C = (st & 1) * 32 + (swz % 64) / 2; }
struct UnitOrder {
  int nM, nN, nwg, G, c;
  DI void init(int M, int N, int G_, int c_) { nM = M / G_BM; nN = N / G_BM; nwg = nM * nN; G = G_; c = c_; }
  DI bool next(int i, int& pm, int& pn) const {
    const long L = (long)i * G + c; if (L >= nwg) return false;
    int wgid = (int)L; { const int q = nwg / G_NXCD, r = nwg % G_NXCD, xcd = wgid % G_NXCD, off = wgid / G_NXCD; wgid = (xcd < r ? xcd * (q + 1) : r * (q + 1) + (xcd - r) * q) + off; }
    const int nig = G_WGM * nN, gid = wgid / nig, fm = gid * G_WGM, gsz = (nM - fm) < G_WGM ? (nM - fm) : G_WGM;
    pm = fm + ((wgid % nig) % gsz); pn = (wgid % nig) / gsz; return true;
  }
};
template <class Epi>
DI void gemm_phase(const bf16_t* __restrict__ A, const bf16_t* __restrict__ Bt, int M, int N, int K, const Epi& epi, char* smem, int asplit = -1, int gG = -1, int gC = 0) {
  const int bx_ = obid(), G_ = ogrid(); (void)bx_; (void)G_;
  A = lp(A);
  Bt = lp(Bt);
  smem += zoff();
  LAS unsigned char* lds = (LAS unsigned char*)smem;
  const int tid = otid(), wid = __builtin_amdgcn_readfirstlane(tid >> 6), lane = tid & 63, wr = wid >> 2, wc = wid & 3, fr = lane & 15, fq = lane >> 4;
  const int nt = K / G_BK;
  unsigned voff[2];
#pragma unroll
  for (int i = 0; i < 2; ++i) { int R, C; stage_rc(tid * 16 + i * 8192, R, C); voff[i] = (unsigned)(R * K + C) * 2u; }
  const size_t kstep = (size_t)(G_BK * 2);
  const size_t hstep = (size_t)G_HALF * K * 2;
  const size_t tstep = 2 * hstep;
  const unsigned ldsw = (unsigned)wid * 1024u;
  const int aoff = lds_byte(wr * 64 + fr, fq * 8), boff = lds_byte(wc * 32 + fr, fq * 8);
#define PG8_SA(b, h) (((b) * 2 + (h)) * G_HTB)
#define PG8_SB(b, h) ((4 + (b) * 2 + (h)) * G_HTB)
#define PG8_STAGE(bufoff, gbase) do { _Pragma("unroll") for (int _i = 0; _i < 2; ++_i) \
    __builtin_amdgcn_global_load_lds((const unsigned*)((const char*)(gbase) + voff[_i]), (LAS unsigned*)(lds + (bufoff) + ldsw + _i * 8192), 16, 0, 0); } while (0)
#define PG8_LDA(dst, b, h) do { _Pragma("unroll") for (int m = 0; m < 4; ++m) _Pragma("unroll") for (int k = 0; k < 2; ++k) dst[m][k] = *(const LAS bf16x8*)(lds + PG8_SA(b, h) + aoff + m * 2048 + k * 1024); } while (0)
#define PG8_LDB(dst, b, h) do { _Pragma("unroll") for (int n = 0; n < 2; ++n) _Pragma("unroll") for (int k = 0; k < 2; ++k) dst[n][k] = *(const LAS bf16x8*)(lds + PG8_SB(b, h) + boff + n * 2048 + k * 1024); } while (0)
#define PG8_MMA(ai, bj, At, Bt_) do { __builtin_amdgcn_s_setprio(1); _Pragma("unroll") for (int m = 0; m < 4; ++m) _Pragma("unroll") for (int n = 0; n < 2; ++n) _Pragma("unroll") for (int k = 0; k < 2; ++k) \
    acc[ai][bj][m][n] = __builtin_amdgcn_mfma_f32_16x16x32_bf16(Bt_[n][k], At[m][k], acc[ai][bj][m][n], 0, 0, 0); __builtin_amdgcn_s_setprio(0); } while (0)
#define PG8_WAIT_V(n) asm volatile("s_waitcnt vmcnt(" #n ")" ::: "memory")
#define PG8_WAIT_L(n) asm volatile("s_waitcnt lgkmcnt(" #n ")" ::: "memory")
#define PG8_BAR __builtin_amdgcn_s_barrier()
#define PG8_SCHED __builtin_amdgcn_sched_barrier(0)
#define PG8_AROW(pm) ((size_t)(asplit < 0 ? (pm) * 256 : (((pm) >> 4) << 13) + asplit + (((pm) & 15) << 8)))
  UnitOrder S; S.init(M, N, gG < 0 ? G_ : gG, gG < 0 ? bx_ : gC);
  int cpm, cpn, npm = 0, npn = 0, ui = 0;
  if (!S.next(0, cpm, cpn)) return;
  f32x4 acc[2][2][4][2];
#pragma unroll
  for (int a = 0; a < 2; ++a)
#pragma unroll
    for (int b = 0; b < 2; ++b)
#pragma unroll
      for (int m = 0; m < 4; ++m)
#pragma unroll
        for (int n = 0; n < 2; ++n) acc[a][b][m][n] = (f32x4){0.f, 0.f, 0.f, 0.f};
  bf16x8 At[4][2], B0[2][2], B1[2][2];
  const char* cA = (const char*)A + PG8_AROW(cpm) * K * 2; const char* cB = (const char*)Bt + (size_t)cpn * tstep;
  PG8_STAGE(PG8_SB(0, 0), cB); PG8_STAGE(PG8_SA(0, 0), cA); PG8_STAGE(PG8_SB(0, 1), cB + hstep); PG8_STAGE(PG8_SA(0, 1), cA + hstep);
  if (wr == 1) PG8_BAR;
  PG8_WAIT_V(4); PG8_BAR;
  PG8_STAGE(PG8_SB(1, 0), cB + kstep); PG8_STAGE(PG8_SA(1, 0), cA + kstep); PG8_STAGE(PG8_SB(1, 1), cB + hstep + kstep);
  PG8_WAIT_V(6); PG8_BAR;
  for (;;) {
    const bool has_next = S.next(ui + 1, npm, npn);
    const char* nA = has_next ? (const char*)A + PG8_AROW(npm) * K * 2 : cA; const char* nB = has_next ? (const char*)Bt + (size_t)npn * tstep : cB;
    for (int t = 0; t < nt; t += 2) {
      const bool last = (t == nt - 2);
      const char* a1 = cA + (size_t)(t + 1) * kstep;
      const char* a2 = last ? nA : cA + (size_t)(t + 2) * kstep; const char* b2 = last ? nB : cB + (size_t)(t + 2) * kstep;
      const char* a3 = a2 + kstep; const char* b3 = b2 + kstep;
      PG8_LDB(B0, 0, 0); PG8_SCHED; PG8_LDA(At, 0, 0); PG8_STAGE(PG8_SA(1, 1), a1 + hstep);
      PG8_WAIT_L(8); PG8_BAR; PG8_WAIT_L(0); PG8_MMA(0, 0, At, B0); PG8_BAR; PG8_SCHED;
      PG8_LDB(B1, 0, 1); PG8_STAGE(PG8_SB(0, 0), b2);
      PG8_BAR; PG8_WAIT_L(0); PG8_MMA(0, 1, At, B1); PG8_BAR;
      PG8_LDA(At, 0, 1); PG8_STAGE(PG8_SA(0, 0), a2);
      PG8_BAR; PG8_WAIT_L(0); PG8_MMA(1, 0, At, B0); PG8_BAR; PG8_SCHED;
      PG8_STAGE(PG8_SB(0, 1), b2 + hstep);
      PG8_WAIT_V(6); PG8_BAR; PG8_MMA(1, 1, At, B1); PG8_BAR;
      PG8_LDB(B0, 1, 0); PG8_SCHED; PG8_LDA(At, 1, 0); PG8_STAGE(PG8_SA(0, 1), a2 + hstep);
      PG8_WAIT_L(8); PG8_BAR; PG8_WAIT_L(0); PG8_MMA(0, 0, At, B0); PG8_BAR; PG8_SCHED;
      PG8_LDB(B1, 1, 1); PG8_STAGE(PG8_SB(1, 0), b3);
      PG8_BAR; PG8_WAIT_L(0); PG8_MMA(0, 1, At, B1); PG8_BAR;
      PG8_LDA(At, 1, 1); PG8_STAGE(PG8_SA(1, 0), a3);
      PG8_BAR; PG8_WAIT_L(0); PG8_MMA(1, 0, At, B0); PG8_BAR; PG8_SCHED;
      PG8_STAGE(PG8_SB(1, 1), b3 + hstep);
      PG8_WAIT_V(6); PG8_BAR; PG8_MMA(1, 1, At, B1); PG8_BAR;
    }
    if constexpr (Epi::PRELOAD) {
#pragma unroll
      for (int ai = 0; ai < 2; ++ai) {
        u32x4 pre[4][2][2];
#pragma unroll
        for (int m = 0; m < 4; ++m)
#pragma unroll
          for (int bj = 0; bj < 2; ++bj)
#pragma unroll
            for (int n = 0; n < 2; ++n)
              pre[m][bj][n] = epi.pre(cpm * 256 + ai * 128 + wr * 64 + m * 16 + fr, cpn * 256 + bj * 128 + wc * 32 + n * 16 + fq * 4);
        __builtin_amdgcn_sched_barrier(0);
#pragma unroll
        for (int m = 0; m < 4; ++m)
#pragma unroll
          for (int bj = 0; bj < 2; ++bj)
#pragma unroll
            for (int n = 0; n < 2; ++n)
              epi.fin(cpm * 256 + ai * 128 + wr * 64 + m * 16 + fr, cpn * 256 + bj * 128 + wc * 32 + n * 16 + fq * 4, acc[ai][bj][m][n], pre[m][bj][n]);
      }
    } else {
#pragma unroll
    for (int ai = 0; ai < 2; ++ai)
#pragma unroll
      for (int m = 0; m < 4; ++m)
#pragma unroll
        for (int bj = 0; bj < 2; ++bj)
#pragma unroll
          for (int n = 0; n < 2; ++n)
            epi(cpm * 256 + ai * 128 + wr * 64 + m * 16 + fr, cpn * 256 + bj * 128 + wc * 32 + n * 16 + fq * 4, acc[ai][bj][m][n]);
    }
    if (!has_next) break;
#pragma unroll
    for (int a = 0; a < 2; ++a)
#pragma unroll
      for (int b = 0; b < 2; ++b)
#pragma unroll
        for (int m = 0; m < 4; ++m)
#pragma unroll
          for (int n = 0; n < 2; ++n) acc[a][b][m][n] = (f32x4){0.f, 0.f, 0.f, 0.f};
    cpm = npm; cpn = npn; cA = nA; cB = nB; ++ui;
  }
  PG8_WAIT_V(0);
  if (wr == 0) PG8_BAR;
  PG8_BAR;
#undef PG8_SA
#undef PG8_SB
#undef PG8_STAGE
#undef PG8_LDA
#undef PG8_LDB
#undef PG8_MMA
#undef PG8_WAIT_V
#undef PG8_WAIT_L
#undef PG8_BAR
#undef PG8_SCHED
#undef PG8_AROW
}

struct EpiMem {
  static constexpr bool PRELOAD = false;
  bf16_t *kimg, *vimg;
  DI void operator()(int row, int col, f32x4 v) const {
    const int b = row >> 8, m = row & 255;
    const int cb = __builtin_amdgcn_readfirstlane(col & ~127);
    if (cb < 512) {
      const int head = col >> 7, d = col & 127;
      const int mt = m >> 4, n = m & 15, ks = d >> 5, jq = (d & 31) >> 3, j = d & 7;
      bf16_t* p = kimg + (size_t)(b * 4 + head) * 32768 + ((mt * 4 + ks) * 64 + jq * 16 + n) * 8 + j;
      *(u32x2*)p = (u32x2){pk2(v[0], v[1]), pk2(v[2], v[3])};
    } else {
      const int c2 = col - 512, head = c2 >> 7, d0 = c2 & 127;
      const int kk = m >> 5, mm = m & 31, j = 4 * (mm >> 4) + (mm & 3), jq = (mm & 15) >> 2;
#pragma unroll
      for (int i = 0; i < 4; i++) {
        const int d = d0 + i, dt = d >> 4, r = d & 15;
        vimg[(size_t)(b * 4 + head) * 32768 + ((dt * 8 + kk) * 64 + jq * 16 + r) * 8 + j] = f2bf(v[i]);
      }
    }
  }
};
struct EpiA1 {
  static constexpr bool PRELOAD = false;
  bf16_t *U, *VT, *QX;
  DI void operator()(int row, int col, f32x4 v) const {
    const int cb = __builtin_amdgcn_readfirstlane(col & ~127);
    if (cb < 1024) {
      *(u32x2*)(U + (size_t)row * 1024 + col) = (u32x2){pk2(geluf_(v[0]), geluf_(v[1])), pk2(geluf_(v[2]), geluf_(v[3]))};
    } else if (cb < 2048) {
      const int c = col - 1024, chunk = row >> 7, s = row & 127;
#pragma unroll
      for (int i = 0; i < 4; i++) VT[(((size_t)chunk * 1024 + c + i) << 7) + s] = f2bf(geluf_(v[i]));
    } else {
      *(u32x2*)(QX + (size_t)row * 512 + (col - 2048)) = (u32x2){pk2(v[0], v[1]), pk2(v[2], v[3])};
    }
  }
};
struct EpiPlain {
  static constexpr bool PRELOAD = false;
  bf16_t* R; int ld;
  DI void operator()(int row, int col, f32x4 v) const { *(u32x2*)(R + (size_t)row * ld + col) = (u32x2){pk2(v[0], v[1]), pk2(v[2], v[3])}; }
};
struct EpiC1 {
  static constexpr bool PRELOAD = false;
  bf16_t* R; float* ab; int hfoff;
  DI void operator()(int row, int col, f32x4 v) const {
    const int cb = __builtin_amdgcn_readfirstlane(col & ~127);
    if (cb < 3584) *(u32x2*)(R + (size_t)row * 3584 + col) = (u32x2){pk2(v[0], v[1]), pk2(v[2], v[3])};
    else if (cb == 3584 && col < 3600) *(f32x4*)(ab + (size_t)(((row >> 12) << 13) + hfoff + (row & 4095)) * 16 + (col - 3584)) = v;
  }
};
struct EpiGate {
  static constexpr bool PRELOAD = true;
  bf16_t* Y; const float* __restrict__ ssq; const float* __restrict__ onw; int isC, col0, hfoff;
  DI int tokof(int row) const { return hfoff < 0 ? row : ((row >> 12) << 13) + hfoff + (row & 4095); }
  DI u32x4 pre(int row, int col) const {
    const int tok = tokof(row), yc = col + col0;
    const u32x2 m = *(const u32x2*)(Y + (size_t)tok * 1536 + yc);
    float q = 0.f;
    if (isC && __builtin_amdgcn_readfirstlane(yc & ~127) < 1024) q = ssq[(size_t)tok * 8 + (yc >> 7)];
    return (u32x4){m[0], m[1], __float_as_uint(q), 0u};
  }
  DI void fin(int row, int col, f32x4 v, u32x4 pr) const {
    const int tok = tokof(row), yc = col + col0;
    float a0 = lo2f(pr[0]), a1 = hi2f(pr[0]), a2 = lo2f(pr[1]), a3 = hi2f(pr[1]);
    if (isC && __builtin_amdgcn_readfirstlane(yc & ~127) < 1024) {
      const float r = rsqrtf(__uint_as_float(pr[2]) * (1.f / 128.f) + EPS);
      const f32x4 w = *(const f32x4*)(onw + (yc & 127));
      a0 *= r * w[0]; a1 *= r * w[1]; a2 *= r * w[2]; a3 *= r * w[3];
    }
    *(u32x2*)(Y + (size_t)tok * 1536 + yc) = (u32x2){pk2(a0 * siluf_(v[0]), a1 * siluf_(v[1])), pk2(a2 * siluf_(v[2]), a3 * siluf_(v[3]))};
  }
  DI void operator()(int row, int col, f32x4 v) const { fin(row, col, v, pre(row, col)); }
};
struct EpiOut {
  static constexpr bool PRELOAD = false;
  bf16_t* O;
  DI void operator()(int row, int col, f32x4 v) const { *(u32x2*)(O + (size_t)row * 1024 + col) = (u32x2){pk2(v[0], v[1]), pk2(v[2], v[3])}; }
};

DI void conv_seg(const float* __restrict__ src, int ld, int col0, int ncols, bf16_t* __restrict__ dst, int K, char* smem) {
  const int bx_ = obid(), G_ = ogrid(); (void)bx_; (void)G_;
  src = lp(src);
  dst = lp(dst);
  smem += zoff();
  float* tile = (float*)smem;
  const int tid = otid();
  const int ntj = (ncols + 63) >> 6, ntk = K >> 6;
  for (int t = bx_; t < ntj * ntk; t += G_) {
    const int tj = t % ntj, tk = t / ntj;
    {
      const int jj = tid & 63, k0 = tid >> 6;
      const bool ok = (tj * 64 + jj) < ncols;
#pragma unroll
      for (int i = 0; i < 8; i++) {
        const int kk = k0 + 8 * i;
        tile[kk * 65 + jj] = ok ? src[(size_t)(tk * 64 + kk) * ld + col0 + tj * 64 + jj] : 0.f;
      }
    }
    __syncthreads();
    {
      const int kk2 = (tid & 31) * 2, j2 = tid >> 5;
#pragma unroll
      for (int i = 0; i < 4; i++) {
        const int jj = j2 + 16 * i;
        if (tj * 64 + jj < ncols) *(unsigned*)(dst + (size_t)(tj * 64 + jj) * K + tk * 64 + kk2) = pk2(tile[kk2 * 65 + jj], tile[(kk2 + 1) * 65 + jj]);
      }
    }
    __syncthreads();
  }
}

DI void rmsnorm_rows(const float* __restrict__ x, const float* __restrict__ w, bf16_t* __restrict__ h, int nrows) {
  const int bx_ = obid(), G_ = ogrid(); (void)bx_; (void)G_;
  x = lp(x);
  w = lp(w);
  h = lp(h);
  const int lane = otid() & 63, wid = otid() >> 6;
  f32x4 wv[4];
#pragma unroll
  for (int i = 0; i < 4; i++) wv[i] = *(const f32x4*)(w + i * 256 + lane * 4);
  for (int row = bx_ * 8 + wid; row < nrows; row += G_ * 8) {
    f32x4 v[4]; float ss = 0.f;
#pragma unroll
    for (int i = 0; i < 4; i++) { v[i] = *(const f32x4*)(x + (size_t)row * 1024 + i * 256 + lane * 4); ss += v[i][0] * v[i][0] + v[i][1] * v[i][1] + v[i][2] * v[i][2] + v[i][3] * v[i][3]; }
    ss = wsum(ss);
    const float r = rsqrtf(ss * (1.f / 1024.f) + EPS);
#pragma unroll
    for (int i = 0; i < 4; i++)
      *(u32x2*)(h + (size_t)row * 1024 + i * 256 + lane * 4) = (u32x2){pk2(v[i][0] * r * wv[i][0], v[i][1] * r * wv[i][1]), pk2(v[i][2] * r * wv[i][2], v[i][3] * r * wv[i][3])};
  }
}

DI void norm_phase(const bf16_t* __restrict__ O, const float* xin, float* xout, const float* __restrict__ wpost, const float* __restrict__ wpre, bf16_t* __restrict__ h) {
  const int bx_ = obid(), G_ = ogrid(); (void)bx_; (void)G_;
  O = lp(O);
  xin = lp(xin);
  xout = lp(xout);
  wpost = lp(wpost);
  wpre = lp(wpre);
  h = lp(h);
  const int lane = otid() & 63, wid = otid() >> 6;
  f32x4 wp[4], wq[4];
#pragma unroll
  for (int i = 0; i < 4; i++) { wp[i] = *(const f32x4*)(wpost + i * 256 + lane * 4); wq[i] = wpre ? *(const f32x4*)(wpre + i * 256 + lane * 4) : (f32x4){0.f, 0.f, 0.f, 0.f}; }
  for (int row = bx_ * 8 + wid; row < NTOK; row += G_ * 8) {
    f32x4 o[4], xv[4]; float ss = 0.f;
#pragma unroll
    for (int i = 0; i < 4; i++) {
      { const u32x2 ob = *(const u32x2*)(O + (size_t)row * 1024 + i * 256 + lane * 4); o[i] = (f32x4){lo2f(ob[0]), hi2f(ob[0]), lo2f(ob[1]), hi2f(ob[1])}; }
      xv[i] = *(const f32x4*)(xin + (size_t)row * 1024 + i * 256 + lane * 4);
      ss += o[i][0] * o[i][0] + o[i][1] * o[i][1] + o[i][2] * o[i][2] + o[i][3] * o[i][3];
    }
    ss = wsum(ss);
    const float r = rsqrtf(ss * (1.f / 1024.f) + EPS);
    float s2 = 0.f;
#pragma unroll
    for (int i = 0; i < 4; i++) {
#pragma unroll
      for (int j = 0; j < 4; j++) { xv[i][j] += o[i][j] * r * wp[i][j]; s2 += xv[i][j] * xv[i][j]; }
      *(f32x4*)(xout + (size_t)row * 1024 + i * 256 + lane * 4) = xv[i];
    }
    if (wpre) {
      s2 = wsum(s2);
      const float r2 = rsqrtf(s2 * (1.f / 1024.f) + EPS);
#pragma unroll
      for (int i = 0; i < 4; i++)
        *(u32x2*)(h + (size_t)row * 1024 + i * 256 + lane * 4) = (u32x2){pk2(xv[i][0] * r2 * wq[i][0], xv[i][1] * r2 * wq[i][1]), pk2(xv[i][2] * r2 * wq[i][2], xv[i][3] * r2 * wq[i][3])};
    }
  }
}

DI void attn_phase(const bf16_t* __restrict__ Q, int ldq, int hfoff  , int nrows, const bf16_t* __restrict__ Kimg, const bf16_t* __restrict__ Vimg,
                   bf16_t* __restrict__ mix, int bid, int nb, char* smem) {
  const int bx_ = obid(), G_ = ogrid(); (void)bx_; (void)G_;
  Q = lp(Q);
  Kimg = lp(Kimg);
  Vimg = lp(Vimg);
  mix = lp(mix);
  smem += zoff();
  const int tid = otid(), lane = tid & 63, wid = tid >> 6, fr = lane & 15, fq = lane >> 4;
  const int items = (nrows >> 9) * 4;
  for (int it = bid; it < items; it += nb) {
    const int head = it & 3, span = it >> 2, lrow0 = span * 512;
    const int tokb = hfoff < 0 ? lrow0 : ((lrow0 >> 12) << 13) + hfoff + (lrow0 & 4095);
    const int b = tokb >> 13;
    const u32x4* ksrc = (const u32x4*)(Kimg + (size_t)(b * 4 + head) * 32768);
    const u32x4* vsrc = (const u32x4*)(Vimg + (size_t)(b * 4 + head) * 32768);
    {
      u32x4 kr[8], vr[8];
#pragma unroll
      for (int i = 0; i < 8; i++) { kr[i] = ksrc[tid + 512 * i]; vr[i] = vsrc[tid + 512 * i]; }
      __builtin_amdgcn_sched_barrier(0);
#pragma unroll
      for (int i = 0; i < 8; i++) { ((u32x4*)smem)[tid + 512 * i] = kr[i]; ((u32x4*)(smem + 65536))[tid + 512 * i] = vr[i]; }
    }
    __syncthreads();
    for (int qi = 0; qi < 4; qi++) {
      const int lr = lrow0 + qi * 128 + wid * 16;
      bf16x8 qf[4];
#pragma unroll
      for (int ks = 0; ks < 4; ks++) qf[ks] = *(const bf16x8*)(Q + (size_t)(lr + fr) * ldq + head * 128 + ks * 32 + fq * 8);
      f32x4 st[16];
#pragma unroll
      for (int mt = 0; mt < 16; mt++) {
        f32x4 a = (f32x4){0.f, 0.f, 0.f, 0.f};
#pragma unroll
        for (int ks = 0; ks < 4; ks++) a = mfma16(*(const bf16x8*)(smem + ((mt * 4 + ks) * 64 + lane) * 16), qf[ks], a);
        st[mt] = a;
        if (mt & 1) __builtin_amdgcn_sched_barrier(0);
      }
      float mx = -3.0e38f;
#pragma unroll
      for (int mt = 0; mt < 16; mt++)
#pragma unroll
        for (int i = 0; i < 4; i++) mx = fmaxf(mx, st[mt][i]);
      mx = fmaxf(mx, __shfl_xor(mx, 16)); mx = fmaxf(mx, __shfl_xor(mx, 32));
      const float sc = 0.08838834764831845f * 1.4426950408889634f;
      float sum = 0.f;
#pragma unroll
      for (int mt = 0; mt < 16; mt++)
#pragma unroll
        for (int i = 0; i < 4; i++) { const float pz = __builtin_amdgcn_exp2f((st[mt][i] - mx) * sc); st[mt][i] = pz; sum += pz; }
      sum += __shfl_xor(sum, 16); sum += __shfl_xor(sum, 32);
      bf16x8 pf[8];
#pragma unroll
      for (int kk = 0; kk < 8; kk++) pf[kk] = pack8(st[2 * kk], st[2 * kk + 1]);
      const float inv = 1.f / sum;
      bf16_t* op = mix + (size_t)(tokb + (lr - lrow0) + fr) * 1536 + 1024 + head * 128 + fq * 4;
#pragma unroll
      for (int dt = 0; dt < 8; dt++) {
        f32x4 o = (f32x4){0.f, 0.f, 0.f, 0.f};
#pragma unroll
        for (int kk = 0; kk < 8; kk++) o = mfma16(*(const bf16x8*)(smem + 65536 + ((dt * 8 + kk) * 64 + lane) * 16), pf[kk], o);
        *(u32x2*)(op + dt * 16) = (u32x2){pk2(o[0] * inv, o[1] * inv), pk2(o[2] * inv, o[3] * inv)};
        __builtin_amdgcn_sched_barrier(0);
      }
    }
    __syncthreads();
  }
}

DI void gmlp_phase(const bf16_t* __restrict__ U, const bf16_t* __restrict__ VT, const bf16_t* __restrict__ Wsb, const float* __restrict__ ln_w,
                   const float* __restrict__ ln_b, const float* __restrict__ b_s, bf16_t* __restrict__ mix, char* smem) {
  const int bx_ = obid(), G_ = ogrid(); (void)bx_; (void)G_;
  U = lp(U);
  VT = lp(VT);
  Wsb = lp(Wsb);
  ln_w = lp(ln_w);
  ln_b = lp(ln_b);
  b_s = lp(b_s);
  mix = lp(mix);
  smem += zoff();
  float* red = (float*)smem;
  float* stats = (float*)(smem + 32768);
  for (int chunk = bx_; chunk < 256; chunk += G_) {
    const int tid = otid(), lane = tid & 63, wid = tid >> 6, fr = lane & 15, fq = lane >> 4;
    {
      const int s8 = tid & 15, cgp = tid >> 4;
      float sm[8], sq[8];
#pragma unroll
      for (int j = 0; j < 8; j++) { sm[j] = 0.f; sq[j] = 0.f; }
#pragma unroll 8
      for (int cc = 0; cc < 32; cc++) {
        const u32x4 raw = *(const u32x4*)(VT + (((size_t)chunk * 1024 + cgp * 32 + cc) << 7) + s8 * 8);
        float v[8]; unpack8(raw, v);
#pragma unroll
        for (int j = 0; j < 8; j++) { sm[j] += v[j]; sq[j] += v[j] * v[j]; }
      }
#pragma unroll
      for (int j = 0; j < 8; j++) { red[(cgp * 128 + s8 * 8 + j) * 2] = sm[j]; red[(cgp * 128 + s8 * 8 + j) * 2 + 1] = sq[j]; }
    }
    __syncthreads();
    if (tid < 128) {
      float S = 0.f, Q = 0.f;
      for (int g2 = 0; g2 < 32; g2++) { S += red[(g2 * 128 + tid) * 2]; Q += red[(g2 * 128 + tid) * 2 + 1]; }
      const float mean = S * (1.f / 1024.f), var = Q * (1.f / 1024.f) - mean * mean;
      stats[tid * 2] = mean; stats[tid * 2 + 1] = rsqrtf(fmaxf(var, 0.f) + EPS);
    }
    __syncthreads();
    const int g = wid;
    float lwv[8], lbv[8];
#pragma unroll
    for (int ct = 0; ct < 8; ct++) { lwv[ct] = ln_w[g * 128 + 16 * ct + fr]; lbv[ct] = ln_b[g * 128 + 16 * ct + fr]; }
#pragma unroll
    for (int tq = 0; tq < 4; tq++) {
      f32x4 acc[8][2];
#pragma unroll
      for (int ct = 0; ct < 8; ct++)
#pragma unroll
        for (int tt = 0; tt < 2; tt++) acc[ct][tt] = (f32x4){0.f, 0.f, 0.f, 0.f};
#pragma unroll
      for (int ks = 0; ks < 4; ks++) {
        if (ks <= tq) {
          float mean8[8], rstd8[8];
#pragma unroll
          for (int j = 0; j < 8; j++) { mean8[j] = stats[(32 * ks + 8 * fq + j) * 2]; rstd8[j] = stats[(32 * ks + 8 * fq + j) * 2 + 1]; }
          bf16x8 bfr[2];
#pragma unroll
          for (int tt = 0; tt < 2; tt++) bfr[tt] = *(const bf16x8*)(Wsb + ((size_t)g * 128 + 32 * tq + 16 * tt + fr) * 128 + 32 * ks + 8 * fq);
          u32x4 rawv[8];
#pragma unroll
          for (int ct = 0; ct < 8; ct++) rawv[ct] = *(const u32x4*)(VT + (((size_t)chunk * 1024 + g * 128 + 16 * ct + fr) << 7) + 32 * ks + 8 * fq);
#pragma unroll
          for (int ct = 0; ct < 8; ct++) {
            const float lw = lwv[ct], lb = lbv[ct];
            float v[8]; unpack8(rawv[ct], v);
#pragma unroll
            for (int j = 0; j < 8; j++) v[j] = (v[j] - mean8[j]) * rstd8[j] * lw + lb;
            u32x4 pa; pa[0] = pk2(v[0], v[1]); pa[1] = pk2(v[2], v[3]); pa[2] = pk2(v[4], v[5]); pa[3] = pk2(v[6], v[7]);
            const bf16x8 af = __builtin_bit_cast(bf16x8, pa);
#pragma unroll
            for (int tt = 0; tt < 2; tt++) acc[ct][tt] = mfma16(af, bfr[tt], acc[ct][tt]);
            if (ct & 1) __builtin_amdgcn_sched_barrier(0);
          }
        }
      }
#pragma unroll
      for (int tt = 0; tt < 2; tt++) {
        const int t = 32 * tq + 16 * tt + fr;
        const size_t tok = (size_t)chunk * 128 + t;
        const float bs = b_s[g * 128 + t];
        u32x2 uuv[8];
#pragma unroll
        for (int ct = 0; ct < 8; ct++) uuv[ct] = *(const u32x2*)(U + tok * 1024 + g * 128 + 16 * ct + 4 * fq);
#pragma unroll
        for (int ct = 0; ct < 8; ct++) {
          const int col = g * 128 + 16 * ct + 4 * fq;
          const u32x2 uu = uuv[ct];
          const f32x4 a = acc[ct][tt];
          *(u32x2*)(mix + tok * 1536 + col) = (u32x2){pk2(lo2f(uu[0]) * (a[0] + bs), hi2f(uu[0]) * (a[1] + bs)), pk2(lo2f(uu[1]) * (a[2] + bs), hi2f(uu[1]) * (a[3] + bs))};
        }
      }
      __builtin_amdgcn_sched_barrier(0);
    }
    __syncthreads();
  }
}

DI void sconv_phase(const bf16_t* __restrict__ R, const float* __restrict__ cw, bf16_t* __restrict__ mix) {
  const int bx_ = obid(), G_ = ogrid(); (void)bx_; (void)G_;
  R = lp(R);
  cw = lp(cw);
  mix = lp(mix);
  for (int idx = bx_ * 512 + otid(); idx < NTOK * 128; idx += G_ * 512) {
    const int row = idx >> 7, c = (idx & 127) * 8, s = row & 8191;
    float acc[8];
#pragma unroll
    for (int j = 0; j < 8; j++) acc[j] = 0.f;
#pragma unroll
    for (int k = 0; k < 3; k++) {
      if (s - 2 + k >= 0) {
        const size_t r2 = (size_t)(row - 2 + k);
        float a[8], b[8]; unpack8(*(const u32x4*)(R + r2 * 3584 + 1024 + c), a); unpack8(*(const u32x4*)(R + r2 * 3584 + 2048 + c), b);
        const f32x4 w0 = *(const f32x4*)(cw + k * 1024 + c), w1 = *(const f32x4*)(cw + k * 1024 + c + 4);
#pragma unroll
        for (int j = 0; j < 4; j++) { acc[j] += w0[j] * a[j] * b[j]; acc[4 + j] += w1[j] * a[4 + j] * b[4 + j]; }
      }
    }
    float g[8]; unpack8(*(const u32x4*)(R + (size_t)row * 3584 + c), g);
    u32x4 o;
#pragma unroll
    for (int j = 0; j < 4; j++) o[j] = pk2(g[2 * j] * acc[2 * j], g[2 * j + 1] * acc[2 * j + 1]);
    *(u32x4*)(mix + (size_t)row * 1536 + c) = o;
  }
}

constexpr int P_SET = 1024 + 3 * 17408;
constexpr int P_AF = 0, P_SET0 = 16384, P_WB = P_SET0 + 2 * P_SET, P_QK = P_WB + 17408, P_END = P_QK + 9216;
constexpr int P_WL = P_END;
constexpr int XST_OFF = P_END + 2 * 6144;
static_assert(XST_OFF + 64 <= LDS_BYTES, "prep lds");

DI void prep_loadw(const float* __restrict__ cw, int ci, float* wl, int t0, int nth) {
  const int hh = (ci >> 6) & 7;
  for (int i = t0; i < 384; i += nth) {
    const int sec = i >> 7, kk = (i >> 5) & 3, c4 = i & 31;
    *(f32x4*)(wl + i * 4) = *(const f32x4*)(cw + (size_t)kk * 3072 + sec * 1024 + hh * 128 + c4 * 4);
  }
}
DI void prep_conv(const bf16_t* __restrict__ R, const float* __restrict__ ab, const float* wl, const float* __restrict__ a_log,
                  const float* __restrict__ dt_bias, float* __restrict__ glbuf, bf16_t* __restrict__ stash, int half, int ci, char* sb, int t0, int nth) {
  float* gc = (float*)sb; float* be = gc + 64; float* eg = gc + 128; float* ek = gc + 192;
  bf16_t* Kb = (bf16_t*)(sb + 1024); bf16_t* Qb = Kb + 64 * 136; bf16_t* Vb = Qb + 64 * 136;
  const int bl = ci >> 9, hh = (ci >> 6) & 7, n = ci & 63;
  const int tokg = bl * 8192 + half * 4096 + n * 64;
  if (t0 < 64) {
    const int lane = t0;
    const float a = ab[(size_t)(tokg + lane) * 16 + hh], bb = ab[(size_t)(tokg + lane) * 16 + 8 + hh];
    const float xs = a + dt_bias[hh];
    const float sp = xs > 20.f ? xs : log1pf(__expf(xs));
    float g = -__expf(a_log[hh]) * sp;
#pragma unroll
    for (int o = 1; o < 64; o <<= 1) { const float t = __shfl_up(g, o); if (lane >= o) g += t; }
    const float gl = __shfl(g, 63);
    gc[lane] = g; be[lane] = sigmoidf_(bb); eg[lane] = __expf(g); ek[lane] = __expf(gl - g);
    if (lane == 63) glbuf[ci] = __expf(gl);
  }
  for (int idx = t0; idx < 512; idx += nth) {
    const int t = idx >> 3, sub = idx & 7;
    u32x4 raw[3][4][2];
#pragma unroll
    for (int sec = 0; sec < 3; sec++)
#pragma unroll
      for (int kk = 0; kk < 4; kk++) {
        const int sl = n * 64 + t - 3 + kk;
        if (sl >= 0 || half == 1) {
          const bf16_t* src = sl >= 0 ? R + (size_t)(bl * 4096 + sl) * 3584 + sec * 1024 + hh * 128 + sub * 16
                                      : stash + (size_t)((bl * 8 + hh) * 3 + (sl + 3)) * 384 + sec * 128 + sub * 16;
          raw[sec][kk][0] = *(const u32x4*)src; raw[sec][kk][1] = *(const u32x4*)(src + 8);
        } else {
          raw[sec][kk][0] = (u32x4){0u, 0u, 0u, 0u}; raw[sec][kk][1] = (u32x4){0u, 0u, 0u, 0u};
        }
      }
#pragma unroll
    for (int sec = 0; sec < 3; sec++) {
      float acc[16];
#pragma unroll
      for (int j = 0; j < 16; j++) acc[j] = 0.f;
#pragma unroll
      for (int kk = 0; kk < 4; kk++) {
        float xv[16]; unpack8(raw[sec][kk][0], xv); unpack8(raw[sec][kk][1], xv + 8);
#pragma unroll
        for (int q4 = 0; q4 < 4; q4++) {
          const f32x4 w = *(const f32x4*)(wl + (sec * 4 + kk) * 128 + sub * 16 + q4 * 4);
#pragma unroll
          for (int j = 0; j < 4; j++) acc[q4 * 4 + j] += w[j] * xv[q4 * 4 + j];
        }
      }
      float ss = 0.f;
#pragma unroll
      for (int j = 0; j < 16; j++) { acc[j] = siluf_(acc[j]); ss += acc[j] * acc[j]; }
      float scale = 1.f;
      if (sec < 2) {
        ss += __shfl_xor(ss, 1); ss += __shfl_xor(ss, 2); ss += __shfl_xor(ss, 4);
        scale = rsqrtf(ss + EPS) * (sec == 0 ? 0.08838834764831845f : 1.f);
      }
      bf16_t* dst = (sec == 0 ? Qb : (sec == 1 ? Kb : Vb)) + t * 136 + sub * 16;
      u32x4 p0, p1;
#pragma unroll
      for (int j = 0; j < 4; j++) { p0[j] = pk2(acc[2 * j] * scale, acc[2 * j + 1] * scale); p1[j] = pk2(acc[8 + 2 * j] * scale, acc[9 + 2 * j] * scale); }
      *(u32x4*)dst = p0; *(u32x4*)(dst + 8) = p1;
    }
    __builtin_amdgcn_sched_barrier(0);
  }
  if (half == 0 && n == 63 && t0 < 144) {
    const int r = t0 / 48, piece = t0 % 48, sec = piece >> 4, c16 = piece & 15;
    *(u32x4*)(stash + (size_t)((bl * 8 + hh) * 3 + r) * 384 + sec * 128 + c16 * 8) =
        *(const u32x4*)(R + (size_t)(bl * 4096 + 4093 + r) * 3584 + sec * 1024 + hh * 128 + c16 * 8);
  }
}

#define LDS_BAR() do { asm volatile("s_waitcnt lgkmcnt(0)" ::: "memory"); __builtin_amdgcn_s_barrier(); asm volatile("" ::: "memory"); } while (0)

DI void prep_phase(const bf16_t* __restrict__ R, const float* __restrict__ ab, const float* __restrict__ cw, const float* __restrict__ a_log,
                   const float* __restrict__ dt_bias, char* __restrict__ ops, float* __restrict__ glbuf, bf16_t* __restrict__ stash, int half, char* smem) {
  const int bx_ = obid(), G_ = ogrid(); (void)bx_; (void)G_;
  R = lp(R);
  ab = lp(ab);
  cw = lp(cw);
  a_log = lp(a_log);
  dt_bias = lp(dt_bias);
  ops = lp(ops);
  glbuf = lp(glbuf);
  stash = lp(stash);
  smem += zoff();
  float* Af = (float*)(smem + P_AF); bf16_t* Wb = (bf16_t*)(smem + P_WB); bf16_t* QKb = (bf16_t*)(smem + P_QK);
  float* WL = (float*)(smem + P_WL);
  if (bx_ < 2048) prep_loadw(cw, bx_, WL, otid(), 512);
  LDS_BAR();
  int k = -1;
  for (int ci = bx_ - G_; ci < 2048; ci += G_, k++) {
    const bool live = ci >= 0;
    const int tid = otid(), lane = tid & 63, wid = tid >> 6, fr = lane & 15, fq = lane >> 4;
    char* sb = smem + P_SET0 + (k & 1) * P_SET;
    const float* gc = (const float*)sb; const float* be = gc + 64; const float* eg = gc + 128; const float* ek = gc + 192;
    const bf16_t* Kb = (const bf16_t*)(sb + 1024); const bf16_t* Qb = Kb + 64 * 136; const bf16_t* Vb = Qb + 64 * 136;
    char* op = ops + (size_t)ci * OPS_STRIDE;
    if (live) {
      const int it = wid & 3, which = wid >> 2;
      const bf16_t* X = which ? Qb : Kb;
      bf16x8 af[4];
#pragma unroll
      for (int ks = 0; ks < 4; ks++) af[ks] = *(const bf16x8*)(X + (16 * it + fr) * 136 + 32 * ks + 8 * fq);
#pragma unroll
      for (int jt = 0; jt < 4; jt++) {
        f32x4 a = (f32x4){0.f, 0.f, 0.f, 0.f};
#pragma unroll
        for (int ks = 0; ks < 4; ks++) a = mfma16(af[ks], *(const bf16x8*)(Kb + (16 * jt + fr) * 136 + 32 * ks + 8 * fq), a);
        const int j = 16 * jt + fr;
        const float gj = gc[j];
#pragma unroll
        for (int ii = 0; ii < 4; ii++) {
          const int i = 16 * it + 4 * fq + ii;
          const float dec = __expf(fminf(gc[i] - gj, 0.f));
          if (which == 0) Af[i * 64 + j] = (j < i) ? be[i] * a[ii] * dec : 0.f;
          else QKb[i * 72 + j] = f2bf((j <= i) ? a[ii] * dec : 0.f);
        }
      }
    }
    LDS_BAR();
    if (tid < 256) {
      if (live) {
      const int col = tid;
      float Uv[64];
      const bool isv = col < 128;
      const bf16_t* xs = isv ? (Vb + col) : (Kb + (col - 128));
#pragma unroll
      for (int i = 0; i < 64; i++) { Uv[i] = bf2f(xs[i * 136]) * (be[i] * (isv ? 1.f : eg[i])); asm volatile("" : "+v"(Uv[i])); }
      __builtin_amdgcn_sched_barrier(0);
      f32x4 ac[16], an[16];
      ac[0] = *(const f32x4*)(Af + 1 * 64);
#pragma unroll
      for (int i = 1; i < 64; i++) {
        if (i + 1 < 64) {
#pragma unroll
          for (int j4 = 0; j4 < (i + 1 + 3) / 4; j4++) an[j4] = *(const f32x4*)(Af + (i + 1) * 64 + j4 * 4);
        }
        __builtin_amdgcn_sched_barrier(0);
        float xv = Uv[i], xw = 0.f, xy = 0.f, xz = 0.f;
#pragma unroll
        for (int j4 = 0; j4 < (i + 3) / 4; j4++) {
          const f32x4 a = ac[j4];
          if (j4 * 4 + 0 < i) xv -= a[0] * Uv[j4 * 4 + 0];
          if (j4 * 4 + 1 < i) xw -= a[1] * Uv[j4 * 4 + 1];
          if (j4 * 4 + 2 < i) xy -= a[2] * Uv[j4 * 4 + 2];
          if (j4 * 4 + 3 < i) xz -= a[3] * Uv[j4 * 4 + 3];
        }
        Uv[i] = (xv + xw) + (xy + xz);
        __builtin_amdgcn_sched_barrier(0);
        if (i + 1 < 64) {
#pragma unroll
          for (int j4 = 0; j4 < (i + 1 + 3) / 4; j4++) ac[j4] = an[j4];
        }
      }
      if (col < 128) {
        const int w8 = col >> 4, lo = col & 15;
#pragma unroll
        for (int ct = 0; ct < 4; ct++)
#pragma unroll
          for (int jq = 0; jq < 4; jq++)
            *(u32x2*)(op + 57344 + (((w8 * 4 + ct) * 64 + jq * 16 + lo) * 8)) = (u32x2){pk2(Uv[16 * ct + 4 * jq], Uv[16 * ct + 4 * jq + 1]), pk2(Uv[16 * ct + 4 * jq + 2], Uv[16 * ct + 4 * jq + 3])};
      } else {
#pragma unroll
        for (int i = 0; i < 64; i++) Wb[i * 136 + col - 128] = f2bf(Uv[i]);
      }
      }
    } else {
      const int t2 = tid - 256;
      if (live) {
#pragma unroll
      for (int i = 0; i < 4; i++) {
        const int idx = t2 + 256 * i, frag = idx >> 6, ln = idx & 63, ct = frag >> 2, m = frag & 3, r = ln & 15, jq = ln >> 4;
        const int c = 16 * ct + r, d0 = 32 * m + 4 * jq;
        const u32x2 lo = *(const u32x2*)(Qb + c * 136 + d0), hi = *(const u32x2*)(Qb + c * 136 + d0 + 16);
        const float e = eg[c];
        *(u32x4*)(op + 16384 + idx * 16) = (u32x4){pk2(lo2f(lo[0]) * e, hi2f(lo[0]) * e), pk2(lo2f(lo[1]) * e, hi2f(lo[1]) * e), pk2(lo2f(hi[0]) * e, hi2f(hi[0]) * e), pk2(lo2f(hi[1]) * e, hi2f(hi[1]) * e)};
      }
#pragma unroll
      for (int i = 0; i < 4; i++) {
        const int idx = t2 + 256 * i, frag = idx >> 6, ln = idx & 63, dt = frag >> 1, kk = frag & 1, r = ln & 15, jq = ln >> 4;
        const int d = 16 * dt + r;
        float v[8];
#pragma unroll
        for (int j = 0; j < 8; j++) { const int c = 32 * kk + 16 * (j >> 2) + 4 * jq + (j & 3); v[j] = bf2f(Kb[c * 136 + d]) * ek[c]; }
        *(u32x4*)(op + 40960 + idx * 16) = (u32x4){pk2(v[0], v[1]), pk2(v[2], v[3]), pk2(v[4], v[5]), pk2(v[6], v[7])};
      }
#pragma unroll
      for (int i = 0; i < 2; i++) {
        const int idx = t2 + 256 * i, frag = idx >> 6, ln = idx & 63, ct = frag >> 1, kk = frag & 1, r = ln & 15, jq = ln >> 4;
        const int row = 16 * ct + r, c0 = 32 * kk + 4 * jq;
        const u32x2 lo = *(const u32x2*)(QKb + row * 72 + c0), hi = *(const u32x2*)(QKb + row * 72 + c0 + 16);
        *(u32x4*)(op + 32768 + idx * 16) = (u32x4){lo[0], lo[1], hi[0], hi[1]};
      }
      }
      if (ci + G_ < 2048) prep_conv(R, ab, WL + ((k + 1) & 1) * 1536, a_log, dt_bias, glbuf, stash, half, ci + G_, smem + P_SET0 + ((k + 1) & 1) * P_SET, t2, 256);
      if (ci + 2 * G_ < 2048) prep_loadw(cw, ci + 2 * G_, WL + (k & 1) * 1536, t2, 256);
    }
    LDS_BAR();
    if (live)
#pragma unroll
    for (int i = 0; i < 2; i++) {
      const int idx = tid + 512 * i, frag = idx >> 6, ln = idx & 63, ct = frag >> 2, m = frag & 3, r = ln & 15, jq = ln >> 4;
      const int c = 16 * ct + r, d0 = 32 * m + 4 * jq;
      const u32x2 lo = *(const u32x2*)(Wb + c * 136 + d0), hi = *(const u32x2*)(Wb + c * 136 + d0 + 16);
      *(u32x4*)(op + idx * 16) = (u32x4){lo[0], lo[1], hi[0], hi[1]};
    }
  }
  LDS_BAR();
}

DI void scan_block(const char* __restrict__ ops, const float* __restrict__ glbuf, bf16_t* __restrict__ mix, float* __restrict__ ssq,
                   f32x4* __restrict__ stbuf, int half, char* smem) {
  const int bx_ = obid(), G_ = ogrid(); (void)bx_; (void)G_;
  ops = lp(ops);
  glbuf = lp(glbuf);
  mix = lp(mix);
  ssq = lp(ssq);
  stbuf = lp(stbuf);
  smem += zoff();
  const int tid = otid(), lane = tid & 63, w = tid >> 6, fr = lane & 15, fq = lane >> 4;
  const bool comp = w < 4;
  const int blk = bx_, bl = blk >> 3, hh = blk & 7;
  const int chunk0 = (bl * 8 + hh) * 64;
  const int tokbase = bl * 8192 + half * 4096;
  const char* cp = ops + (size_t)chunk0 * OPS_STRIDE;
  float* part = (float*)(smem + 114688);
  {
    u32x4 pr0[7];
#pragma unroll
    for (int i = 0; i < 7; i++) pr0[i] = ((const u32x4*)cp)[tid + 512 * i];
    __builtin_amdgcn_sched_barrier(0);
#pragma unroll
    for (int i = 0; i < 7; i++) ((u32x4*)smem)[tid + 512 * i] = pr0[i];
  }
  __syncthreads();
  if (!comp) {
    const int t2 = tid - 256;
    u32x4 sx[14], sy[14];
    {
      const u32x4* np = (const u32x4*)(cp + (size_t)1 * OPS_STRIDE);
#pragma unroll
      for (int i = 0; i < 14; i++) sy[i] = np[t2 + 256 * i];
    }
    for (int n = 0; n < 64; n += 2) {
      if (n + 2 < 64) {
        const u32x4* np = (const u32x4*)(cp + (size_t)(n + 2) * OPS_STRIDE);
#pragma unroll
        for (int i = 0; i < 14; i++) sx[i] = np[t2 + 256 * i];
      }
      {
        u32x4* nb = (u32x4*)(smem + 57344);
#pragma unroll
        for (int i = 0; i < 14; i++) nb[t2 + 256 * i] = sy[i];
      }
      asm volatile("s_waitcnt lgkmcnt(0)" ::: "memory");
      __builtin_amdgcn_s_barrier();
      asm volatile("" ::: "memory");
      if (n + 3 < 64) {
        const u32x4* np = (const u32x4*)(cp + (size_t)(n + 3) * OPS_STRIDE);
#pragma unroll
        for (int i = 0; i < 14; i++) sy[i] = np[t2 + 256 * i];
      }
      if (n + 2 < 64) {
        u32x4* nb = (u32x4*)smem;
#pragma unroll
        for (int i = 0; i < 14; i++) nb[t2 + 256 * i] = sx[i];
      }
      asm volatile("s_waitcnt lgkmcnt(0)" ::: "memory");
      __builtin_amdgcn_s_barrier();
      asm volatile("" ::: "memory");
    }
  } else {
    f32x4* stp = stbuf + ((size_t)(blk * 4 + w) * 16) * 64 + lane;
    f32x4 S[8][2]; bf16x8 sB[4][2];
#pragma unroll
    for (int i = 0; i < 8; i++)
#pragma unroll
      for (int nt = 0; nt < 2; nt++) S[i][nt] = half ? stp[(i * 2 + nt) * 64] : (f32x4){0.f, 0.f, 0.f, 0.f};
#pragma unroll
    for (int m = 0; m < 4; m++)
#pragma unroll
      for (int nt = 0; nt < 2; nt++) sB[m][nt] = pack8(S[2 * m][nt], S[2 * m + 1][nt]);
    u32x2 uf[4][2];
#pragma unroll
    for (int ct = 0; ct < 4; ct++)
#pragma unroll
      for (int nt = 0; nt < 2; nt++) uf[ct][nt] = *(const u32x2*)(cp + 57344 + (((2 * w + nt) * 4 + ct) * 64 + lane) * 8);
    float gl = glbuf[chunk0];
    for (int n = 0; n < 64; n++) {
      const char* buf = smem + (n & 1) * 57344;
      if (n > 0 && lane < 16) {
        const float* pp = part + ((n - 1) & 1) * 256 + 16 * w + lane;
        ssq[(size_t)(tokbase + (n - 1) * 64 + 16 * w + lane) * 8 + hh] = pp[0] + pp[64] + pp[128] + pp[192];
      }
      bf16x8 vB[2][2];
      {
        f32x4 vn[4][2];
#pragma unroll
        for (int ct = 0; ct < 4; ct++) {
          f32x4 t0 = (f32x4){0.f, 0.f, 0.f, 0.f}, t1 = t0;
#pragma unroll
          for (int m = 0; m < 4; m++) {
            const bf16x8 a = *(const bf16x8*)(buf + ((ct * 4 + m) * 64 + lane) * 16);
            t0 = mfma16(a, sB[m][0], t0); t1 = mfma16(a, sB[m][1], t1);
          }
          vn[ct][0] = (f32x4){lo2f(uf[ct][0][0]) - t0[0], hi2f(uf[ct][0][0]) - t0[1], lo2f(uf[ct][0][1]) - t0[2], hi2f(uf[ct][0][1]) - t0[3]};
          vn[ct][1] = (f32x4){lo2f(uf[ct][1][0]) - t1[0], hi2f(uf[ct][1][0]) - t1[1], lo2f(uf[ct][1][1]) - t1[2], hi2f(uf[ct][1][1]) - t1[3]};
        }
#pragma unroll
        for (int kk = 0; kk < 2; kk++)
#pragma unroll
          for (int nt = 0; nt < 2; nt++) vB[kk][nt] = pack8(vn[2 * kk][nt], vn[2 * kk + 1][nt]);
      }
      const float glc = gl;
      if (n + 1 < 64) {
        const char* np = cp + (size_t)(n + 1) * OPS_STRIDE;
#pragma unroll
        for (int ct = 0; ct < 4; ct++)
#pragma unroll
          for (int nt = 0; nt < 2; nt++) uf[ct][nt] = *(const u32x2*)(np + 57344 + (((2 * w + nt) * 4 + ct) * 64 + lane) * 8);
        gl = glbuf[chunk0 + n + 1];
      }
      __builtin_amdgcn_sched_barrier(0);
      float v[16];
      {
        bf16_t* mp = mix + (size_t)(tokbase + n * 64) * 1536 + hh * 128 + 32 * w + fr;
#pragma unroll
        for (int ct = 0; ct < 4; ct++) {
          f32x4 t0 = (f32x4){0.f, 0.f, 0.f, 0.f}, t1 = t0;
#pragma unroll
          for (int m = 0; m < 4; m++) {
            const bf16x8 a = *(const bf16x8*)(buf + 16384 + ((ct * 4 + m) * 64 + lane) * 16);
            t0 = mfma16(a, sB[m][0], t0); t1 = mfma16(a, sB[m][1], t1);
          }
#pragma unroll
          for (int kk = 0; kk < 2; kk++) {
            const bf16x8 a = *(const bf16x8*)(buf + 32768 + ((ct * 2 + kk) * 64 + lane) * 16);
            t0 = mfma16(a, vB[kk][0], t0); t1 = mfma16(a, vB[kk][1], t1);
          }
#pragma unroll
          for (int ii = 0; ii < 4; ii++) {
            const bf16_t b0 = f2bf(t0[ii]), b1 = f2bf(t1[ii]);
            bf16_t* rp = mp + (size_t)(16 * ct + 4 * fq + ii) * 1536;
            rp[0] = b0; rp[16] = b1;
            const float f0 = bf2f(b0), f1 = bf2f(b1);
            v[ct * 4 + ii] = f0 * f0 + f1 * f1;
          }
        }
      }
      __builtin_amdgcn_sched_barrier(0);
#pragma unroll
      for (int dt = 0; dt < 8; dt++) {
        f32x4 t0 = S[dt][0] * glc, t1 = S[dt][1] * glc;
#pragma unroll
        for (int kk = 0; kk < 2; kk++) {
          const bf16x8 a = *(const bf16x8*)(buf + 40960 + ((dt * 2 + kk) * 64 + lane) * 16);
          t0 = mfma16(a, vB[kk][0], t0); t1 = mfma16(a, vB[kk][1], t1);
        }
        S[dt][0] = t0; S[dt][1] = t1;
      }
#pragma unroll
      for (int m = 0; m < 4; m++)
#pragma unroll
        for (int nt = 0; nt < 2; nt++) sB[m][nt] = pack8(S[2 * m][nt], S[2 * m + 1][nt]);
      __builtin_amdgcn_sched_barrier(0);
#pragma unroll
      for (int st = 8; st >= 1; st >>= 1) {
        const bool hiL = (fr & st) != 0;
#pragma unroll
        for (int k = 0; k < st; k++) {
          const float keep = hiL ? v[k + st] : v[k];
          const float send = hiL ? v[k] : v[k + st];
          v[k] = keep + __shfl_xor(send, st);
        }
      }
      part[(n & 1) * 256 + w * 64 + 16 * (fr >> 2) + 4 * fq + (fr & 3)] = v[0];
      asm volatile("s_waitcnt lgkmcnt(0)" ::: "memory");
      __builtin_amdgcn_s_barrier();
      asm volatile("" ::: "memory");
    }
    if (lane < 16) {
      const float* pp = part + (63 & 1) * 256 + 16 * w + lane;
      ssq[(size_t)(tokbase + 63 * 64 + 16 * w + lane) * 8 + hh] = pp[0] + pp[64] + pp[128] + pp[192];
    }
    if (half == 0) {
#pragma unroll
      for (int i = 0; i < 8; i++)
#pragma unroll
        for (int nt = 0; nt < 2; nt++) stp[(i * 2 + nt) * 64] = S[i][nt];
    }
  }
  __syncthreads();
}

#define XB_TMO      128
#define XB_XCNT(j)  (256  + 64 * (j))
#define XB_XSUB(j)  (1280 + 64 * (j))
#define XB_XGEN(j)  (2304 + 64 * (j))
#define XB_TOP      3328
#define XB_TOPGEN   3392
#define XCD_BAR_WORDS 3456
#define XB_SPIN_CAP (1u << 18)

__device__ __forceinline__ unsigned xb_ld(unsigned* p)              { return __hip_atomic_load(p, __ATOMIC_RELAXED, __HIP_MEMORY_SCOPE_AGENT); }
__device__ __forceinline__ unsigned xb_add(unsigned* p, unsigned v) { return __hip_atomic_fetch_add(p, v, __ATOMIC_RELAXED, __HIP_MEMORY_SCOPE_AGENT); }
__device__ __forceinline__ unsigned xb_xcc_id() { return (unsigned)__builtin_amdgcn_s_getreg((3 << 11) | 20) & 0xFu; }
#define XB_SPIN(cond, bar) do { unsigned _sp = 0; while (cond) { __builtin_amdgcn_s_sleep(1); \
    if ((++_sp & 255u) == 0u) { if (xb_ld(&(bar)[XB_TMO])) break; if (_sp > XB_SPIN_CAP) { atomicAdd(&(bar)[XB_TMO], 1u); break; } } } } while (0)

struct XcdBarrier {
    unsigned* bar; unsigned x;
    volatile LAS unsigned* st;
};

__device__ __forceinline__ XcdBarrier xcd_barrier_post(unsigned* bar, volatile LAS unsigned* st) {
    XcdBarrier b; b.bar = bar; b.x = xb_xcc_id(); b.st = st;
    if (threadIdx.x == 0) (void)xb_add(&bar[XB_XCNT(b.x)], 1u);
    return b;
}
__device__ __forceinline__ void xcd_barrier_complete(unsigned* bar, unsigned x, unsigned& nloc, unsigned& nx) {
    const unsigned G = gridDim.x * gridDim.y * gridDim.z;
    unsigned sum, cnt, mine, sp = 0u;
    for (;;) {
        sum = 0u; cnt = 0u; mine = 0u;
#pragma unroll
        for (unsigned j = 0; j < 16; ++j) { const unsigned c = xb_ld(&bar[XB_XCNT(j)]); sum += c; cnt += (c > 0u) ? 1u : 0u; mine = (j == x) ? c : mine; }
        if (sum == G) break;
        __builtin_amdgcn_s_sleep(1);
        if ((++sp & 255u) == 0u) { if (xb_ld(&bar[XB_TMO])) break; if (sp > XB_SPIN_CAP) { atomicAdd(&bar[XB_TMO], 1u); break; } }
    }
    nloc = mine > 0u ? mine : 1u; nx = cnt > 0u ? cnt : 1u;
}

__device__ __forceinline__ void xcd_barrier(const XcdBarrier& b) {
    asm volatile("s_waitcnt vmcnt(0)" ::: "memory");
    __syncthreads();
    if (threadIdx.x == 0) {
        unsigned* bar = b.bar;
        __builtin_amdgcn_s_waitcnt(0);
        unsigned nloc = b.st[0], nx = b.st[1];
        if (nloc == 0u) { xcd_barrier_complete(bar, b.x, nloc, nx); b.st[0] = nloc; b.st[1] = nx; }
        const unsigned old = xb_add(&bar[XB_XSUB(b.x)], 1u);
        const unsigned gen = old / nloc;
        if (old + 1u == (gen + 1u) * nloc) {
            __builtin_amdgcn_fence(__ATOMIC_RELEASE, "agent");
            asm volatile("s_waitcnt vmcnt(0)" ::: "memory");
            const unsigned og = xb_add(&bar[XB_TOP], 1u);
            const unsigned tg = og / nx;
            if (og + 1u == (tg + 1u) * nx) xb_add(&bar[XB_TOPGEN], 1u);
            else XB_SPIN(xb_ld(&bar[XB_TOPGEN]) == tg, bar);
            __builtin_amdgcn_fence(__ATOMIC_ACQUIRE, "agent");
            xb_add(&bar[XB_XGEN(b.x)], 1u);
            asm volatile("s_waitcnt vmcnt(0)" ::: "memory");
        } else {
            XB_SPIN(xb_ld(&bar[XB_XGEN(b.x)]) == gen, bar);
            __builtin_amdgcn_fence(__ATOMIC_ACQUIRE, "agent");
            asm volatile("s_waitcnt vmcnt(0)" ::: "memory");
        }
    }
    __syncthreads();
}

constexpr int PRM_NPRE = 0, PRM_NPOST = 4096, PRM_ALNW = 8192, PRM_ALNB = 10240, PRM_ABS = 12288, PRM_BCW = 14336, PRM_CCW = 17408, PRM_CALOG = 29696, PRM_CDT = 29704, PRM_CONW = 29712;
#define WS_PTRS(ws) \
  const float* PRM = (const float*)(ws + OFF_PRM); \
  bf16_t* W2 = (bf16_t*)(ws + OFF_W2); \
  bf16_t* WO = (bf16_t*)(ws + OFF_WO); \
  bf16_t* WM = (bf16_t*)(ws + OFF_WM); \
  bf16_t* WS = (bf16_t*)(ws + OFF_WS); \
  bf16_t* HMEM = (bf16_t*)(ws + OFF_HMEM); \
  bf16_t* KIMG = (bf16_t*)(ws + OFF_KIMG); \
  bf16_t* VIMG = (bf16_t*)(ws + OFF_VIMG); \
  float* AB = (float*)(ws + OFF_AB); \
  float* SSQ = (float*)(ws + OFF_SSQ); \
  float* GL = (float*)(ws + OFF_GL); \
  f32x4* STB = (f32x4*)(ws + OFF_ST); \
  bf16_t* STASH = (bf16_t*)(ws + OFF_STASH); \
  bf16_t* H = (bf16_t*)(ws + OFF_H); \
  bf16_t* MIX = (bf16_t*)(ws + OFF_MIX); \
  char* BIG = ws + OFF_BIG;
__global__ void __launch_bounds__(512) mega_kernel(Params p) {
  __shared__ __attribute__((aligned(16))) char smem[LDS_BYTES];
  cg::grid_group grid = cg::this_grid();
  char* ws0 = p.ws;
  volatile LAS unsigned* xst = (volatile LAS unsigned*)(LAS unsigned char*)(smem + XST_OFF);
  if (threadIdx.x < 2) xst[threadIdx.x] = 0u;
  __syncthreads();
  const XcdBarrier xb = xcd_barrier_post((unsigned*)(ws0 + OFF_BAR), xst);

  {
  char* ws = lp(ws0);
  WS_PTRS(ws)
  conv_seg(p.a_w_in, 4096, 0, 2560, (bf16_t*)(ws + OFF_W1_0), 1024, smem);
  conv_seg(p.a_w_in, 4096, 2560, 1536, W2, 1024, smem);
  conv_seg(p.a_w_in + 1024 * 4096, 4096, 0, 2560, (bf16_t*)(ws + OFF_W1_3), 1024, smem);
  conv_seg(p.a_w_in + 1024 * 4096, 4096, 2560, 1536, W2 + 3 * 1536 * 1024, 1024, smem);
  conv_seg(p.b_w_in, 5120, 0, 3584, (bf16_t*)(ws + OFF_W1_1), 1024, smem);
  conv_seg(p.b_w_in, 5120, 3584, 1536, W2 + 1 * 1536 * 1024, 1024, smem);
  conv_seg(p.c_w_in, 5136, 0, 3072, ((bf16_t*)(ws + OFF_W1_2)), 1024, smem);
  conv_seg(p.c_w_in, 5136, 3088, 512, ((bf16_t*)(ws + OFF_W1_2)) + 3072 * 1024, 1024, smem);
  conv_seg(p.c_w_in, 5136, 3072, 16, ((bf16_t*)(ws + OFF_W1_2)) + 3584 * 1024, 1024, smem);
  conv_seg(p.c_w_in, 5136, 3600, 1536, W2 + 2 * 1536 * 1024, 1024, smem);
  for (int l = 0; l < 4; l++) conv_seg(p.w_out + (size_t)l * 1536 * 1024, 1024, 0, 1024, WO + (size_t)l * 1024 * 1536, 1536, smem);
  conv_seg(p.w_mem_kv, 1024, 0, 1024, WM, 1024, smem);
  for (int i = blockIdx.x * 512 + otid(); i < 240 * 1024 / 2; i += gridDim.x * 512) ((unsigned*)(((bf16_t*)(ws + OFF_W1_2)) + 3600 * 1024))[i] = 0u;
  for (int i = blockIdx.x * 512 + otid(); i < 2 * 8 * 128 * 128; i += gridDim.x * 512) {
    const int s = i & 127, t = (i >> 7) & 127;
    WS[i] = (s <= t) ? f2bf(p.a_w_s[i]) : (bf16_t)0;
  }
  {
    float* prm = (float*)(ws + OFF_PRM);
    const int gt = blockIdx.x * 512 + otid(), gs = gridDim.x * 512;
    for (int i = gt; i < 4096; i += gs) { prm[PRM_NPRE + i] = p.norm_pre[i]; prm[PRM_NPOST + i] = p.norm_post[i]; }
    for (int i = gt; i < 2048; i += gs) { prm[PRM_ALNW + i] = p.a_ln_w[i]; prm[PRM_ALNB + i] = p.a_ln_b[i]; prm[PRM_ABS + i] = p.a_b_s[i]; }
    for (int i = gt; i < 3072; i += gs) prm[PRM_BCW + i] = p.b_conv_w[i];
    for (int i = gt; i < 12288; i += gs) prm[PRM_CCW + i] = p.c_conv_w[i];
    for (int i = gt; i < 8; i += gs) { prm[PRM_CALOG + i] = p.c_a_log[i]; prm[PRM_CDT + i] = p.c_dt_bias[i]; }
    for (int i = gt; i < 128; i += gs) prm[PRM_CONW + i] = p.c_o_norm_w[i];
  }
  rmsnorm_rows(p.x, p.norm_pre, H, NTOK);
  rmsnorm_rows(p.mem, p.mem_norm_w, HMEM, 1024);
  }
  grid.sync();

  for (int ph = 0; ph < 23; ph++) {
    char* ws = lp(ws0);
    WS_PTRS(ws)
    int l, q;
    if (ph < 5) { l = 0; q = ph; } else if (ph < 10) { l = 1; q = ph - 5; } else if (ph < 18) { l = 2; q = ph - 10; } else { l = 3; q = ph - 18; }
    const int kind = l % 3;
    int op, hf = 0;
    if (kind == 2) { op = q == 0 ? 0 : q == 1 ? 1 : q == 2 ? 6 : q == 3 ? 1 : q == 4 ? 7 : q == 5 ? 8 : q == 6 ? 4 : 5; hf = q >= 3 ? 1 : 0; }
    else op = q == 0 ? 0 : (q == 1 ? 2 : q + 1);
    const int bx = blockIdx.x, G = gridDim.x;
    const bool scanblk = (op == 6 || op == 7) && bx < 32;
    if (op == 0 || (op == 6 && !scanblk)) {
      const bf16_t* W1l = (const bf16_t*)(ws + (l == 0 ? OFF_W1_0 : l == 1 ? OFF_W1_1 : l == 2 ? OFF_W1_2 : OFF_W1_3));
      if (kind == 0) {
        EpiA1 e{(bf16_t*)BIG, (bf16_t*)(BIG + BIG_VT), (bf16_t*)(BIG + BIG_QX)};
        gemm_phase(H, W1l, NTOK, 2560, 1024, e, smem);
      } else if (kind == 1) {
        EpiPlain e{(bf16_t*)BIG, 3584};
        gemm_phase(H, W1l, NTOK, 3584, 1024, e, smem);
      } else {
        const int g1h = op == 6 ? 1 : 0;
        EpiC1 e{(bf16_t*)BIG, AB, g1h * 4096};
        gemm_phase(H, W1l, 16384, 3840, 1024, e, smem, g1h * 4096, op == 6 ? G - 32 : -1, bx - 32);
      }
      if (l == 0) {
        EpiMem e{KIMG, VIMG};
        gemm_phase(HMEM, WM, 1024, 1024, 1024, e, smem);
      }
    }
    if (op == 1) prep_phase((const bf16_t*)BIG, AB, PRM + PRM_CCW, PRM + PRM_CALOG, PRM + PRM_CDT, BIG + BIG_OPS, GL, STASH, hf, smem);
    if (op == 2) {
      if (kind == 0) {
        const int j = l / 3;
        gmlp_phase((const bf16_t*)BIG, (const bf16_t*)(BIG + BIG_VT), WS + (size_t)j * 8 * 128 * 128, PRM + PRM_ALNW + j * 1024, PRM + PRM_ALNB + j * 1024,
                   PRM + PRM_ABS + j * 1024, MIX, smem);
      } else {
        sconv_phase((const bf16_t*)BIG, PRM + PRM_BCW, MIX);
      }
    }
    if (scanblk) scan_block(BIG + BIG_OPS, GL, MIX, SSQ, STB, op == 6 ? 0 : 1, smem);
    if (op == 1 || op == 2) {
      const bf16_t* Q; int ldq, tok0, nrows;
      if (kind == 0) { Q = (const bf16_t*)(BIG + BIG_QX); ldq = 512; tok0 = -1; nrows = NTOK; }
      else if (kind == 1) { Q = (const bf16_t*)BIG + 3072; ldq = 3584; tok0 = -1; nrows = NTOK; }
      else { Q = (const bf16_t*)BIG + 3072; ldq = 3584; tok0 = hf * 4096; nrows = 16384; }
      attn_phase(Q, ldq, tok0, nrows, KIMG, VIMG, MIX, bx, G, smem);
    }
    if (op == 3 || op == 8 || (op == 7 && !scanblk)) {
      const int nv = op == 7 ? 2 : 1;
      for (int v = 0; v < nv; v++) {
        const bf16_t* Bz = W2 + (size_t)l * 1536 * 1024;
        int M = NTOK, N = 1536, asplit = -1, col0 = 0;
        if (op == 7 && v == 0) { Bz += (size_t)1024 * 1024; N = 512; col0 = 1024; }
        if ((op == 7 && v == 1) || op == 8) { M = 16384; N = 1024; asplit = op == 8 ? 4096 : 0; }
        EpiGate e{MIX, SSQ, PRM + PRM_CONW, kind == 2 ? 1 : 0, col0, asplit};
        gemm_phase(H, Bz, M, N, 1024, e, smem, asplit, op == 7 ? G - 32 : -1, bx - 32);
      }
    }
    if (op == 4) {
      EpiOut e{(bf16_t*)BIG};
      gemm_phase(MIX, WO + (size_t)l * 1024 * 1536, NTOK, 1024, 1536, e, smem);
    }
    if (op == 5) {
      norm_phase((const bf16_t*)BIG, l == 0 ? p.x : p.out, p.out, PRM + PRM_NPOST + l * 1024, l < 3 ? PRM + PRM_NPRE + (l + 1) * 1024 : nullptr, H);
    }
    xcd_barrier(xb);
  }
}

extern "C" void kernel_launch(void* const* d_in, const int* in_sizes, int n_in, void* d_out, int out_size, void* d_ws, size_t ws_size,
                              hipStream_t stream) {
  static int grid_blocks = 0;
  if (!grid_blocks) {
    int dev = 0, cus = 0, per_cu = 0;
    (void)hipGetDevice(&dev);
    (void)hipDeviceGetAttribute(&cus, hipDeviceAttributeMultiprocessorCount, dev);
    (void)hipOccupancyMaxActiveBlocksPerMultiprocessor(&per_cu, mega_kernel, 512, 0);
    if (per_cu > 1) per_cu = 1;
    if (per_cu < 1) per_cu = 1;
    grid_blocks = cus * per_cu;
  }
  Params p{};
  p.x = (const float*)d_in[0]; p.mem = (const float*)d_in[1]; p.mem_norm_w = (const float*)d_in[2]; p.w_mem_kv = (const float*)d_in[3];
  p.norm_pre = (const float*)d_in[4]; p.norm_post = (const float*)d_in[5]; p.w_out = (const float*)d_in[6]; p.a_w_in = (const float*)d_in[7];
  p.a_ln_w = (const float*)d_in[8]; p.a_ln_b = (const float*)d_in[9]; p.a_w_s = (const float*)d_in[10]; p.a_b_s = (const float*)d_in[11];
  p.b_w_in = (const float*)d_in[12]; p.b_conv_w = (const float*)d_in[13]; p.c_w_in = (const float*)d_in[14]; p.c_conv_w = (const float*)d_in[15];
  p.c_a_log = (const float*)d_in[16]; p.c_dt_bias = (const float*)d_in[17]; p.c_o_norm_w = (const float*)d_in[18];
  p.out = (float*)d_out;
  p.ws = (char*)d_ws;
  (void)hipMemsetAsync((char*)d_ws + OFF_BAR, 0, XCD_BAR_WORDS * sizeof(unsigned), stream);
  void* args[] = {&p};
  hipError_t e = hipLaunchCooperativeKernel((void*)mega_kernel, dim3(grid_blocks), dim3(512), args, 0, stream);
  if (e != hipSuccess) fprintf(stderr, "cooperative launch failed: %s (grid %d)\n", hipGetErrorString(e), grid_blocks);
}
```

```cpp
#include <hip/hip_runtime.h>
#include <hip/hip_cooperative_groups.h>
#include <cstdio>
namespace cg = cooperative_groups;

#define DI __device__ __forceinline__
typedef unsigned short bf16_t;
typedef short bf16x8 __attribute__((ext_vector_type(8)));
typedef float f32x4 __attribute__((ext_vector_type(4)));
typedef unsigned u32x4 __attribute__((ext_vector_type(4)));
typedef unsigned u32x2 __attribute__((ext_vector_type(2)));

constexpr int NTOK = 32768;
constexpr float EPS = 1e-6f;
constexpr int LDS_BYTES = 161856;
constexpr int OPS_STRIDE = 73728;

constexpr size_t SZ_W1A = 2560ull * 1024 * 2, SZ_W1B = 3584ull * 1024 * 2, SZ_W1C = 3840ull * 1024 * 2;
constexpr size_t OFF_W1_0 = 0;
constexpr size_t OFF_W1_1 = OFF_W1_0 + SZ_W1A;
constexpr size_t OFF_W1_2 = OFF_W1_1 + SZ_W1B;
constexpr size_t OFF_W1_3 = OFF_W1_2 + SZ_W1C;
constexpr size_t SZ_W2 = 1536ull * 1024 * 2;
constexpr size_t OFF_W2 = OFF_W1_3 + SZ_W1A;
constexpr size_t OFF_WO = OFF_W2 + 4 * SZ_W2;
constexpr size_t OFF_WM = OFF_WO + 4 * SZ_W2;
constexpr size_t OFF_WS = OFF_WM + 2097152;
constexpr size_t OFF_HMEM = OFF_WS + 524288;
constexpr size_t OFF_KIMG = OFF_HMEM + 2097152;
constexpr size_t OFF_VIMG = OFF_KIMG + 1048576;
constexpr size_t OFF_AB = OFF_VIMG + 1048576;
constexpr size_t OFF_SSQ = OFF_AB + 2097152;
constexpr size_t OFF_GL = OFF_SSQ + 1048576;
constexpr size_t OFF_ST = OFF_GL + 65536;
constexpr size_t OFF_STASH = OFF_ST + 2097152;
constexpr size_t OFF_BAR = OFF_STASH + 131072;
constexpr size_t OFF_PRM = OFF_BAR + 65536;
constexpr size_t OFF_H = OFF_PRM + 131072;
constexpr size_t OFF_MIX = OFF_H + 67108864;
constexpr size_t OFF_BIG = OFF_MIX + 100663296;
constexpr size_t BIG_VT = 67108864, BIG_QX = 134217728, BIG_OPS = 117440512;
static_assert(OFF_BIG + 268435456ull <= 536870912ull, "workspace overflow");

struct Params {
  const float *x, *mem, *mem_norm_w, *w_mem_kv, *norm_pre, *norm_post, *w_out, *a_w_in, *a_ln_w, *a_ln_b, *a_w_s, *a_b_s,
      *b_w_in, *b_conv_w, *c_w_in, *c_conv_w, *c_a_log, *c_dt_bias, *c_o_norm_w;
  float* out;
  char* ws;
};

typedef float f32x2 __attribute__((ext_vector_type(2)));
typedef __bf16 bf16x2_t __attribute__((ext_vector_type(2)));
DI unsigned pk2(float lo, float hi) { f32x2 v = {lo, hi}; bf16x2_t b = __builtin_convertvector(v, bf16x2_t); return __builtin_bit_cast(unsigned, b); }
DI float lo2f(unsigned p) { return __uint_as_float(p << 16); }
DI float hi2f(unsigned p) { return __uint_as_float(p & 0xffff0000u); }
DI float bf2f(bf16_t v) { return __uint_as_float(((unsigned)v) << 16); }
DI bf16_t f2bf(float f) { return (bf16_t)(pk2(f, 0.f) & 0xffffu); }
DI int zoff() { int z; asm volatile("s_mov_b32 %0, 0" : "=s"(z)); return z; }
DI int obid() { int r; asm volatile("s_mov_b32 %0, %1" : "=s"(r) : "s"(blockIdx.x)); return r; }
DI int ogrid() { int r; asm volatile("s_mov_b32 %0, %1" : "=s"(r) : "s"(gridDim.x)); return r; }
template <class T> DI T* lp(T* p) { return (T*)((char*)p + zoff()); }
DI int otid() { int t; asm volatile("v_mov_b32 %0, %1" : "=v"(t) : "v"(threadIdx.x)); return t; }
DI float wsum(float v) {
#pragma unroll
  for (int o = 32; o; o >>= 1) v += __shfl_xor(v, o);
  return v;
}
DI float sigmoidf_(float x) { return __builtin_amdgcn_rcpf(1.f + __expf(-x)); }
DI float siluf_(float x) { return x * sigmoidf_(x); }
DI float geluf_(float x) { const float u = 0.7978845608028654f * (x + 0.044715f * x * x * x); return x * sigmoidf_(2.f * u); }
DI f32x4 mfma16(bf16x8 a, bf16x8 b, f32x4 c) { return __builtin_amdgcn_mfma_f32_16x16x32_bf16(a, b, c, 0, 0, 0); }
DI bf16x8 pack8(f32x4 a, f32x4 b) {
  u32x4 p; p[0] = pk2(a[0], a[1]); p[1] = pk2(a[2], a[3]); p[2] = pk2(b[0], b[1]); p[3] = pk2(b[2], b[3]);
  return __builtin_bit_cast(bf16x8, p);
}
DI void unpack8(u32x4 p, float* v) {
#pragma unroll
  for (int i = 0; i < 4; i++) { v[2 * i] = lo2f(p[i]); v[2 * i + 1] = hi2f(p[i]); }
}

#define LAS __attribute__((address_space(3)))
constexpr int G_BM = 256, G_BK = 64, G_HALF = 128, G_HTB = G_HALF * G_BK * 2, G_NXCD = 8, G_WGM = 8;
DI int lds_byte(int r, int c) { const int st = (r >> 4) * 2 + (c >> 5), rr = r & 15, cc = c & 31, ob = rr * 64 + cc * 2; return st * 1024 + (ob ^ (((ob >> 9) & 1) << 5)); }
DI void stage_rc(int b, int& R, int& C) { const int st = b / 1024, sb = b % 1024, swz = sb ^ (((sb >> 9) & 1) << 5); R = (st >> 1) * 16 + swz / 64; C = (st & 1) * 32 + (swz % 64) / 2; }
struct UnitOrder {
  int nM, nN, nwg, G, c;
  DI void init(int M, int N, int G_, int c_) { nM = M / G_BM; nN = N / G_BM; nwg = nM * nN; G = G_; c = c_; }
  DI bool next(int i, int& pm, int& pn) const {
    const long L = (long)i * G + c; if (L >= nwg) return false;
    int wgid = (int)L; { const int q = nwg / G_NXCD, r = nwg % G_NXCD, xcd = wgid % G_NXCD, off = wgid / G_NXCD; wgid = (xcd < r ? xcd * (q + 1) : r * (q + 1) + (xcd - r) * q) + off; }
    const int nig = G_WGM * nN, gid = wgid / nig, fm = gid * G_WGM, gsz = (nM - fm) < G_WGM ? (nM - fm) : G_WGM;
    pm = fm + ((wgid % nig) % gsz); pn = (wgid % nig) / gsz; return true;
  }
};
template <class Epi>
DI void gemm_phase(const bf16_t* __restrict__ A, const bf16_t* __restrict__ Bt, int M, int N, int K, const Epi& epi, char* smem, int asplit = -1, int gG = -1, int gC = 0) {
  const int bx_ = obid(), G_ = ogrid(); (void)bx_; (void)G_;
  A = lp(A);
  Bt = lp(Bt);
  smem += zoff();
  LAS unsigned char* lds = (LAS unsigned char*)smem;
  const int tid = otid(), wid = __builtin_amdgcn_readfirstlane(tid >> 6), lane = tid & 63, wr = wid >> 2, wc = wid & 3, fr = lane & 15, fq = lane >> 4;
  const int nt = K / G_BK;
  unsigned voff[2];
#pragma unroll
  for (int i = 0; i < 2; ++i) { int R, C; stage_rc(tid * 16 + i * 8192, R, C); voff[i] = (unsigned)(R * K + C) * 2u; }
  const size_t kstep = (size_t)(G_BK * 2);
  const size_t hstep = (size_t)G_HALF * K * 2;
  const size_t tstep = 2 * hstep;
  const unsigned ldsw = (unsigned)wid * 1024u;
  const int aoff = lds_byte(wr * 64 + fr, fq * 8), boff = lds_byte(wc * 32 + fr, fq * 8);
#define PG8_SA(b, h) (((b) * 2 + (h)) * G_HTB)
#define PG8_SB(b, h) ((4 + (b) * 2 + (h)) * G_HTB)
#define PG8_STAGE(bufoff, gbase) do { _Pragma("unroll") for (int _i = 0; _i < 2; ++_i) \
    __builtin_amdgcn_global_load_lds((const unsigned*)((const char*)(gbase) + voff[_i]), (LAS unsigned*)(lds + (bufoff) + ldsw + _i * 8192), 16, 0, 0); } while (0)
#define PG8_LDA(dst, b, h) do { _Pragma("unroll") for (int m = 0; m < 4; ++m) _Pragma("unroll") for (int k = 0; k < 2; ++k) dst[m][k] = *(const LAS bf16x8*)(lds + PG8_SA(b, h) + aoff + m * 2048 + k * 1024); } while (0)
#define PG8_LDB(dst, b, h) do { _Pragma("unroll") for (int n = 0; n < 2; ++n) _Pragma("unroll") for (int k = 0; k < 2; ++k) dst[n][k] = *(const LAS bf16x8*)(lds + PG8_SB(b, h) + boff + n * 2048 + k * 1024); } while (0)
#define PG8_MMA(ai, bj, At, Bt_) do { __builtin_amdgcn_s_setprio(1); _Pragma("unroll") for (int m = 0; m < 4; ++m) _Pragma("unroll") for (int n = 0; n < 2; ++n) _Pragma("unroll") for (int k = 0; k < 2; ++k) \
    acc[ai][bj][m][n] = __builtin_amdgcn_mfma_f32_16x16x32_bf16(Bt_[n][k], At[m][k], acc[ai][bj][m][n], 0, 0, 0); __builtin_amdgcn_s_setprio(0); } while (0)
#define PG8_WAIT_V(n) asm volatile("s_waitcnt vmcnt(" #n ")" ::: "memory")
#define PG8_WAIT_L(n) asm volatile("s_waitcnt lgkmcnt(" #n ")" ::: "memory")
#define PG8_BAR __builtin_amdgcn_s_barrier()
#define PG8_SCHED __builtin_amdgcn_sched_barrier(0)
#define PG8_AROW(pm) ((size_t)(asplit < 0 ? (pm) * 256 : (((pm) >> 4) << 13) + asplit + (((pm) & 15) << 8)))
  UnitOrder S; S.init(M, N, gG < 0 ? G_ : gG, gG < 0 ? bx_ : gC);
  int cpm, cpn, npm = 0, npn = 0, ui = 0;
  if (!S.next(0, cpm, cpn)) return;
  f32x4 acc[2][2][4][2];
#pragma unroll
  for (int a = 0; a < 2; ++a)
#pragma unroll
    for (int b = 0; b < 2; ++b)
#pragma unroll
      for (int m = 0; m < 4; ++m)
#pragma unroll
        for (int n = 0; n < 2; ++n) acc[a][b][m][n] = (f32x4){0.f, 0.f, 0.f, 0.f};
  bf16x8 At[4][2], B0[2][2], B1[2][2];
  const char* cA = (const char*)A + PG8_AROW(cpm) * K * 2; const char* cB = (const char*)Bt + (size_t)cpn * tstep;
  PG8_STAGE(PG8_SB(0, 0), cB); PG8_STAGE(PG8_SA(0, 0), cA); PG8_STAGE(PG8_SB(0, 1), cB + hstep); PG8_STAGE(PG8_SA(0, 1), cA + hstep);
  if (wr == 1) PG8_BAR;
  PG8_WAIT_V(4); PG8_BAR;
  PG8_STAGE(PG8_SB(1, 0), cB + kstep); PG8_STAGE(PG8_SA(1, 0), cA + kstep); PG8_STAGE(PG8_SB(1, 1), cB + hstep + kstep);
  PG8_WAIT_V(6); PG8_BAR;
  for (;;) {
    const bool has_next = S.next(ui + 1, npm, npn);
    const char* nA = has_next ? (const char*)A + PG8_AROW(npm) * K * 2 : cA; const char* nB = has_next ? (const char*)Bt + (size_t)npn * tstep : cB;
    for (int t = 0; t < nt; t += 2) {
      const bool last = (t == nt - 2);
      const char* a1 = cA + (size_t)(t + 1) * kstep;
      const char* a2 = last ? nA : cA + (size_t)(t + 2) * kstep; const char* b2 = last ? nB : cB + (size_t)(t + 2) * kstep;
      const char* a3 = a2 + kstep; const char* b3 = b2 + kstep;
      PG8_LDB(B0, 0, 0); PG8_SCHED; PG8_LDA(At, 0, 0); PG8_STAGE(PG8_SA(1, 1), a1 + hstep);
      PG8_WAIT_L(8); PG8_BAR; PG8_WAIT_L(0); PG8_MMA(0, 0, At, B0); PG8_BAR; PG8_SCHED;
      PG8_LDB(B1, 0, 1); PG8_STAGE(PG8_SB(0, 0), b2);
      PG8_BAR; PG8_WAIT_L(0); PG8_MMA(0, 1, At, B1); PG8_BAR;
      PG8_LDA(At, 0, 1); PG8_STAGE(PG8_SA(0, 0), a2);
      PG8_BAR; PG8_WAIT_L(0); PG8_MMA(1, 0, At, B0); PG8_BAR; PG8_SCHED;
      PG8_STAGE(PG8_SB(0, 1), b2 + hstep);
      PG8_WAIT_V(6); PG8_BAR; PG8_MMA(1, 1, At, B1); PG8_BAR;
      PG8_LDB(B0, 1, 0); PG8_SCHED; PG8_LDA(At, 1, 0); PG8_STAGE(PG8_SA(0, 1), a2 + hstep);
      PG8_WAIT_L(8); PG8_BAR; PG8_WAIT_L(0); PG8_MMA(0, 0, At, B0); PG8_BAR; PG8_SCHED;
      PG8_LDB(B1, 1, 1); PG8_STAGE(PG8_SB(1, 0), b3);
      PG8_BAR; PG8_WAIT_L(0); PG8_MMA(0, 1, At, B1); PG8_BAR;
      PG8_LDA(At, 1, 1); PG8_STAGE(PG8_SA(1, 0), a3);
      PG8_BAR; PG8_WAIT_L(0); PG8_MMA(1, 0, At, B0); PG8_BAR; PG8_SCHED;
      PG8_STAGE(PG8_SB(1, 1), b3 + hstep);
      PG8_WAIT_V(6); PG8_BAR; PG8_MMA(1, 1, At, B1); PG8_BAR;
    }
    if constexpr (Epi::PRELOAD) {
#pragma unroll
      for (int ai = 0; ai < 2; ++ai) {
        u32x4 pre[4][2][2];
#pragma unroll
        for (int m = 0; m < 4; ++m)
#pragma unroll
          for (int bj = 0; bj < 2; ++bj)
#pragma unroll
            for (int n = 0; n < 2; ++n)
              pre[m][bj][n] = epi.pre(cpm * 256 + ai * 128 + wr * 64 + m * 16 + fr, cpn * 256 + bj * 128 + wc * 32 + n * 16 + fq * 4);
        __builtin_amdgcn_sched_barrier(0);
#pragma unroll
        for (int m = 0; m < 4; ++m)
#pragma unroll
          for (int bj = 0; bj < 2; ++bj)
#pragma unroll
            for (int n = 0; n < 2; ++n)
              epi.fin(cpm * 256 + ai * 128 + wr * 64 + m * 16 + fr, cpn * 256 + bj * 128 + wc * 32 + n * 16 + fq * 4, acc[ai][bj][m][n], pre[m][bj][n]);
      }
    } else {
#pragma unroll
    for (int ai = 0; ai < 2; ++ai)
#pragma unroll
      for (int m = 0; m < 4; ++m)
#pragma unroll
        for (int bj = 0; bj < 2; ++bj)
#pragma unroll
          for (int n = 0; n < 2; ++n)
            epi(cpm * 256 + ai * 128 + wr * 64 + m * 16 + fr, cpn * 256 + bj * 128 + wc * 32 + n * 16 + fq * 4, acc[ai][bj][m][n]);
    }
    if (!has_next) break;
#pragma unroll
    for (int a = 0; a < 2; ++a)
#pragma unroll
      for (int b = 0; b < 2; ++b)
#pragma unroll
        for (int m = 0; m < 4; ++m)
#pragma unroll
          for (int n = 0; n < 2; ++n) acc[a][b][m][n] = (f32x4){0.f, 0.f, 0.f, 0.f};
    cpm = npm; cpn = npn; cA = nA; cB = nB; ++ui;
  }
  PG8_WAIT_V(0);
  if (wr == 0) PG8_BAR;
  PG8_BAR;
#undef PG8_SA
#undef PG8_SB
#undef PG8_STAGE
#undef PG8_LDA
#undef PG8_LDB
#undef PG8_MMA
#undef PG8_WAIT_V
#undef PG8_WAIT_L
#undef PG8_BAR
#undef PG8_SCHED
#undef PG8_AROW
}

struct EpiMem {
  static constexpr bool PRELOAD = false;
  bf16_t *kimg, *vimg;
  DI void operator()(int row, int col, f32x4 v) const {
    const int b = row >> 8, m = row & 255;
    const int cb = __builtin_amdgcn_readfirstlane(col & ~127);
    if (cb < 512) {
      const int head = col >> 7, d = col & 127;
      const int mt = m >> 4, n = m & 15, ks = d >> 5, jq = (d & 31) >> 3, j = d & 7;
      bf16_t* p = kimg + (size_t)(b * 4 + head) * 32768 + ((mt * 4 + ks) * 64 + jq * 16 + n) * 8 + j;
      *(u32x2*)p = (u32x2){pk2(v[0], v[1]), pk2(v[2], v[3])};
    } else {
      const int c2 = col - 512, head = c2 >> 7, d0 = c2 & 127;
      const int kk = m >> 5, mm = m & 31, j = 4 * (mm >> 4) + (mm & 3), jq = (mm & 15) >> 2;
#pragma unroll
      for (int i = 0; i < 4; i++) {
        const int d = d0 + i, dt = d >> 4, r = d & 15;
        vimg[(size_t)(b * 4 + head) * 32768 + ((dt * 8 + kk) * 64 + jq * 16 + r) * 8 + j] = f2bf(v[i]);
      }
    }
  }
};
struct EpiA1 {
  static constexpr bool PRELOAD = false;
  bf16_t *U, *VT, *QX;
  DI void operator()(int row, int col, f32x4 v) const {
    const int cb = __builtin_amdgcn_readfirstlane(col & ~127);
    if (cb < 1024) {
      *(u32x2*)(U + (size_t)row * 1024 + col) = (u32x2){pk2(geluf_(v[0]), geluf_(v[1])), pk2(geluf_(v[2]), geluf_(v[3]))};
    } else if (cb < 2048) {
      const int c = col - 1024, chunk = row >> 7, s = row & 127;
#pragma unroll
      for (int i = 0; i < 4; i++) VT[(((size_t)chunk * 1024 + c + i) << 7) + s] = f2bf(geluf_(v[i]));
    } else {
      *(u32x2*)(QX + (size_t)row * 512 + (col - 2048)) = (u32x2){pk2(v[0], v[1]), pk2(v[2], v[3])};
    }
  }
};
struct EpiPlain {
  static constexpr bool PRELOAD = false;
  bf16_t* R; int ld;
  DI void operator()(int row, int col, f32x4 v) const { *(u32x2*)(R + (size_t)row * ld + col) = (u32x2){pk2(v[0], v[1]), pk2(v[2], v[3])}; }
};
struct EpiC1 {
  static constexpr bool PRELOAD = false;
  bf16_t* R; float* ab; int hfoff;
  DI void operator()(int row, int col, f32x4 v) const {
    const int cb = __builtin_amdgcn_readfirstlane(col & ~127);
    if (cb < 3584) *(u32x2*)(R + (size_t)row * 3584 + col) = (u32x2){pk2(v[0], v[1]), pk2(v[2], v[3])};
    else if (cb == 3584 && col < 3600) *(f32x4*)(ab + (size_t)(((row >> 12) << 13) + hfoff + (row & 4095)) * 16 + (col - 3584)) = v;
  }
};
struct EpiGate {
  static constexpr bool PRELOAD = true;
  bf16_t* Y; const float* __restrict__ ssq; const float* __restrict__ onw; int isC, col0, hfoff;
  DI int tokof(int row) const { return hfoff < 0 ? row : ((row >> 12) << 13) + hfoff + (row & 4095); }
  DI u32x4 pre(int row, int col) const {
    const int tok = tokof(row), yc = col + col0;
    const u32x2 m = *(const u32x2*)(Y + (size_t)tok * 1536 + yc);
    float q = 0.f;
    if (isC && __builtin_amdgcn_readfirstlane(yc & ~127) < 1024) q = ssq[(size_t)tok * 8 + (yc >> 7)];
    return (u32x4){m[0], m[1], __float_as_uint(q), 0u};
  }
  DI void fin(int row, int col, f32x4 v, u32x4 pr) const {
    const int tok = tokof(row), yc = col + col0;
    float a0 = lo2f(pr[0]), a1 = hi2f(pr[0]), a2 = lo2f(pr[1]), a3 = hi2f(pr[1]);
    if (isC && __builtin_amdgcn_readfirstlane(yc & ~127) < 1024) {
      const float r = rsqrtf(__uint_as_float(pr[2]) * (1.f / 128.f) + EPS);
      const f32x4 w = *(const f32x4*)(onw + (yc & 127));
      a0 *= r * w[0]; a1 *= r * w[1]; a2 *= r * w[2]; a3 *= r * w[3];
    }
    *(u32x2*)(Y + (size_t)tok * 1536 + yc) = (u32x2){pk2(a0 * siluf_(v[0]), a1 * siluf_(v[1])), pk2(a2 * siluf_(v[2]), a3 * siluf_(v[3]))};
  }
  DI void operator()(int row, int col, f32x4 v) const { fin(row, col, v, pre(row, col)); }
};
struct EpiOut {
  static constexpr bool PRELOAD = false;
  bf16_t* O;
  DI void operator()(int row, int col, f32x4 v) const { *(u32x2*)(O + (size_t)row * 1024 + col) = (u32x2){pk2(v[0], v[1]), pk2(v[2], v[3])}; }
};

#define LDS_BAR() do { asm volatile("s_waitcnt lgkmcnt(0)" ::: "memory"); __builtin_amdgcn_s_barrier(); asm volatile("" ::: "memory"); } while (0)
DI void conv_seg(const float* __restrict__ src, int ld, int col0, int ncols, bf16_t* __restrict__ dst, int K, char* smem) {
  const int bx_ = obid(), G_ = ogrid();
  smem += zoff();
  float* tile = (float*)smem;
  const int tid = otid();
  const int ntj = (ncols + 63) >> 6, ntk = K >> 6, nt = ntj * ntk;
  const int jj = tid & 63, k0 = tid >> 6;
  float r[8];
  int t = bx_;
  if (t < nt) {
    const int tj = t % ntj, tk = t / ntj;
    const bool ok = (tj * 64 + jj) < ncols;
#pragma unroll
    for (int i = 0; i < 8; i++) r[i] = ok ? src[(size_t)(tk * 64 + k0 + 8 * i) * ld + col0 + tj * 64 + jj] : 0.f;
  }
  for (; t < nt; t += G_) {
    const int tj = t % ntj, tk = t / ntj;
#pragma unroll
    for (int i = 0; i < 8; i++) tile[(k0 + 8 * i) * 65 + jj] = r[i];
    LDS_BAR();
    if (t + G_ < nt) {
      const int t2 = t + G_, tj2 = t2 % ntj, tk2 = t2 / ntj;
      const bool ok = (tj2 * 64 + jj) < ncols;
#pragma unroll
      for (int i = 0; i < 8; i++) r[i] = ok ? src[(size_t)(tk2 * 64 + k0 + 8 * i) * ld + col0 + tj2 * 64 + jj] : 0.f;
    }
    {
      const int kk2 = (tid & 31) * 2, j2 = tid >> 5;
#pragma unroll
      for (int i = 0; i < 4; i++) {
        const int j = j2 + 16 * i;
        if (tj * 64 + j < ncols) *(unsigned*)(dst + (size_t)(tj * 64 + j) * K + tk * 64 + kk2) = pk2(tile[kk2 * 65 + j], tile[(kk2 + 1) * 65 + j]);
      }
    }
    LDS_BAR();
  }
}

DI void rmsnorm_rows(const float* __restrict__ x, const float* __restrict__ w, bf16_t* __restrict__ h, int nrows) {
  const int bx_ = obid(), G_ = ogrid(); (void)bx_; (void)G_;
  x = lp(x);
  w = lp(w);
  h = lp(h);
  const int lane = otid() & 63, wid = otid() >> 6;
  f32x4 wv[4];
#pragma unroll
  for (int i = 0; i < 4; i++) wv[i] = *(const f32x4*)(w + i * 256 + lane * 4);
  for (int row = bx_ * 8 + wid; row < nrows; row += G_ * 8) {
    f32x4 v[4]; float ss = 0.f;
#pragma unroll
    for (int i = 0; i < 4; i++) { v[i] = *(const f32x4*)(x + (size_t)row * 1024 + i * 256 + lane * 4); ss += v[i][0] * v[i][0] + v[i][1] * v[i][1] + v[i][2] * v[i][2] + v[i][3] * v[i][3]; }
    ss = wsum(ss);
    const float r = rsqrtf(ss * (1.f / 1024.f) + EPS);
#pragma unroll
    for (int i = 0; i < 4; i++)
      *(u32x2*)(h + (size_t)row * 1024 + i * 256 + lane * 4) = (u32x2){pk2(v[i][0] * r * wv[i][0], v[i][1] * r * wv[i][1]), pk2(v[i][2] * r * wv[i][2], v[i][3] * r * wv[i][3])};
  }
}

DI void norm_phase(const bf16_t* __restrict__ O, const float* xin, float* xout, const float* __restrict__ wpost, const float* __restrict__ wpre, bf16_t* __restrict__ h) {
  const int bx_ = obid(), G_ = ogrid(); (void)bx_; (void)G_;
  O = lp(O);
  xin = lp(xin);
  xout = lp(xout);
  wpost = lp(wpost);
  wpre = lp(wpre);
  h = lp(h);
  const int lane = otid() & 63, wid = otid() >> 6;
  f32x4 wp[4], wq[4];
#pragma unroll
  for (int i = 0; i < 4; i++) { wp[i] = *(const f32x4*)(wpost + i * 256 + lane * 4); wq[i] = wpre ? *(const f32x4*)(wpre + i * 256 + lane * 4) : (f32x4){0.f, 0.f, 0.f, 0.f}; }
  for (int row = bx_ * 8 + wid; row < NTOK; row += G_ * 8) {
    f32x4 o[4], xv[4]; float ss = 0.f;
#pragma unroll
    for (int i = 0; i < 4; i++) {
      { const u32x2 ob = *(const u32x2*)(O + (size_t)row * 1024 + i * 256 + lane * 4); o[i] = (f32x4){lo2f(ob[0]), hi2f(ob[0]), lo2f(ob[1]), hi2f(ob[1])}; }
      xv[i] = *(const f32x4*)(xin + (size_t)row * 1024 + i * 256 + lane * 4);
      ss += o[i][0] * o[i][0] + o[i][1] * o[i][1] + o[i][2] * o[i][2] + o[i][3] * o[i][3];
    }
    ss = wsum(ss);
    const float r = rsqrtf(ss * (1.f / 1024.f) + EPS);
    float s2 = 0.f;
#pragma unroll
    for (int i = 0; i < 4; i++) {
#pragma unroll
      for (int j = 0; j < 4; j++) { xv[i][j] += o[i][j] * r * wp[i][j]; s2 += xv[i][j] * xv[i][j]; }
      *(f32x4*)(xout + (size_t)row * 1024 + i * 256 + lane * 4) = xv[i];
    }
    if (wpre) {
      s2 = wsum(s2);
      const float r2 = rsqrtf(s2 * (1.f / 1024.f) + EPS);
#pragma unroll
      for (int i = 0; i < 4; i++)
        *(u32x2*)(h + (size_t)row * 1024 + i * 256 + lane * 4) = (u32x2){pk2(xv[i][0] * r2 * wq[i][0], xv[i][1] * r2 * wq[i][1]), pk2(xv[i][2] * r2 * wq[i][2], xv[i][3] * r2 * wq[i][3])};
    }
  }
}

DI void attn_phase(const bf16_t* __restrict__ Q, int ldq, int hfoff  , int nrows, const bf16_t* __restrict__ Kimg, const bf16_t* __restrict__ Vimg,
                   bf16_t* __restrict__ mix, int bid, int nb, char* smem) {
  const int bx_ = obid(), G_ = ogrid(); (void)bx_; (void)G_;
  Q = lp(Q);
  Kimg = lp(Kimg);
  Vimg = lp(Vimg);
  mix = lp(mix);
  smem += zoff();
  const int tid = otid(), lane = tid & 63, wid = tid >> 6, fr = lane & 15, fq = lane >> 4;
  const int items = (nrows >> 9) * 4;
  for (int it = bid; it < items; it += nb) {
    const int head = it & 3, span = it >> 2, lrow0 = span * 512;
    const int tokb = hfoff < 0 ? lrow0 : ((lrow0 >> 12) << 13) + hfoff + (lrow0 & 4095);
    const int b = tokb >> 13;
    const u32x4* ksrc = (const u32x4*)(Kimg + (size_t)(b * 4 + head) * 32768);
    const u32x4* vsrc = (const u32x4*)(Vimg + (size_t)(b * 4 + head) * 32768);
    {
      u32x4 kr[8], vr[8];
#pragma unroll
      for (int i = 0; i < 8; i++) { kr[i] = ksrc[tid + 512 * i]; vr[i] = vsrc[tid + 512 * i]; }
      __builtin_amdgcn_sched_barrier(0);
#pragma unroll
      for (int i = 0; i < 8; i++) { ((u32x4*)smem)[tid + 512 * i] = kr[i]; ((u32x4*)(smem + 65536))[tid + 512 * i] = vr[i]; }
    }
    __syncthreads();
    for (int qi = 0; qi < 4; qi++) {
      const int lr = lrow0 + qi * 128 + wid * 16;
      bf16x8 qf[4];
#pragma unroll
      for (int ks = 0; ks < 4; ks++) qf[ks] = *(const bf16x8*)(Q + (size_t)(lr + fr) * ldq + head * 128 + ks * 32 + fq * 8);
      f32x4 st[16];
#pragma unroll
      for (int mt = 0; mt < 16; mt++) {
        f32x4 a = (f32x4){0.f, 0.f, 0.f, 0.f};
#pragma unroll
        for (int ks = 0; ks < 4; ks++) a = mfma16(*(const bf16x8*)(smem + ((mt * 4 + ks) * 64 + lane) * 16), qf[ks], a);
        st[mt] = a;
        if (mt & 1) __builtin_amdgcn_sched_barrier(0);
      }
      float mx = -3.0e38f;
#pragma unroll
      for (int mt = 0; mt < 16; mt++)
#pragma unroll
        for (int i = 0; i < 4; i++) mx = fmaxf(mx, st[mt][i]);
      mx = fmaxf(mx, __shfl_xor(mx, 16)); mx = fmaxf(mx, __shfl_xor(mx, 32));
      const float sc = 0.08838834764831845f * 1.4426950408889634f;
      float sum = 0.f;
#pragma unroll
      for (int mt = 0; mt < 16; mt++)
#pragma unroll
        for (int i = 0; i < 4; i++) { const float pz = __builtin_amdgcn_exp2f((st[mt][i] - mx) * sc); st[mt][i] = pz; sum += pz; }
      sum += __shfl_xor(sum, 16); sum += __shfl_xor(sum, 32);
      bf16x8 pf[8];
#pragma unroll
      for (int kk = 0; kk < 8; kk++) pf[kk] = pack8(st[2 * kk], st[2 * kk + 1]);
      const float inv = 1.f / sum;
      bf16_t* op = mix + (size_t)(tokb + (lr - lrow0) + fr) * 1536 + 1024 + head * 128 + fq * 4;
#pragma unroll
      for (int dt = 0; dt < 8; dt++) {
        f32x4 o = (f32x4){0.f, 0.f, 0.f, 0.f};
#pragma unroll
        for (int kk = 0; kk < 8; kk++) o = mfma16(*(const bf16x8*)(smem + 65536 + ((dt * 8 + kk) * 64 + lane) * 16), pf[kk], o);
        *(u32x2*)(op + dt * 16) = (u32x2){pk2(o[0] * inv, o[1] * inv), pk2(o[2] * inv, o[3] * inv)};
        __builtin_amdgcn_sched_barrier(0);
      }
    }
    __syncthreads();
  }
}

DI void gmlp_phase(const bf16_t* __restrict__ U, const bf16_t* __restrict__ VT, const bf16_t* __restrict__ Wsb, const float* __restrict__ ln_w,
                   const float* __restrict__ ln_b, const float* __restrict__ b_s, bf16_t* __restrict__ mix, char* smem) {
  const int bx_ = obid(), G_ = ogrid(); (void)bx_; (void)G_;
  U = lp(U);
  VT = lp(VT);
  Wsb = lp(Wsb);
  ln_w = lp(ln_w);
  ln_b = lp(ln_b);
  b_s = lp(b_s);
  mix = lp(mix);
  smem += zoff();
  float* red = (float*)smem;
  float* stats = (float*)(smem + 32768);
  for (int chunk = bx_; chunk < 256; chunk += G_) {
    const int tid = otid(), lane = tid & 63, wid = tid >> 6, fr = lane & 15, fq = lane >> 4;
    {
      const int s8 = tid & 15, cgp = tid >> 4;
      float sm[8], sq[8];
#pragma unroll
      for (int j = 0; j < 8; j++) { sm[j] = 0.f; sq[j] = 0.f; }
#pragma unroll 8
      for (int cc = 0; cc < 32; cc++) {
        const u32x4 raw = *(const u32x4*)(VT + (((size_t)chunk * 1024 + cgp * 32 + cc) << 7) + s8 * 8);
        float v[8]; unpack8(raw, v);
#pragma unroll
        for (int j = 0; j < 8; j++) { sm[j] += v[j]; sq[j] += v[j] * v[j]; }
      }
#pragma unroll
      for (int j = 0; j < 8; j++) { red[(cgp * 128 + s8 * 8 + j) * 2] = sm[j]; red[(cgp * 128 + s8 * 8 + j) * 2 + 1] = sq[j]; }
    }
    __syncthreads();
    if (tid < 128) {
      float S = 0.f, Q = 0.f;
      for (int g2 = 0; g2 < 32; g2++) { S += red[(g2 * 128 + tid) * 2]; Q += red[(g2 * 128 + tid) * 2 + 1]; }
      const float mean = S * (1.f / 1024.f), var = Q * (1.f / 1024.f) - mean * mean;
      stats[tid * 2] = mean; stats[tid * 2 + 1] = rsqrtf(fmaxf(var, 0.f) + EPS);
    }
    __syncthreads();
    const int g = wid;
    float lwv[8], lbv[8];
#pragma unroll
    for (int ct = 0; ct < 8; ct++) { lwv[ct] = ln_w[g * 128 + 16 * ct + fr]; lbv[ct] = ln_b[g * 128 + 16 * ct + fr]; }
#pragma unroll
    for (int tq = 0; tq < 4; tq++) {
      f32x4 acc[8][2];
#pragma unroll
      for (int ct = 0; ct < 8; ct++)
#pragma unroll
        for (int tt = 0; tt < 2; tt++) acc[ct][tt] = (f32x4){0.f, 0.f, 0.f, 0.f};
#pragma unroll
      for (int ks = 0; ks < 4; ks++) {
        if (ks <= tq) {
          float mean8[8], rstd8[8];
#pragma unroll
          for (int j = 0; j < 8; j++) { mean8[j] = stats[(32 * ks + 8 * fq + j) * 2]; rstd8[j] = stats[(32 * ks + 8 * fq + j) * 2 + 1]; }
          bf16x8 bfr[2];
#pragma unroll
          for (int tt = 0; tt < 2; tt++) bfr[tt] = *(const bf16x8*)(Wsb + ((size_t)g * 128 + 32 * tq + 16 * tt + fr) * 128 + 32 * ks + 8 * fq);
          u32x4 rawv[8];
#pragma unroll
          for (int ct = 0; ct < 8; ct++) rawv[ct] = *(const u32x4*)(VT + (((size_t)chunk * 1024 + g * 128 + 16 * ct + fr) << 7) + 32 * ks + 8 * fq);
#pragma unroll
          for (int ct = 0; ct < 8; ct++) {
            const float lw = lwv[ct], lb = lbv[ct];
            float v[8]; unpack8(rawv[ct], v);
#pragma unroll
            for (int j = 0; j < 8; j++) v[j] = (v[j] - mean8[j]) * rstd8[j] * lw + lb;
            u32x4 pa; pa[0] = pk2(v[0], v[1]); pa[1] = pk2(v[2], v[3]); pa[2] = pk2(v[4], v[5]); pa[3] = pk2(v[6], v[7]);
            const bf16x8 af = __builtin_bit_cast(bf16x8, pa);
#pragma unroll
            for (int tt = 0; tt < 2; tt++) acc[ct][tt] = mfma16(af, bfr[tt], acc[ct][tt]);
            if (ct & 1) __builtin_amdgcn_sched_barrier(0);
          }
        }
      }
#pragma unroll
      for (int tt = 0; tt < 2; tt++) {
        const int t = 32 * tq + 16 * tt + fr;
        const size_t tok = (size_t)chunk * 128 + t;
        const float bs = b_s[g * 128 + t];
        u32x2 uuv[8];
#pragma unroll
        for (int ct = 0; ct < 8; ct++) uuv[ct] = *(const u32x2*)(U + tok * 1024 + g * 128 + 16 * ct + 4 * fq);
#pragma unroll
        for (int ct = 0; ct < 8; ct++) {
          const int col = g * 128 + 16 * ct + 4 * fq;
          const u32x2 uu = uuv[ct];
          const f32x4 a = acc[ct][tt];
          *(u32x2*)(mix + tok * 1536 + col) = (u32x2){pk2(lo2f(uu[0]) * (a[0] + bs), hi2f(uu[0]) * (a[1] + bs)), pk2(lo2f(uu[1]) * (a[2] + bs), hi2f(uu[1]) * (a[3] + bs))};
        }
      }
      __builtin_amdgcn_sched_barrier(0);
    }
    __syncthreads();
  }
}

DI void sconv_phase(const bf16_t* __restrict__ R, const float* __restrict__ cw, bf16_t* __restrict__ mix) {
  const int bx_ = obid(), G_ = ogrid(); (void)bx_; (void)G_;
  R = lp(R);
  cw = lp(cw);
  mix = lp(mix);
  for (int idx = bx_ * 512 + otid(); idx < NTOK * 128; idx += G_ * 512) {
    const int row = idx >> 7, c = (idx & 127) * 8, s = row & 8191;
    float acc[8];
#pragma unroll
    for (int j = 0; j < 8; j++) acc[j] = 0.f;
#pragma unroll
    for (int k = 0; k < 3; k++) {
      if (s - 2 + k >= 0) {
        const size_t r2 = (size_t)(row - 2 + k);
        float a[8], b[8]; unpack8(*(const u32x4*)(R + r2 * 3584 + 1024 + c), a); unpack8(*(const u32x4*)(R + r2 * 3584 + 2048 + c), b);
        const f32x4 w0 = *(const f32x4*)(cw + k * 1024 + c), w1 = *(const f32x4*)(cw + k * 1024 + c + 4);
#pragma unroll
        for (int j = 0; j < 4; j++) { acc[j] += w0[j] * a[j] * b[j]; acc[4 + j] += w1[j] * a[4 + j] * b[4 + j]; }
      }
    }
    float g[8]; unpack8(*(const u32x4*)(R + (size_t)row * 3584 + c), g);
    u32x4 o;
#pragma unroll
    for (int j = 0; j < 4; j++) o[j] = pk2(g[2 * j] * acc[2 * j], g[2 * j + 1] * acc[2 * j + 1]);
    *(u32x4*)(mix + (size_t)row * 1536 + c) = o;
  }
}

constexpr int P_SET = 1024 + 3 * 17408;
constexpr int P_AF = 0, P_SET0 = 16384, P_WB = P_SET0 + 2 * P_SET, P_QK = P_WB + 17408, P_END = P_QK + 9216;
constexpr int P_WL = P_END;
constexpr int XST_OFF = P_END + 2 * 6144;
static_assert(XST_OFF + 64 <= LDS_BYTES, "prep lds");

DI void prep_loadw(const float* __restrict__ cw, int ci, float* wl, int t0, int nth) {
  const int hh = (ci >> 6) & 7;
  for (int i = t0; i < 384; i += nth) {
    const int sec = i >> 7, kk = (i >> 5) & 3, c4 = i & 31;
    *(f32x4*)(wl + i * 4) = *(const f32x4*)(cw + (size_t)kk * 3072 + sec * 1024 + hh * 128 + c4 * 4);
  }
}
DI void prep_conv(const bf16_t* __restrict__ R, const float* __restrict__ ab, const float* wl, const float* __restrict__ a_log,
                  const float* __restrict__ dt_bias, float* __restrict__ glbuf, bf16_t* __restrict__ stash, int half, int ci, char* sb, int t0, int nth) {
  float* gc = (float*)sb; float* be = gc + 64; float* eg = gc + 128; float* ek = gc + 192;
  bf16_t* Kb = (bf16_t*)(sb + 1024); bf16_t* Qb = Kb + 64 * 136; bf16_t* Vb = Qb + 64 * 136;
  const int bl = ci >> 9, hh = (ci >> 6) & 7, n = ci & 63;
  const int tokg = bl * 8192 + half * 4096 + n * 64;
  if (t0 < 64) {
    const int lane = t0;
    const float a = ab[(size_t)(tokg + lane) * 16 + hh], bb = ab[(size_t)(tokg + lane) * 16 + 8 + hh];
    const float xs = a + dt_bias[hh];
    const float sp = xs > 20.f ? xs : log1pf(__expf(xs));
    float g = -__expf(a_log[hh]) * sp;
#pragma unroll
    for (int o = 1; o < 64; o <<= 1) { const float t = __shfl_up(g, o); if (lane >= o) g += t; }
    const float gl = __shfl(g, 63);
    gc[lane] = g; be[lane] = sigmoidf_(bb); eg[lane] = __expf(g); ek[lane] = __expf(gl - g);
    if (lane == 63) glbuf[ci] = __expf(gl);
  }
  for (int idx = t0; idx < 512; idx += nth) {
    const int t = idx >> 3, sub = idx & 7;
    u32x4 raw[3][4][2];
#pragma unroll
    for (int sec = 0; sec < 3; sec++)
#pragma unroll
      for (int kk = 0; kk < 4; kk++) {
        const int sl = n * 64 + t - 3 + kk;
        if (sl >= 0 || half == 1) {
          const bf16_t* src = sl >= 0 ? R + (size_t)(bl * 4096 + sl) * 3584 + sec * 1024 + hh * 128 + sub * 16
                                      : stash + (size_t)((bl * 8 + hh) * 3 + (sl + 3)) * 384 + sec * 128 + sub * 16;
          raw[sec][kk][0] = *(const u32x4*)src; raw[sec][kk][1] = *(const u32x4*)(src + 8);
        } else {
          raw[sec][kk][0] = (u32x4){0u, 0u, 0u, 0u}; raw[sec][kk][1] = (u32x4){0u, 0u, 0u, 0u};
        }
      }
#pragma unroll
    for (int sec = 0; sec < 3; sec++) {
      float acc[16];
#pragma unroll
      for (int j = 0; j < 16; j++) acc[j] = 0.f;
#pragma unroll
      for (int kk = 0; kk < 4; kk++) {
        float xv[16]; unpack8(raw[sec][kk][0], xv); unpack8(raw[sec][kk][1], xv + 8);
#pragma unroll
        for (int q4 = 0; q4 < 4; q4++) {
          const f32x4 w = *(const f32x4*)(wl + (sec * 4 + kk) * 128 + sub * 16 + q4 * 4);
#pragma unroll
          for (int j = 0; j < 4; j++) acc[q4 * 4 + j] += w[j] * xv[q4 * 4 + j];
        }
      }
      float ss = 0.f;
#pragma unroll
      for (int j = 0; j < 16; j++) { acc[j] = siluf_(acc[j]); ss += acc[j] * acc[j]; }
      float scale = 1.f;
      if (sec < 2) {
        ss += __shfl_xor(ss, 1); ss += __shfl_xor(ss, 2); ss += __shfl_xor(ss, 4);
        scale = rsqrtf(ss + EPS) * (sec == 0 ? 0.08838834764831845f : 1.f);
      }
      bf16_t* dst = (sec == 0 ? Qb : (sec == 1 ? Kb : Vb)) + t * 136 + sub * 16;
      u32x4 p0, p1;
#pragma unroll
      for (int j = 0; j < 4; j++) { p0[j] = pk2(acc[2 * j] * scale, acc[2 * j + 1] * scale); p1[j] = pk2(acc[8 + 2 * j] * scale, acc[9 + 2 * j] * scale); }
      *(u32x4*)dst = p0; *(u32x4*)(dst + 8) = p1;
    }
    __builtin_amdgcn_sched_barrier(0);
  }
  if (half == 0 && n == 63 && t0 < 144) {
    const int r = t0 / 48, piece = t0 % 48, sec = piece >> 4, c16 = piece & 15;
    *(u32x4*)(stash + (size_t)((bl * 8 + hh) * 3 + r) * 384 + sec * 128 + c16 * 8) =
        *(const u32x4*)(R + (size_t)(bl * 4096 + 4093 + r) * 3584 + sec * 1024 + hh * 128 + c16 * 8);
  }
}


DI void prep_phase(const bf16_t* __restrict__ R, const float* __restrict__ ab, const float* __restrict__ cw, const float* __restrict__ a_log,
                   const float* __restrict__ dt_bias, char* __restrict__ ops, float* __restrict__ glbuf, bf16_t* __restrict__ stash, int half, char* smem) {
  const int bx_ = obid(), G_ = ogrid(); (void)bx_; (void)G_;
  R = lp(R);
  ab = lp(ab);
  cw = lp(cw);
  a_log = lp(a_log);
  dt_bias = lp(dt_bias);
  ops = lp(ops);
  glbuf = lp(glbuf);
  stash = lp(stash);
  smem += zoff();
  float* Af = (float*)(smem + P_AF); bf16_t* Wb = (bf16_t*)(smem + P_WB); bf16_t* QKb = (bf16_t*)(smem + P_QK);
  float* WL = (float*)(smem + P_WL);
  if (bx_ < 2048) prep_loadw(cw, bx_, WL, otid(), 512);
  LDS_BAR();
  int k = -1;
  for (int ci = bx_ - G_; ci < 2048; ci += G_, k++) {
    const bool live = ci >= 0;
    const int tid = otid(), lane = tid & 63, wid = tid >> 6, fr = lane & 15, fq = lane >> 4;
    char* sb = smem + P_SET0 + (k & 1) * P_SET;
    const float* gc = (const float*)sb; const float* be = gc + 64; const float* eg = gc + 128; const float* ek = gc + 192;
    const bf16_t* Kb = (const bf16_t*)(sb + 1024); const bf16_t* Qb = Kb + 64 * 136; const bf16_t* Vb = Qb + 64 * 136;
    char* op = ops + (size_t)ci * OPS_STRIDE;
    if (live) {
      const int it = wid & 3, which = wid >> 2;
      const bf16_t* X = which ? Qb : Kb;
      bf16x8 af[4];
#pragma unroll
      for (int ks = 0; ks < 4; ks++) af[ks] = *(const bf16x8*)(X + (16 * it + fr) * 136 + 32 * ks + 8 * fq);
#pragma unroll
      for (int jt = 0; jt < 4; jt++) {
        f32x4 a = (f32x4){0.f, 0.f, 0.f, 0.f};
#pragma unroll
        for (int ks = 0; ks < 4; ks++) a = mfma16(af[ks], *(const bf16x8*)(Kb + (16 * jt + fr) * 136 + 32 * ks + 8 * fq), a);
        const int j = 16 * jt + fr;
        const float gj = gc[j];
#pragma unroll
        for (int ii = 0; ii < 4; ii++) {
          const int i = 16 * it + 4 * fq + ii;
          const float dec = __expf(fminf(gc[i] - gj, 0.f));
          if (which == 0) Af[i * 64 + j] = (j < i) ? be[i] * a[ii] * dec : 0.f;
          else QKb[i * 72 + j] = f2bf((j <= i) ? a[ii] * dec : 0.f);
        }
      }
    }
    LDS_BAR();
    if (tid < 256) {
      if (live) {
      const int col = tid;
      float Uv[64];
      const bool isv = col < 128;
      const bf16_t* xs = isv ? (Vb + col) : (Kb + (col - 128));
#pragma unroll
      for (int i = 0; i < 64; i++) { Uv[i] = bf2f(xs[i * 136]) * (be[i] * (isv ? 1.f : eg[i])); asm volatile("" : "+v"(Uv[i])); }
      __builtin_amdgcn_sched_barrier(0);
      f32x4 ac[16], an[16];
      ac[0] = *(const f32x4*)(Af + 1 * 64);
#pragma unroll
      for (int i = 1; i < 64; i++) {
        if (i + 1 < 64) {
#pragma unroll
          for (int j4 = 0; j4 < (i + 1 + 3) / 4; j4++) an[j4] = *(const f32x4*)(Af + (i + 1) * 64 + j4 * 4);
        }
        __builtin_amdgcn_sched_barrier(0);
        float xv = Uv[i], xw = 0.f, xy = 0.f, xz = 0.f;
#pragma unroll
        for (int j4 = 0; j4 < (i + 3) / 4; j4++) {
          const f32x4 a = ac[j4];
          if (j4 * 4 + 0 < i) xv -= a[0] * Uv[j4 * 4 + 0];
          if (j4 * 4 + 1 < i) xw -= a[1] * Uv[j4 * 4 + 1];
          if (j4 * 4 + 2 < i) xy -= a[2] * Uv[j4 * 4 + 2];
          if (j4 * 4 + 3 < i) xz -= a[3] * Uv[j4 * 4 + 3];
        }
        Uv[i] = (xv + xw) + (xy + xz);
        __builtin_amdgcn_sched_barrier(0);
        if (i + 1 < 64) {
#pragma unroll
          for (int j4 = 0; j4 < (i + 1 + 3) / 4; j4++) ac[j4] = an[j4];
        }
      }
      if (col < 128) {
        const int w8 = col >> 4, lo = col & 15;
#pragma unroll
        for (int ct = 0; ct < 4; ct++)
#pragma unroll
          for (int jq = 0; jq < 4; jq++)
            *(u32x2*)(op + 57344 + (((w8 * 4 + ct) * 64 + jq * 16 + lo) * 8)) = (u32x2){pk2(Uv[16 * ct + 4 * jq], Uv[16 * ct + 4 * jq + 1]), pk2(Uv[16 * ct + 4 * jq + 2], Uv[16 * ct + 4 * jq + 3])};
      } else {
#pragma unroll
        for (int i = 0; i < 64; i++) Wb[i * 136 + col - 128] = f2bf(Uv[i]);
      }
      }
    } else {
      const int t2 = tid - 256;
      if (live) {
#pragma unroll
      for (int i = 0; i < 4; i++) {
        const int idx = t2 + 256 * i, frag = idx >> 6, ln = idx & 63, ct = frag >> 2, m = frag & 3, r = ln & 15, jq = ln >> 4;
        const int c = 16 * ct + r, d0 = 32 * m + 4 * jq;
        const u32x2 lo = *(const u32x2*)(Qb + c * 136 + d0), hi = *(const u32x2*)(Qb + c * 136 + d0 + 16);
        const float e = eg[c];
        *(u32x4*)(op + 16384 + idx * 16) = (u32x4){pk2(lo2f(lo[0]) * e, hi2f(lo[0]) * e), pk2(lo2f(lo[1]) * e, hi2f(lo[1]) * e), pk2(lo2f(hi[0]) * e, hi2f(hi[0]) * e), pk2(lo2f(hi[1]) * e, hi2f(hi[1]) * e)};
      }
#pragma unroll
      for (int i = 0; i < 4; i++) {
        const int idx = t2 + 256 * i, frag = idx >> 6, ln = idx & 63, dt = frag >> 1, kk = frag & 1, r = ln & 15, jq = ln >> 4;
        const int d = 16 * dt + r;
        float v[8];
#pragma unroll
        for (int j = 0; j < 8; j++) { const int c = 32 * kk + 16 * (j >> 2) + 4 * jq + (j & 3); v[j] = bf2f(Kb[c * 136 + d]) * ek[c]; }
        *(u32x4*)(op + 40960 + idx * 16) = (u32x4){pk2(v[0], v[1]), pk2(v[2], v[3]), pk2(v[4], v[5]), pk2(v[6], v[7])};
      }
#pragma unroll
      for (int i = 0; i < 2; i++) {
        const int idx = t2 + 256 * i, frag = idx >> 6, ln = idx & 63, ct = frag >> 1, kk = frag & 1, r = ln & 15, jq = ln >> 4;
        const int row = 16 * ct + r, c0 = 32 * kk + 4 * jq;
        const u32x2 lo = *(const u32x2*)(QKb + row * 72 + c0), hi = *(const u32x2*)(QKb + row * 72 + c0 + 16);
        *(u32x4*)(op + 32768 + idx * 16) = (u32x4){lo[0], lo[1], hi[0], hi[1]};
      }
      }
      if (ci + G_ < 2048) prep_conv(R, ab, WL + ((k + 1) & 1) * 1536, a_log, dt_bias, glbuf, stash, half, ci + G_, smem + P_SET0 + ((k + 1) & 1) * P_SET, t2, 256);
      if (ci + 2 * G_ < 2048) prep_loadw(cw, ci + 2 * G_, WL + (k & 1) * 1536, t2, 256);
    }
    LDS_BAR();
    if (live)
#pragma unroll
    for (int i = 0; i < 2; i++) {
      const int idx = tid + 512 * i, frag = idx >> 6, ln = idx & 63, ct = frag >> 2, m = frag & 3, r = ln & 15, jq = ln >> 4;
      const int c = 16 * ct + r, d0 = 32 * m + 4 * jq;
      const u32x2 lo = *(const u32x2*)(Wb + c * 136 + d0), hi = *(const u32x2*)(Wb + c * 136 + d0 + 16);
      *(u32x4*)(op + idx * 16) = (u32x4){lo[0], lo[1], hi[0], hi[1]};
    }
  }
  LDS_BAR();
}

DI void scan_block(const char* __restrict__ ops, const float* __restrict__ glbuf, bf16_t* __restrict__ mix, float* __restrict__ ssq,
                   f32x4* __restrict__ stbuf, int half, char* smem) {
  const int bx_ = obid(), G_ = ogrid(); (void)bx_; (void)G_;
  ops = lp(ops);
  glbuf = lp(glbuf);
  mix = lp(mix);
  ssq = lp(ssq);
  stbuf = lp(stbuf);
  smem += zoff();
  const int tid = otid(), lane = tid & 63, w = tid >> 6, fr = lane & 15, fq = lane >> 4;
  const bool comp = w < 4;
  const int blk = bx_, bl = blk >> 3, hh = blk & 7;
  const int chunk0 = (bl * 8 + hh) * 64;
  const int tokbase = bl * 8192 + half * 4096;
  const char* cp = ops + (size_t)chunk0 * OPS_STRIDE;
  float* part = (float*)(smem + 114688);
  {
    u32x4 pr0[7];
#pragma unroll
    for (int i = 0; i < 7; i++) pr0[i] = ((const u32x4*)cp)[tid + 512 * i];
    __builtin_amdgcn_sched_barrier(0);
#pragma unroll
    for (int i = 0; i < 7; i++) ((u32x4*)smem)[tid + 512 * i] = pr0[i];
  }
  __syncthreads();
  if (!comp) {
    const int t2 = tid - 256;
    u32x4 sx[14], sy[14];
    {
      const u32x4* np = (const u32x4*)(cp + (size_t)1 * OPS_STRIDE);
#pragma unroll
      for (int i = 0; i < 14; i++) sy[i] = np[t2 + 256 * i];
    }
    for (int n = 0; n < 64; n += 2) {
      if (n + 2 < 64) {
        const u32x4* np = (const u32x4*)(cp + (size_t)(n + 2) * OPS_STRIDE);
#pragma unroll
        for (int i = 0; i < 14; i++) sx[i] = np[t2 + 256 * i];
      }
      {
        u32x4* nb = (u32x4*)(smem + 57344);
#pragma unroll
        for (int i = 0; i < 14; i++) nb[t2 + 256 * i] = sy[i];
      }
      asm volatile("s_waitcnt lgkmcnt(0)" ::: "memory");
      __builtin_amdgcn_s_barrier();
      asm volatile("" ::: "memory");
      if (n + 3 < 64) {
        const u32x4* np = (const u32x4*)(cp + (size_t)(n + 3) * OPS_STRIDE);
#pragma unroll
        for (int i = 0; i < 14; i++) sy[i] = np[t2 + 256 * i];
      }
      if (n + 2 < 64) {
        u32x4* nb = (u32x4*)smem;
#pragma unroll
        for (int i = 0; i < 14; i++) nb[t2 + 256 * i] = sx[i];
      }
      asm volatile("s_waitcnt lgkmcnt(0)" ::: "memory");
      __builtin_amdgcn_s_barrier();
      asm volatile("" ::: "memory");
    }
  } else {
    f32x4* stp = stbuf + ((size_t)(blk * 4 + w) * 16) * 64 + lane;
    f32x4 S[8][2]; bf16x8 sB[4][2];
#pragma unroll
    for (int i = 0; i < 8; i++)
#pragma unroll
      for (int nt = 0; nt < 2; nt++) S[i][nt] = half ? stp[(i * 2 + nt) * 64] : (f32x4){0.f, 0.f, 0.f, 0.f};
#pragma unroll
    for (int m = 0; m < 4; m++)
#pragma unroll
      for (int nt = 0; nt < 2; nt++) sB[m][nt] = pack8(S[2 * m][nt], S[2 * m + 1][nt]);
    u32x2 uf[4][2];
#pragma unroll
    for (int ct = 0; ct < 4; ct++)
#pragma unroll
      for (int nt = 0; nt < 2; nt++) uf[ct][nt] = *(const u32x2*)(cp + 57344 + (((2 * w + nt) * 4 + ct) * 64 + lane) * 8);
    float gl = glbuf[chunk0];
    for (int n = 0; n < 64; n++) {
      const char* buf = smem + (n & 1) * 57344;
      if (n > 0 && lane < 16) {
        const float* pp = part + ((n - 1) & 1) * 256 + 16 * w + lane;
        ssq[(size_t)(tokbase + (n - 1) * 64 + 16 * w + lane) * 8 + hh] = pp[0] + pp[64] + pp[128] + pp[192];
      }
      bf16x8 vB[2][2];
      {
        f32x4 vn[4][2];
#pragma unroll
        for (int ct = 0; ct < 4; ct++) {
          f32x4 t0 = (f32x4){0.f, 0.f, 0.f, 0.f}, t1 = t0;
#pragma unroll
          for (int m = 0; m < 4; m++) {
            const bf16x8 a = *(const bf16x8*)(buf + ((ct * 4 + m) * 64 + lane) * 16);
            t0 = mfma16(a, sB[m][0], t0); t1 = mfma16(a, sB[m][1], t1);
          }
          vn[ct][0] = (f32x4){lo2f(uf[ct][0][0]) - t0[0], hi2f(uf[ct][0][0]) - t0[1], lo2f(uf[ct][0][1]) - t0[2], hi2f(uf[ct][0][1]) - t0[3]};
          vn[ct][1] = (f32x4){lo2f(uf[ct][1][0]) - t1[0], hi2f(uf[ct][1][0]) - t1[1], lo2f(uf[ct][1][1]) - t1[2], hi2f(uf[ct][1][1]) - t1[3]};
        }
#pragma unroll
        for (int kk = 0; kk < 2; kk++)
#pragma unroll
          for (int nt = 0; nt < 2; nt++) vB[kk][nt] = pack8(vn[2 * kk][nt], vn[2 * kk + 1][nt]);
      }
      const float glc = gl;
      if (n + 1 < 64) {
        const char* np = cp + (size_t)(n + 1) * OPS_STRIDE;
#pragma unroll
        for (int ct = 0; ct < 4; ct++)
#pragma unroll
          for (int nt = 0; nt < 2; nt++) uf[ct][nt] = *(const u32x2*)(np + 57344 + (((2 * w + nt) * 4 + ct) * 64 + lane) * 8);
        gl = glbuf[chunk0 + n + 1];
      }
      __builtin_amdgcn_sched_barrier(0);
      float v[16];
      {
        bf16_t* mp = mix + (size_t)(tokbase + n * 64) * 1536 + hh * 128 + 32 * w + fr;
#pragma unroll
        for (int ct = 0; ct < 4; ct++) {
          f32x4 t0 = (f32x4){0.f, 0.f, 0.f, 0.f}, t1 = t0;
#pragma unroll
          for (int m = 0; m < 4; m++) {
            const bf16x8 a = *(const bf16x8*)(buf + 16384 + ((ct * 4 + m) * 64 + lane) * 16);
            t0 = mfma16(a, sB[m][0], t0); t1 = mfma16(a, sB[m][1], t1);
          }
#pragma unroll
          for (int kk = 0; kk < 2; kk++) {
            const bf16x8 a = *(const bf16x8*)(buf + 32768 + ((ct * 2 + kk) * 64 + lane) * 16);
            t0 = mfma16(a, vB[kk][0], t0); t1 = mfma16(a, vB[kk][1], t1);
          }
#pragma unroll
          for (int ii = 0; ii < 4; ii++) {
            const bf16_t b0 = f2bf(t0[ii]), b1 = f2bf(t1[ii]);
            bf16_t* rp = mp + (size_t)(16 * ct + 4 * fq + ii) * 1536;
            rp[0] = b0; rp[16] = b1;
            const float f0 = bf2f(b0), f1 = bf2f(b1);
            v[ct * 4 + ii] = f0 * f0 + f1 * f1;
          }
        }
      }
      __builtin_amdgcn_sched_barrier(0);
#pragma unroll
      for (int dt = 0; dt < 8; dt++) {
        f32x4 t0 = S[dt][0] * glc, t1 = S[dt][1] * glc;
#pragma unroll
        for (int kk = 0; kk < 2; kk++) {
          const bf16x8 a = *(const bf16x8*)(buf + 40960 + ((dt * 2 + kk) * 64 + lane) * 16);
          t0 = mfma16(a, vB[kk][0], t0); t1 = mfma16(a, vB[kk][1], t1);
        }
        S[dt][0] = t0; S[dt][1] = t1;
      }
#pragma unroll
      for (int m = 0; m < 4; m++)
#pragma unroll
        for (int nt = 0; nt < 2; nt++) sB[m][nt] = pack8(S[2 * m][nt], S[2 * m + 1][nt]);
      __builtin_amdgcn_sched_barrier(0);
#pragma unroll
      for (int st = 8; st >= 1; st >>= 1) {
        const bool hiL = (fr & st) != 0;
#pragma unroll
        for (int k = 0; k < st; k++) {
          const float keep = hiL ? v[k + st] : v[k];
          const float send = hiL ? v[k] : v[k + st];
          v[k] = keep + __shfl_xor(send, st);
        }
      }
      part[(n & 1) * 256 + w * 64 + 16 * (fr >> 2) + 4 * fq + (fr & 3)] = v[0];
      asm volatile("s_waitcnt lgkmcnt(0)" ::: "memory");
      __builtin_amdgcn_s_barrier();
      asm volatile("" ::: "memory");
    }
    if (lane < 16) {
      const float* pp = part + (63 & 1) * 256 + 16 * w + lane;
      ssq[(size_t)(tokbase + 63 * 64 + 16 * w + lane) * 8 + hh] = pp[0] + pp[64] + pp[128] + pp[192];
    }
    if (half == 0) {
#pragma unroll
      for (int i = 0; i < 8; i++)
#pragma unroll
        for (int nt = 0; nt < 2; nt++) stp[(i * 2 + nt) * 64] = S[i][nt];
    }
  }
  __syncthreads();
}

#define XB_TMO      128
#define XB_XCNT(j)  (256  + 64 * (j))
#define XB_XSUB(j)  (1280 + 64 * (j))
#define XB_XGEN(j)  (2304 + 64 * (j))
#define XB_TOP      3328
#define XB_TOPGEN   3392
#define XCD_BAR_WORDS 3456
#define XB_SPIN_CAP (1u << 18)

__device__ __forceinline__ unsigned xb_ld(unsigned* p)              { return __hip_atomic_load(p, __ATOMIC_RELAXED, __HIP_MEMORY_SCOPE_AGENT); }
__device__ __forceinline__ unsigned xb_add(unsigned* p, unsigned v) { return __hip_atomic_fetch_add(p, v, __ATOMIC_RELAXED, __HIP_MEMORY_SCOPE_AGENT); }
__device__ __forceinline__ unsigned xb_xcc_id() { return (unsigned)__builtin_amdgcn_s_getreg((3 << 11) | 20) & 0xFu; }
#define XB_SPIN(cond, bar) do { unsigned _sp = 0; while (cond) { __builtin_amdgcn_s_sleep(1); \
    if ((++_sp & 255u) == 0u) { if (xb_ld(&(bar)[XB_TMO])) break; if (_sp > XB_SPIN_CAP) { atomicAdd(&(bar)[XB_TMO], 1u); break; } } } } while (0)

struct XcdBarrier {
    unsigned* bar; unsigned x;
    volatile LAS unsigned* st;
};

__device__ __forceinline__ XcdBarrier xcd_barrier_post(unsigned* bar, volatile LAS unsigned* st) {
    XcdBarrier b; b.bar = bar; b.x = xb_xcc_id(); b.st = st;
    if (threadIdx.x == 0) (void)xb_add(&bar[XB_XCNT(b.x)], 1u);
    return b;
}
__device__ __forceinline__ void xcd_barrier_complete(unsigned* bar, unsigned x, unsigned& nloc, unsigned& nx) {
    const unsigned G = gridDim.x * gridDim.y * gridDim.z;
    unsigned sum, cnt, mine, sp = 0u;
    for (;;) {
        sum = 0u; cnt = 0u; mine = 0u;
#pragma unroll
        for (unsigned j = 0; j < 16; ++j) { const unsigned c = xb_ld(&bar[XB_XCNT(j)]); sum += c; cnt += (c > 0u) ? 1u : 0u; mine = (j == x) ? c : mine; }
        if (sum == G) break;
        __builtin_amdgcn_s_sleep(1);
        if ((++sp & 255u) == 0u) { if (xb_ld(&bar[XB_TMO])) break; if (sp > XB_SPIN_CAP) { atomicAdd(&bar[XB_TMO], 1u); break; } }
    }
    nloc = mine > 0u ? mine : 1u; nx = cnt > 0u ? cnt : 1u;
}

__device__ __forceinline__ void xcd_barrier(const XcdBarrier& b) {
    asm volatile("s_waitcnt vmcnt(0)" ::: "memory");
    __syncthreads();
    if (threadIdx.x == 0) {
        unsigned* bar = b.bar;
        __builtin_amdgcn_s_waitcnt(0);
        unsigned nloc = b.st[0], nx = b.st[1];
        if (nloc == 0u) { xcd_barrier_complete(bar, b.x, nloc, nx); b.st[0] = nloc; b.st[1] = nx; }
        const unsigned old = xb_add(&bar[XB_XSUB(b.x)], 1u);
        const unsigned gen = old / nloc;
        if (old + 1u == (gen + 1u) * nloc) {
            __builtin_amdgcn_fence(__ATOMIC_RELEASE, "agent");
            asm volatile("s_waitcnt vmcnt(0)" ::: "memory");
            const unsigned og = xb_add(&bar[XB_TOP], 1u);
            const unsigned tg = og / nx;
            if (og + 1u == (tg + 1u) * nx) xb_add(&bar[XB_TOPGEN], 1u);
            else XB_SPIN(xb_ld(&bar[XB_TOPGEN]) == tg, bar);
            __builtin_amdgcn_fence(__ATOMIC_ACQUIRE, "agent");
            xb_add(&bar[XB_XGEN(b.x)], 1u);
            asm volatile("s_waitcnt vmcnt(0)" ::: "memory");
        } else {
            XB_SPIN(xb_ld(&bar[XB_XGEN(b.x)]) == gen, bar);
            __builtin_amdgcn_fence(__ATOMIC_ACQUIRE, "agent");
            asm volatile("s_waitcnt vmcnt(0)" ::: "memory");
        }
    }
    __syncthreads();
}

constexpr int PRM_NPRE = 0, PRM_NPOST = 4096, PRM_ALNW = 8192, PRM_ALNB = 10240, PRM_ABS = 12288, PRM_BCW = 14336, PRM_CCW = 17408, PRM_CALOG = 29696, PRM_CDT = 29704, PRM_CONW = 29712;
#define WS_PTRS(ws) \
  const float* PRM = (const float*)(ws + OFF_PRM); \
  bf16_t* W2 = (bf16_t*)(ws + OFF_W2); \
  bf16_t* WO = (bf16_t*)(ws + OFF_WO); \
  bf16_t* WM = (bf16_t*)(ws + OFF_WM); \
  bf16_t* WS = (bf16_t*)(ws + OFF_WS); \
  bf16_t* HMEM = (bf16_t*)(ws + OFF_HMEM); \
  bf16_t* KIMG = (bf16_t*)(ws + OFF_KIMG); \
  bf16_t* VIMG = (bf16_t*)(ws + OFF_VIMG); \
  float* AB = (float*)(ws + OFF_AB); \
  float* SSQ = (float*)(ws + OFF_SSQ); \
  float* GL = (float*)(ws + OFF_GL); \
  f32x4* STB = (f32x4*)(ws + OFF_ST); \
  bf16_t* STASH = (bf16_t*)(ws + OFF_STASH); \
  bf16_t* H = (bf16_t*)(ws + OFF_H); \
  bf16_t* MIX = (bf16_t*)(ws + OFF_MIX); \
  char* BIG = ws + OFF_BIG;
__global__ void __launch_bounds__(512) mega_kernel(Params p) {
  __shared__ __attribute__((aligned(16))) char smem[LDS_BYTES];
  cg::grid_group grid = cg::this_grid();
  char* ws0 = p.ws;
  volatile LAS unsigned* xst = (volatile LAS unsigned*)(LAS unsigned char*)(smem + XST_OFF);
  if (threadIdx.x < 2) xst[threadIdx.x] = 0u;
  __syncthreads();
  const XcdBarrier xb = xcd_barrier_post((unsigned*)(ws0 + OFF_BAR), xst);

  {
  char* ws = lp(ws0);
  WS_PTRS(ws)
  conv_seg(p.a_w_in, 4096, 0, 2560, (bf16_t*)(ws + OFF_W1_0), 1024, smem);
  conv_seg(p.a_w_in, 4096, 2560, 1536, W2, 1024, smem);
  conv_seg(p.a_w_in + 1024 * 4096, 4096, 0, 2560, (bf16_t*)(ws + OFF_W1_3), 1024, smem);
  conv_seg(p.a_w_in + 1024 * 4096, 4096, 2560, 1536, W2 + 3 * 1536 * 1024, 1024, smem);
  conv_seg(p.b_w_in, 5120, 0, 3584, (bf16_t*)(ws + OFF_W1_1), 1024, smem);
  conv_seg(p.b_w_in, 5120, 3584, 1536, W2 + 1 * 1536 * 1024, 1024, smem);
  conv_seg(p.c_w_in, 5136, 0, 3072, ((bf16_t*)(ws + OFF_W1_2)), 1024, smem);
  conv_seg(p.c_w_in, 5136, 3088, 512, ((bf16_t*)(ws + OFF_W1_2)) + 3072 * 1024, 1024, smem);
  conv_seg(p.c_w_in, 5136, 3072, 16, ((bf16_t*)(ws + OFF_W1_2)) + 3584 * 1024, 1024, smem);
  conv_seg(p.c_w_in, 5136, 3600, 1536, W2 + 2 * 1536 * 1024, 1024, smem);
  for (int l = 0; l < 4; l++) conv_seg(p.w_out + (size_t)l * 1536 * 1024, 1024, 0, 1024, WO + (size_t)l * 1024 * 1536, 1536, smem);
  conv_seg(p.w_mem_kv, 1024, 0, 1024, WM, 1024, smem);
  for (int i = blockIdx.x * 512 + otid(); i < 240 * 1024 / 2; i += gridDim.x * 512) ((unsigned*)(((bf16_t*)(ws + OFF_W1_2)) + 3600 * 1024))[i] = 0u;
  for (int i = blockIdx.x * 512 + otid(); i < 2 * 8 * 128 * 128; i += gridDim.x * 512) {
    const int s = i & 127, t = (i >> 7) & 127;
    WS[i] = (s <= t) ? f2bf(p.a_w_s[i]) : (bf16_t)0;
  }
  {
    float* prm = (float*)(ws + OFF_PRM);
    const int gt = blockIdx.x * 512 + otid(), gs = gridDim.x * 512;
    for (int i = gt; i < 4096; i += gs) { prm[PRM_NPRE + i] = p.norm_pre[i]; prm[PRM_NPOST + i] = p.norm_post[i]; }
    for (int i = gt; i < 2048; i += gs) { prm[PRM_ALNW + i] = p.a_ln_w[i]; prm[PRM_ALNB + i] = p.a_ln_b[i]; prm[PRM_ABS + i] = p.a_b_s[i]; }
    for (int i = gt; i < 3072; i += gs) prm[PRM_BCW + i] = p.b_conv_w[i];
    for (int i = gt; i < 12288; i += gs) prm[PRM_CCW + i] = p.c_conv_w[i];
    for (int i = gt; i < 8; i += gs) { prm[PRM_CALOG + i] = p.c_a_log[i]; prm[PRM_CDT + i] = p.c_dt_bias[i]; }
    for (int i = gt; i < 128; i += gs) prm[PRM_CONW + i] = p.c_o_norm_w[i];
  }
  rmsnorm_rows(p.x, p.norm_pre, H, NTOK);
  rmsnorm_rows(p.mem, p.mem_norm_w, HMEM, 1024);
  }
  grid.sync();

  for (int ph = 0; ph < 23; ph++) {
    char* ws = lp(ws0);
    WS_PTRS(ws)
    int l, q;
    if (ph < 5) { l = 0; q = ph; } else if (ph < 10) { l = 1; q = ph - 5; } else if (ph < 18) { l = 2; q = ph - 10; } else { l = 3; q = ph - 18; }
    const int kind = l % 3;
    int op, hf = 0;
    if (kind == 2) { op = q == 0 ? 0 : q == 1 ? 1 : q == 2 ? 6 : q == 3 ? 1 : q == 4 ? 7 : q == 5 ? 8 : q == 6 ? 4 : 5; hf = q >= 3 ? 1 : 0; }
    else op = q == 0 ? 0 : (q == 1 ? 2 : q + 1);
    const int bx = blockIdx.x, G = gridDim.x;
    const bool scanblk = (op == 6 || op == 7) && bx < 32;
    if (op == 0 || (op == 6 && !scanblk)) {
      const bf16_t* W1l = (const bf16_t*)(ws + (l == 0 ? OFF_W1_0 : l == 1 ? OFF_W1_1 : l == 2 ? OFF_W1_2 : OFF_W1_3));
      if (kind == 0) {
        EpiA1 e{(bf16_t*)BIG, (bf16_t*)(BIG + BIG_VT), (bf16_t*)(BIG + BIG_QX)};
        gemm_phase(H, W1l, NTOK, 2560, 1024, e, smem);
      } else if (kind == 1) {
        EpiPlain e{(bf16_t*)BIG, 3584};
        gemm_phase(H, W1l, NTOK, 3584, 1024, e, smem);
      } else {
        const int g1h = op == 6 ? 1 : 0;
        EpiC1 e{(bf16_t*)BIG, AB, g1h * 4096};
        gemm_phase(H, W1l, 16384, 3840, 1024, e, smem, g1h * 4096, op == 6 ? G - 32 : -1, bx - 32);
      }
      if (l == 0) {
        EpiMem e{KIMG, VIMG};
        gemm_phase(HMEM, WM, 1024, 1024, 1024, e, smem);
      }
    }
    if (op == 1) prep_phase((const bf16_t*)BIG, AB, PRM + PRM_CCW, PRM + PRM_CALOG, PRM + PRM_CDT, BIG + BIG_OPS, GL, STASH, hf, smem);
    if (op == 2) {
      if (kind == 0) {
        const int j = l / 3;
        gmlp_phase((const bf16_t*)BIG, (const bf16_t*)(BIG + BIG_VT), WS + (size_t)j * 8 * 128 * 128, PRM + PRM_ALNW + j * 1024, PRM + PRM_ALNB + j * 1024,
                   PRM + PRM_ABS + j * 1024, MIX, smem);
      } else {
        sconv_phase((const bf16_t*)BIG, PRM + PRM_BCW, MIX);
      }
    }
    if (scanblk) scan_block(BIG + BIG_OPS, GL, MIX, SSQ, STB, op == 6 ? 0 : 1, smem);
    if (op == 1 || op == 2) {
      const bf16_t* Q; int ldq, tok0, nrows;
      if (kind == 0) { Q = (const bf16_t*)(BIG + BIG_QX); ldq = 512; tok0 = -1; nrows = NTOK; }
      else if (kind == 1) { Q = (const bf16_t*)BIG + 3072; ldq = 3584; tok0 = -1; nrows = NTOK; }
      else { Q = (const bf16_t*)BIG + 3072; ldq = 3584; tok0 = hf * 4096; nrows = 16384; }
      attn_phase(Q, ldq, tok0, nrows, KIMG, VIMG, MIX, bx, G, smem);
    }
    if (op == 3 || op == 8 || (op == 7 && !scanblk)) {
      const int nv = op == 7 ? 2 : 1;
      for (int v = 0; v < nv; v++) {
        const bf16_t* Bz = W2 + (size_t)l * 1536 * 1024;
        int M = NTOK, N = 1536, asplit = -1, col0 = 0;
        if (op == 7 && v == 0) { Bz += (size_t)1024 * 1024; N = 512; col0 = 1024; }
        if ((op == 7 && v == 1) || op == 8) { M = 16384; N = 1024; asplit = op == 8 ? 4096 : 0; }
        EpiGate e{MIX, SSQ, PRM + PRM_CONW, kind == 2 ? 1 : 0, col0, asplit};
        gemm_phase(H, Bz, M, N, 1024, e, smem, asplit, op == 7 ? G - 32 : -1, bx - 32);
      }
    }
    if (op == 4) {
      EpiOut e{(bf16_t*)BIG};
      gemm_phase(MIX, WO + (size_t)l * 1024 * 1536, NTOK, 1024, 1536, e, smem);
    }
    if (op == 5) {
      norm_phase((const bf16_t*)BIG, l == 0 ? p.x : p.out, p.out, PRM + PRM_NPOST + l * 1024, l < 3 ? PRM + PRM_NPRE + (l + 1) * 1024 : nullptr, H);
    }
    xcd_barrier(xb);
  }
}

extern "C" void kernel_launch(void* const* d_in, const int* in_sizes, int n_in, void* d_out, int out_size, void* d_ws, size_t ws_size,
                              hipStream_t stream) {
  static int grid_blocks = 0;
  if (!grid_blocks) {
    int dev = 0, cus = 0, per_cu = 0;
    (void)hipGetDevice(&dev);
    (void)hipDeviceGetAttribute(&cus, hipDeviceAttributeMultiprocessorCount, dev);
    (void)hipOccupancyMaxActiveBlocksPerMultiprocessor(&per_cu, mega_kernel, 512, 0);
    if (per_cu > 1) per_cu = 1;
    if (per_cu < 1) per_cu = 1;
    grid_blocks = cus * per_cu;
  }
  Params p{};
  p.x = (const float*)d_in[0]; p.mem = (const float*)d_in[1]; p.mem_norm_w = (const float*)d_in[2]; p.w_mem_kv = (const float*)d_in[3];
  p.norm_pre = (const float*)d_in[4]; p.norm_post = (const float*)d_in[5]; p.w_out = (const float*)d_in[6]; p.a_w_in = (const float*)d_in[7];
  p.a_ln_w = (const float*)d_in[8]; p.a_ln_b = (const float*)d_in[9]; p.a_w_s = (const float*)d_in[10]; p.a_b_s = (const float*)d_in[11];
  p.b_w_in = (const float*)d_in[12]; p.b_conv_w = (const float*)d_in[13]; p.c_w_in = (const float*)d_in[14]; p.c_conv_w = (const float*)d_in[15];
  p.c_a_log = (const float*)d_in[16]; p.c_dt_bias = (const float*)d_in[17]; p.c_o_norm_w = (const float*)d_in[18];
  p.out = (float*)d_out;
  p.ws = (char*)d_ws;
  (void)hipMemsetAsync((char*)d_ws + OFF_BAR, 0, XCD_BAR_WORDS * sizeof(unsigned), stream);
  void* args[] = {&p};
  hipError_t e = hipLaunchCooperativeKernel((void*)mega_kernel, dim3(grid_blocks), dim3(512), args, 0, stream);
  if (e != hipSuccess) fprintf(stderr, "cooperative launch failed: %s (grid %d)\n", hipGetErrorString(e), grid_blocks);
}
```

```cpp
#include <hip/hip_runtime.h>
#include <hip/hip_cooperative_groups.h>
#include <cstdio>
namespace cg = cooperative_groups;

#define DI __device__ __forceinline__
typedef unsigned short bf16_t;
typedef short bf16x8 __attribute__((ext_vector_type(8)));
typedef float f32x4 __attribute__((ext_vector_type(4)));
typedef unsigned u32x4 __attribute__((ext_vector_type(4)));
typedef unsigned u32x2 __attribute__((ext_vector_type(2)));

constexpr int NTOK = 32768;
constexpr float EPS = 1e-6f;
constexpr int LDS_BYTES = 161856;
constexpr int OPS_STRIDE = 73728;

constexpr size_t SZ_W1A = 2560ull * 1024 * 2, SZ_W1B = 3584ull * 1024 * 2, SZ_W1C = 3840ull * 1024 * 2;
constexpr size_t OFF_W1_0 = 0;
constexpr size_t OFF_W1_1 = OFF_W1_0 + SZ_W1A;
constexpr size_t OFF_W1_2 = OFF_W1_1 + SZ_W1B;
constexpr size_t OFF_W1_3 = OFF_W1_2 + SZ_W1C;
constexpr size_t SZ_W2 = 1536ull * 1024 * 2;
constexpr size_t OFF_W2 = OFF_W1_3 + SZ_W1A;
constexpr size_t OFF_WO = OFF_W2 + 4 * SZ_W2;
constexpr size_t OFF_WM = OFF_WO + 4 * SZ_W2;
constexpr size_t OFF_WS = OFF_WM + 2097152;
constexpr size_t OFF_HMEM = OFF_WS + 524288;
constexpr size_t OFF_KIMG = OFF_HMEM + 2097152;
constexpr size_t OFF_VIMG = OFF_KIMG + 1048576;
constexpr size_t OFF_AB = OFF_VIMG + 1048576;
constexpr size_t OFF_SSQ = OFF_AB + 2097152;
constexpr size_t OFF_GL = OFF_SSQ + 1048576;
constexpr size_t OFF_ST = OFF_GL + 65536;
constexpr size_t OFF_STASH = OFF_ST + 2097152;
constexpr size_t OFF_BAR = OFF_STASH + 131072;
constexpr size_t OFF_PRM = OFF_BAR + 65536;
constexpr size_t OFF_H = OFF_PRM + 131072;
constexpr size_t OFF_MIX = OFF_H + 67108864;
constexpr size_t OFF_BIG = OFF_MIX + 100663296;
constexpr size_t BIG_VT = 67108864, BIG_QX = 134217728, BIG_OPS = 117440512;
static_assert(OFF_BIG + 268435456ull <= 536870912ull, "workspace overflow");

struct Params {
  const float *x, *mem, *mem_norm_w, *w_mem_kv, *norm_pre, *norm_post, *w_out, *a_w_in, *a_ln_w, *a_ln_b, *a_w_s, *a_b_s,
      *b_w_in, *b_conv_w, *c_w_in, *c_conv_w, *c_a_log, *c_dt_bias, *c_o_norm_w;
  float* out;
  char* ws;
};

typedef float f32x2 __attribute__((ext_vector_type(2)));
typedef __bf16 bf16x2_t __attribute__((ext_vector_type(2)));
DI unsigned pk2(float lo, float hi) { f32x2 v = {lo, hi}; bf16x2_t b = __builtin_convertvector(v, bf16x2_t); return __builtin_bit_cast(unsigned, b); }
DI float lo2f(unsigned p) { return __uint_as_float(p << 16); }
DI float hi2f(unsigned p) { return __uint_as_float(p & 0xffff0000u); }
DI float bf2f(bf16_t v) { return __uint_as_float(((unsigned)v) << 16); }
DI bf16_t f2bf(float f) { return (bf16_t)(pk2(f, 0.f) & 0xffffu); }
DI int zoff() { int z; asm volatile("s_mov_b32 %0, 0" : "=s"(z)); return z; }
DI int obid() { int r; asm volatile("s_mov_b32 %0, %1" : "=s"(r) : "s"(blockIdx.x)); return r; }
DI int ogrid() { int r; asm volatile("s_mov_b32 %0, %1" : "=s"(r) : "s"(gridDim.x)); return r; }
template <class T> DI T* lp(T* p) { return (T*)((char*)p + zoff()); }
DI int otid() { int t; asm volatile("v_mov_b32 %0, %1" : "=v"(t) : "v"(threadIdx.x)); return t; }
DI float wsum(float v) {
#pragma unroll
  for (int o = 32; o; o >>= 1) v += __shfl_xor(v, o);
  return v;
}
DI float sigmoidf_(float x) { return __builtin_amdgcn_rcpf(1.f + __expf(-x)); }
DI float siluf_(float x) { return x * sigmoidf_(x); }
DI float geluf_(float x) { const float u = 0.7978845608028654f * (x + 0.044715f * x * x * x); return x * sigmoidf_(2.f * u); }
DI f32x4 mfma16(bf16x8 a, bf16x8 b, f32x4 c) { return __builtin_amdgcn_mfma_f32_16x16x32_bf16(a, b, c, 0, 0, 0); }
DI bf16x8 pack8(f32x4 a, f32x4 b) {
  u32x4 p; p[0] = pk2(a[0], a[1]); p[1] = pk2(a[2], a[3]); p[2] = pk2(b[0], b[1]); p[3] = pk2(b[2], b[3]);
  return __builtin_bit_cast(bf16x8, p);
}
DI void unpack8(u32x4 p, float* v) {
#pragma unroll
  for (int i = 0; i < 4; i++) { v[2 * i] = lo2f(p[i]); v[2 * i + 1] = hi2f(p[i]); }
}

#define LAS __attribute__((address_space(3)))
constexpr int G_BM = 256, G_BK = 64, G_HALF = 128, G_HTB = G_HALF * G_BK * 2, G_NXCD = 8, G_WGM = 8;
DI int lds_byte(int r, int c) { const int st = (r >> 4) * 2 + (c >> 5), rr = r & 15, cc = c & 31, ob = rr * 64 + cc * 2; return st * 1024 + (ob ^ (((ob >> 9) & 1) << 5)); }
DI void stage_rc(int b, int& R, int& C) { const int st = b / 1024, sb = b % 1024, swz = sb ^ (((sb >> 9) & 1) << 5); R = (st >> 1) * 16 + swz / 64; C = (st & 1) * 32 + (swz % 64) / 2; }
struct UnitOrder {
  int nM, nN, nwg, G, c;
  DI void init(int M, int N, int G_, int c_) { nM = M / G_BM; nN = N / G_BM; nwg = nM * nN; G = G_; c = c_; }
  DI bool next(int i, int& pm, int& pn) const {
    const long L = (long)i * G + c; if (L >= nwg) return false;
    int wgid = (int)L; { const int q = nwg / G_NXCD, r = nwg % G_NXCD, xcd = wgid % G_NXCD, off = wgid / G_NXCD; wgid = (xcd < r ? xcd * (q + 1) : r * (q + 1) + (xcd - r) * q) + off; }
    const int nig = G_WGM * nN, gid = wgid / nig, fm = gid * G_WGM, gsz = (nM - fm) < G_WGM ? (nM - fm) : G_WGM;
    pm = fm + ((wgid % nig) % gsz); pn = (wgid % nig) / gsz; return true;
  }
};
template <class Epi>
DI void gemm_phase(const bf16_t* __restrict__ A, const bf16_t* __restrict__ Bt, int M, int N, int K, const Epi& epi, char* smem, int asplit = -1, int gG = -1, int gC = 0) {
  const int bx_ = obid(), G_ = ogrid(); (void)bx_; (void)G_;
  A = lp(A);
  Bt = lp(Bt);
  smem += zoff();
  LAS unsigned char* lds = (LAS unsigned char*)smem;
  const int tid = otid(), wid = __builtin_amdgcn_readfirstlane(tid >> 6), lane = tid & 63, wr = wid >> 2, wc = wid & 3, fr = lane & 15, fq = lane >> 4;
  const int nt = K / G_BK;
  unsigned voff[2], voffB[2];
#pragma unroll
  for (int i = 0; i < 2; ++i) { int R, C; stage_rc(tid * 16 + i * 8192, R, C); const int rho = R & 31, Rb = (R & ~31) + 8 * ((rho & 15) >> 2) + 4 * (rho >> 4) + (rho & 3);
    voff[i] = (unsigned)(R * K + C) * 2u; voffB[i] = (unsigned)(Rb * K + C) * 2u; }
  const size_t kstep = (size_t)(G_BK * 2);
  const size_t hstep = (size_t)G_HALF * K * 2;
  const size_t tstep = 2 * hstep;
  const unsigned ldsw = (unsigned)wid * 1024u;
  const int aoff = lds_byte(wr * 64 + fr, fq * 8), boff = lds_byte(wc * 32 + fr, fq * 8);
#define PG8_SA(b, h) (((b) * 2 + (h)) * G_HTB)
#define PG8_SB(b, h) ((4 + (b) * 2 + (h)) * G_HTB)
#define PG8_STAGEV(bufoff, gbase, vo) do { _Pragma("unroll") for (int _i = 0; _i < 2; ++_i) \
    __builtin_amdgcn_global_load_lds((const unsigned*)((const char*)(gbase) + (vo)[_i]), (LAS unsigned*)(lds + (bufoff) + ldsw + _i * 8192), 16, 0, 0); } while (0)
#define PG8_STAGE(bufoff, gbase) PG8_STAGEV(bufoff, gbase, voff)
#define PG8_STAGEB(bufoff, gbase) PG8_STAGEV(bufoff, gbase, voffB)
#define PG8_LDA(dst, b, h) do { _Pragma("unroll") for (int m = 0; m < 4; ++m) _Pragma("unroll") for (int k = 0; k < 2; ++k) dst[m][k] = *(const LAS bf16x8*)(lds + PG8_SA(b, h) + aoff + m * 2048 + k * 1024); } while (0)
#define PG8_LDB(dst, b, h) do { _Pragma("unroll") for (int n = 0; n < 2; ++n) _Pragma("unroll") for (int k = 0; k < 2; ++k) dst[n][k] = *(const LAS bf16x8*)(lds + PG8_SB(b, h) + boff + n * 2048 + k * 1024); } while (0)
#define PG8_MMA(ai, bj, At, Bt_) do { __builtin_amdgcn_s_setprio(1); _Pragma("unroll") for (int m = 0; m < 4; ++m) _Pragma("unroll") for (int n = 0; n < 2; ++n) _Pragma("unroll") for (int k = 0; k < 2; ++k) \
    acc[ai][bj][m][n] = __builtin_amdgcn_mfma_f32_16x16x32_bf16(Bt_[n][k], At[m][k], acc[ai][bj][m][n], 0, 0, 0); __builtin_amdgcn_s_setprio(0); } while (0)
#define PG8_WAIT_V(n) asm volatile("s_waitcnt vmcnt(" #n ")" ::: "memory")
#define PG8_WAIT_L(n) asm volatile("s_waitcnt lgkmcnt(" #n ")" ::: "memory")
#define PG8_BAR __builtin_amdgcn_s_barrier()
#define PG8_SCHED __builtin_amdgcn_sched_barrier(0)
#define PG8_AROW(pm) ((size_t)(asplit < 0 ? (pm) * 256 : (((pm) >> 4) << 13) + asplit + (((pm) & 15) << 8)))
  UnitOrder S; S.init(M, N, gG < 0 ? G_ : gG, gG < 0 ? bx_ : gC);
  int cpm, cpn, npm = 0, npn = 0, ui = 0;
  if (!S.next(0, cpm, cpn)) return;
  f32x4 acc[2][2][4][2];
#pragma unroll
  for (int a = 0; a < 2; ++a)
#pragma unroll
    for (int b = 0; b < 2; ++b)
#pragma unroll
      for (int m = 0; m < 4; ++m)
#pragma unroll
        for (int n = 0; n < 2; ++n) acc[a][b][m][n] = (f32x4){0.f, 0.f, 0.f, 0.f};
  bf16x8 At[4][2], B0[2][2], B1[2][2];
  const char* cA = (const char*)A + PG8_AROW(cpm) * K * 2; const char* cB = (const char*)Bt + (size_t)cpn * tstep;
  PG8_STAGEB(PG8_SB(0, 0), cB); PG8_STAGE(PG8_SA(0, 0), cA); PG8_STAGEB(PG8_SB(0, 1), cB + hstep); PG8_STAGE(PG8_SA(0, 1), cA + hstep);
  if (wr == 1) PG8_BAR;
  PG8_WAIT_V(4); PG8_BAR;
  PG8_STAGEB(PG8_SB(1, 0), cB + kstep); PG8_STAGE(PG8_SA(1, 0), cA + kstep); PG8_STAGEB(PG8_SB(1, 1), cB + hstep + kstep);
  PG8_WAIT_V(6); PG8_BAR;
  for (;;) {
    const bool has_next = S.next(ui + 1, npm, npn);
    const char* nA = has_next ? (const char*)A + PG8_AROW(npm) * K * 2 : cA; const char* nB = has_next ? (const char*)Bt + (size_t)npn * tstep : cB;
    for (int t = 0; t < nt; t += 2) {
      const bool last = (t == nt - 2);
      const char* a1 = cA + (size_t)(t + 1) * kstep;
      const char* a2 = last ? nA : cA + (size_t)(t + 2) * kstep; const char* b2 = last ? nB : cB + (size_t)(t + 2) * kstep;
      const char* a3 = a2 + kstep; const char* b3 = b2 + kstep;
      PG8_LDB(B0, 0, 0); PG8_SCHED; PG8_LDA(At, 0, 0); PG8_STAGE(PG8_SA(1, 1), a1 + hstep);
      PG8_WAIT_L(8); PG8_BAR; PG8_WAIT_L(0); PG8_MMA(0, 0, At, B0); PG8_BAR; PG8_SCHED;
      PG8_LDB(B1, 0, 1); PG8_STAGEB(PG8_SB(0, 0), b2);
      PG8_BAR; PG8_WAIT_L(0); PG8_MMA(0, 1, At, B1); PG8_BAR;
      PG8_LDA(At, 0, 1); PG8_STAGE(PG8_SA(0, 0), a2);
      PG8_BAR; PG8_WAIT_L(0); PG8_MMA(1, 0, At, B0); PG8_BAR; PG8_SCHED;
      PG8_STAGEB(PG8_SB(0, 1), b2 + hstep);
      PG8_WAIT_V(6); PG8_BAR; PG8_MMA(1, 1, At, B1); PG8_BAR;
      PG8_LDB(B0, 1, 0); PG8_SCHED; PG8_LDA(At, 1, 0); PG8_STAGE(PG8_SA(0, 1), a2 + hstep);
      PG8_WAIT_L(8); PG8_BAR; PG8_WAIT_L(0); PG8_MMA(0, 0, At, B0); PG8_BAR; PG8_SCHED;
      PG8_LDB(B1, 1, 1); PG8_STAGEB(PG8_SB(1, 0), b3);
      PG8_BAR; PG8_WAIT_L(0); PG8_MMA(0, 1, At, B1); PG8_BAR;
      PG8_LDA(At, 1, 1); PG8_STAGE(PG8_SA(1, 0), a3);
      PG8_BAR; PG8_WAIT_L(0); PG8_MMA(1, 0, At, B0); PG8_BAR; PG8_SCHED;
      PG8_STAGEB(PG8_SB(1, 1), b3 + hstep);
      PG8_WAIT_V(6); PG8_BAR; PG8_MMA(1, 1, At, B1); PG8_BAR;
    }
    if constexpr (Epi::PRELOAD) {
#pragma unroll
      for (int ai = 0; ai < 2; ++ai) {
        u32x4 pre[4][2]; float prq[4][2];
#pragma unroll
        for (int m = 0; m < 4; ++m)
#pragma unroll
          for (int bj = 0; bj < 2; ++bj)
            pre[m][bj] = epi.pre(cpm * 256 + ai * 128 + wr * 64 + m * 16 + fr, cpn * 256 + bj * 128 + wc * 32 + fq * 8, prq[m][bj]);
        __builtin_amdgcn_sched_barrier(0);
#pragma unroll
        for (int m = 0; m < 4; ++m)
#pragma unroll
          for (int bj = 0; bj < 2; ++bj)
            epi.fin(cpm * 256 + ai * 128 + wr * 64 + m * 16 + fr, cpn * 256 + bj * 128 + wc * 32 + fq * 8, acc[ai][bj][m][0], acc[ai][bj][m][1], pre[m][bj], prq[m][bj]);
      }
    } else {
#pragma unroll
      for (int ai = 0; ai < 2; ++ai)
#pragma unroll
        for (int m = 0; m < 4; ++m)
#pragma unroll
          for (int bj = 0; bj < 2; ++bj)
            epi(cpm * 256 + ai * 128 + wr * 64 + m * 16 + fr, cpn * 256 + bj * 128 + wc * 32 + fq * 8, acc[ai][bj][m][0], acc[ai][bj][m][1]);
    }
    if (!has_next) break;
#pragma unroll
    for (int a = 0; a < 2; ++a)
#pragma unroll
      for (int b = 0; b < 2; ++b)
#pragma unroll
        for (int m = 0; m < 4; ++m)
#pragma unroll
          for (int n = 0; n < 2; ++n) acc[a][b][m][n] = (f32x4){0.f, 0.f, 0.f, 0.f};
    cpm = npm; cpn = npn; cA = nA; cB = nB; ++ui;
  }
  PG8_WAIT_V(0);
  if (wr == 0) PG8_BAR;
  PG8_BAR;
#undef PG8_SA
#undef PG8_SB
#undef PG8_STAGE
#undef PG8_STAGEB
#undef PG8_STAGEV
#undef PG8_LDA
#undef PG8_LDB
#undef PG8_MMA
#undef PG8_WAIT_V
#undef PG8_WAIT_L
#undef PG8_BAR
#undef PG8_SCHED
#undef PG8_AROW
}

DI u32x4 pk8(f32x4 a, f32x4 b) { return (u32x4){pk2(a[0], a[1]), pk2(a[2], a[3]), pk2(b[0], b[1]), pk2(b[2], b[3])}; }
struct EpiMem {
  static constexpr bool PRELOAD = false;
  bf16_t *kimg, *vimg;
  DI void operator()(int row, int col, f32x4 v0, f32x4 v1) const {
    const int b = row >> 8, m = row & 255;
    const int cb = __builtin_amdgcn_readfirstlane(col & ~127);
    if (cb < 512) {
      const int head = col >> 7, d = col & 127;
      const int mt = m >> 4, n = m & 15, ks = d >> 5, jq = (d & 31) >> 3;
      *(u32x4*)(kimg + (size_t)(b * 4 + head) * 32768 + ((mt * 4 + ks) * 64 + jq * 16 + n) * 8) = pk8(v0, v1);
    } else {
      const int c2 = col - 512, head = c2 >> 7, d0 = c2 & 127;
      const int kk = m >> 5, mm = m & 31, j = 4 * (mm >> 4) + (mm & 3), jq = (mm & 15) >> 2;
#pragma unroll
      for (int i = 0; i < 8; i++) {
        const int d = d0 + i, dt = d >> 4, r = d & 15;
        vimg[(size_t)(b * 4 + head) * 32768 + ((dt * 8 + kk) * 64 + jq * 16 + r) * 8 + j] = f2bf(i < 4 ? v0[i & 3] : v1[i & 3]);
      }
    }
  }
};
struct EpiA1 {
  static constexpr bool PRELOAD = false;
  bf16_t *U, *VT, *QX;
  DI void operator()(int row, int col, f32x4 v0, f32x4 v1) const {
    const int cb = __builtin_amdgcn_readfirstlane(col & ~127);
    if (cb < 2048) {
#pragma unroll
      for (int i = 0; i < 4; i++) { v0[i] = geluf_(v0[i]); v1[i] = geluf_(v1[i]); }
      if (cb < 1024) {
        *(u32x4*)(U + (size_t)row * 1024 + col) = pk8(v0, v1);
      } else {
        const int c = col - 1024, chunk = row >> 7, s = row & 127;
#pragma unroll
        for (int i = 0; i < 8; i++) VT[(((size_t)chunk * 1024 + c + i) << 7) + s] = f2bf(i < 4 ? v0[i & 3] : v1[i & 3]);
      }
    } else {
      *(u32x4*)(QX + (size_t)row * 512 + (col - 2048)) = pk8(v0, v1);
    }
  }
};
struct EpiPlain {
  static constexpr bool PRELOAD = false;
  bf16_t* R; int ld;
  DI void operator()(int row, int col, f32x4 v0, f32x4 v1) const { *(u32x4*)(R + (size_t)row * ld + col) = pk8(v0, v1); }
};
struct EpiC1 {
  static constexpr bool PRELOAD = false;
  bf16_t* R; float* ab; int hfoff;
  DI void operator()(int row, int col, f32x4 v0, f32x4 v1) const {
    const int cb = __builtin_amdgcn_readfirstlane(col & ~127);
    if (cb < 3584) *(u32x4*)(R + (size_t)row * 3584 + col) = pk8(v0, v1);
    else if (cb == 3584 && col < 3600) {
      float* p = ab + (size_t)(((row >> 12) << 13) + hfoff + (row & 4095)) * 16 + (col - 3584);
      *(f32x4*)p = v0; *(f32x4*)(p + 4) = v1;
    }
  }
};
struct EpiGate {
  static constexpr bool PRELOAD = true;
  bf16_t* Y; const float* __restrict__ ssq; const float* __restrict__ onw; int isC, col0, hfoff;
  DI int tokof(int row) const { return hfoff < 0 ? row : ((row >> 12) << 13) + hfoff + (row & 4095); }
  DI u32x4 pre(int row, int col, float& q) const {
    const int tok = tokof(row), yc = col + col0;
    q = 0.f;
    if (isC && __builtin_amdgcn_readfirstlane(yc & ~127) < 1024) q = ssq[(size_t)tok * 8 + (yc >> 7)];
    return *(const u32x4*)(Y + (size_t)tok * 1536 + yc);
  }
  DI void fin(int row, int col, f32x4 v0, f32x4 v1, u32x4 pr, float q) const {
    const int tok = tokof(row), yc = col + col0;
    float a[8]; unpack8(pr, a);
    if (isC && __builtin_amdgcn_readfirstlane(yc & ~127) < 1024) {
      const float r = rsqrtf(q * (1.f / 128.f) + EPS);
      const f32x4 w0 = *(const f32x4*)(onw + (yc & 127)), w1 = *(const f32x4*)(onw + (yc & 127) + 4);
#pragma unroll
      for (int i = 0; i < 4; i++) { a[i] *= r * w0[i]; a[4 + i] *= r * w1[i]; }
    }
    f32x4 o0, o1;
#pragma unroll
    for (int i = 0; i < 4; i++) { o0[i] = a[i] * siluf_(v0[i]); o1[i] = a[4 + i] * siluf_(v1[i]); }
    *(u32x4*)(Y + (size_t)tok * 1536 + yc) = pk8(o0, o1);
  }
};
struct EpiOut {
  static constexpr bool PRELOAD = false;
  bf16_t* O;
  DI void operator()(int row, int col, f32x4 v0, f32x4 v1) const { *(u32x4*)(O + (size_t)row * 1024 + col) = pk8(v0, v1); }
};

#define LDS_BAR() do { asm volatile("s_waitcnt lgkmcnt(0)" ::: "memory"); __builtin_amdgcn_s_barrier(); asm volatile("" ::: "memory"); } while (0)
DI void conv_seg(const float* __restrict__ src, int ld, int col0, int ncols, bf16_t* __restrict__ dst, int K, char* smem) {
  const int bx_ = obid(), G_ = ogrid();
  smem += zoff();
  float* tile = (float*)smem;
  const int tid = otid();
  const int ntj = (ncols + 63) >> 6, ntk = K >> 6, nt = ntj * ntk;
  const int jj = tid & 63, k0 = tid >> 6;
  float r[8];
  int t = bx_;
  if (t < nt) {
    const int tj = t % ntj, tk = t / ntj;
    const bool ok = (tj * 64 + jj) < ncols;
#pragma unroll
    for (int i = 0; i < 8; i++) r[i] = ok ? src[(size_t)(tk * 64 + k0 + 8 * i) * ld + col0 + tj * 64 + jj] : 0.f;
  }
  for (; t < nt; t += G_) {
    const int tj = t % ntj, tk = t / ntj;
#pragma unroll
    for (int i = 0; i < 8; i++) tile[(k0 + 8 * i) * 65 + jj] = r[i];
    LDS_BAR();
    if (t + G_ < nt) {
      const int t2 = t + G_, tj2 = t2 % ntj, tk2 = t2 / ntj;
      const bool ok = (tj2 * 64 + jj) < ncols;
#pragma unroll
      for (int i = 0; i < 8; i++) r[i] = ok ? src[(size_t)(tk2 * 64 + k0 + 8 * i) * ld + col0 + tj2 * 64 + jj] : 0.f;
    }
    {
      const int kk2 = (tid & 31) * 2, j2 = tid >> 5;
#pragma unroll
      for (int i = 0; i < 4; i++) {
        const int j = j2 + 16 * i;
        if (tj * 64 + j < ncols) *(unsigned*)(dst + (size_t)(tj * 64 + j) * K + tk * 64 + kk2) = pk2(tile[kk2 * 65 + j], tile[(kk2 + 1) * 65 + j]);
      }
    }
    LDS_BAR();
  }
}

DI void rmsnorm_rows(const float* __restrict__ x, const float* __restrict__ w, bf16_t* __restrict__ h, int nrows) {
  const int bx_ = obid(), G_ = ogrid(); (void)bx_; (void)G_;
  x = lp(x);
  w = lp(w);
  h = lp(h);
  const int lane = otid() & 63, wid = otid() >> 6;
  f32x4 wv[4];
#pragma unroll
  for (int i = 0; i < 4; i++) wv[i] = *(const f32x4*)(w + i * 256 + lane * 4);
  for (int row = bx_ * 8 + wid; row < nrows; row += G_ * 8) {
    f32x4 v[4]; float ss = 0.f;
#pragma unroll
    for (int i = 0; i < 4; i++) { v[i] = *(const f32x4*)(x + (size_t)row * 1024 + i * 256 + lane * 4); ss += v[i][0] * v[i][0] + v[i][1] * v[i][1] + v[i][2] * v[i][2] + v[i][3] * v[i][3]; }
    ss = wsum(ss);
    const float r = rsqrtf(ss * (1.f / 1024.f) + EPS);
#pragma unroll
    for (int i = 0; i < 4; i++)
      *(u32x2*)(h + (size_t)row * 1024 + i * 256 + lane * 4) = (u32x2){pk2(v[i][0] * r * wv[i][0], v[i][1] * r * wv[i][1]), pk2(v[i][2] * r * wv[i][2], v[i][3] * r * wv[i][3])};
  }
}

DI void norm_phase(const bf16_t* __restrict__ O, const float* xin, float* xout, const float* __restrict__ wpost, const float* __restrict__ wpre, bf16_t* __restrict__ h) {
  const int bx_ = obid(), G_ = ogrid(); (void)bx_; (void)G_;
  O = lp(O);
  xin = lp(xin);
  xout = lp(xout);
  wpost = lp(wpost);
  wpre = lp(wpre);
  h = lp(h);
  const int lane = otid() & 63, wid = otid() >> 6;
  f32x4 wp[4], wq[4];
#pragma unroll
  for (int i = 0; i < 4; i++) { wp[i] = *(const f32x4*)(wpost + i * 256 + lane * 4); wq[i] = wpre ? *(const f32x4*)(wpre + i * 256 + lane * 4) : (f32x4){0.f, 0.f, 0.f, 0.f}; }
  for (int row = bx_ * 8 + wid; row < NTOK; row += G_ * 8) {
    f32x4 o[4], xv[4]; float ss = 0.f;
#pragma unroll
    for (int i = 0; i < 4; i++) {
      { const u32x2 ob = *(const u32x2*)(O + (size_t)row * 1024 + i * 256 + lane * 4); o[i] = (f32x4){lo2f(ob[0]), hi2f(ob[0]), lo2f(ob[1]), hi2f(ob[1])}; }
      xv[i] = *(const f32x4*)(xin + (size_t)row * 1024 + i * 256 + lane * 4);
      ss += o[i][0] * o[i][0] + o[i][1] * o[i][1] + o[i][2] * o[i][2] + o[i][3] * o[i][3];
    }
    ss = wsum(ss);
    const float r = rsqrtf(ss * (1.f / 1024.f) + EPS);
    float s2 = 0.f;
#pragma unroll
    for (int i = 0; i < 4; i++) {
#pragma unroll
      for (int j = 0; j < 4; j++) { xv[i][j] += o[i][j] * r * wp[i][j]; s2 += xv[i][j] * xv[i][j]; }
      *(f32x4*)(xout + (size_t)row * 1024 + i * 256 + lane * 4) = xv[i];
    }
    if (wpre) {
      s2 = wsum(s2);
      const float r2 = rsqrtf(s2 * (1.f / 1024.f) + EPS);
#pragma unroll
      for (int i = 0; i < 4; i++)
        *(u32x2*)(h + (size_t)row * 1024 + i * 256 + lane * 4) = (u32x2){pk2(xv[i][0] * r2 * wq[i][0], xv[i][1] * r2 * wq[i][1]), pk2(xv[i][2] * r2 * wq[i][2], xv[i][3] * r2 * wq[i][3])};
    }
  }
}

DI void attn_phase(const bf16_t* __restrict__ Q, int ldq, int hfoff  , int nrows, const bf16_t* __restrict__ Kimg, const bf16_t* __restrict__ Vimg,
                   bf16_t* __restrict__ mix, int bid, int nb, char* smem) {
  const int bx_ = obid(), G_ = ogrid(); (void)bx_; (void)G_;
  Q = lp(Q);
  Kimg = lp(Kimg);
  Vimg = lp(Vimg);
  mix = lp(mix);
  smem += zoff();
  const int tid = otid(), lane = tid & 63, wid = tid >> 6, fr = lane & 15, fq = lane >> 4;
  const int items = (nrows >> 9) * 4;
  for (int it = bid; it < items; it += nb) {
    const int head = it & 3, span = it >> 2, lrow0 = span * 512;
    const int tokb = hfoff < 0 ? lrow0 : ((lrow0 >> 12) << 13) + hfoff + (lrow0 & 4095);
    const int b = tokb >> 13;
    const u32x4* ksrc = (const u32x4*)(Kimg + (size_t)(b * 4 + head) * 32768);
    const u32x4* vsrc = (const u32x4*)(Vimg + (size_t)(b * 4 + head) * 32768);
    {
      u32x4 kr[8], vr[8];
#pragma unroll
      for (int i = 0; i < 8; i++) { kr[i] = ksrc[tid + 512 * i]; vr[i] = vsrc[tid + 512 * i]; }
      __builtin_amdgcn_sched_barrier(0);
#pragma unroll
      for (int i = 0; i < 8; i++) { ((u32x4*)smem)[tid + 512 * i] = kr[i]; ((u32x4*)(smem + 65536))[tid + 512 * i] = vr[i]; }
    }
    __syncthreads();
    for (int qi = 0; qi < 4; qi++) {
      const int lr = lrow0 + qi * 128 + wid * 16;
      bf16x8 qf[4];
#pragma unroll
      for (int ks = 0; ks < 4; ks++) qf[ks] = *(const bf16x8*)(Q + (size_t)(lr + fr) * ldq + head * 128 + ks * 32 + fq * 8);
      f32x4 st[16];
#pragma unroll
      for (int mt = 0; mt < 16; mt++) {
        f32x4 a = (f32x4){0.f, 0.f, 0.f, 0.f};
#pragma unroll
        for (int ks = 0; ks < 4; ks++) a = mfma16(*(const bf16x8*)(smem + ((mt * 4 + ks) * 64 + lane) * 16), qf[ks], a);
        st[mt] = a;
        if (mt & 1) __builtin_amdgcn_sched_barrier(0);
      }
      float mx = -3.0e38f;
#pragma unroll
      for (int mt = 0; mt < 16; mt++)
#pragma unroll
        for (int i = 0; i < 4; i++) mx = fmaxf(mx, st[mt][i]);
      mx = fmaxf(mx, __shfl_xor(mx, 16)); mx = fmaxf(mx, __shfl_xor(mx, 32));
      const float sc = 0.08838834764831845f * 1.4426950408889634f;
      float sum = 0.f;
#pragma unroll
      for (int mt = 0; mt < 16; mt++)
#pragma unroll
        for (int i = 0; i < 4; i++) { const float pz = __builtin_amdgcn_exp2f((st[mt][i] - mx) * sc); st[mt][i] = pz; sum += pz; }
      sum += __shfl_xor(sum, 16); sum += __shfl_xor(sum, 32);
      bf16x8 pf[8];
#pragma unroll
      for (int kk = 0; kk < 8; kk++) pf[kk] = pack8(st[2 * kk], st[2 * kk + 1]);
      const float inv = 1.f / sum;
      bf16_t* op = mix + (size_t)(tokb + (lr - lrow0) + fr) * 1536 + 1024 + head * 128 + fq * 4;
#pragma unroll
      for (int dt = 0; dt < 8; dt++) {
        f32x4 o = (f32x4){0.f, 0.f, 0.f, 0.f};
#pragma unroll
        for (int kk = 0; kk < 8; kk++) o = mfma16(*(const bf16x8*)(smem + 65536 + ((dt * 8 + kk) * 64 + lane) * 16), pf[kk], o);
        *(u32x2*)(op + dt * 16) = (u32x2){pk2(o[0] * inv, o[1] * inv), pk2(o[2] * inv, o[3] * inv)};
        __builtin_amdgcn_sched_barrier(0);
      }
    }
    __syncthreads();
  }
}

DI void gmlp_phase(const bf16_t* __restrict__ U, const bf16_t* __restrict__ VT, const bf16_t* __restrict__ Wsb, const float* __restrict__ ln_w,
                   const float* __restrict__ ln_b, const float* __restrict__ b_s, bf16_t* __restrict__ mix, char* smem) {
  const int bx_ = obid(), G_ = ogrid(); (void)bx_; (void)G_;
  U = lp(U);
  VT = lp(VT);
  Wsb = lp(Wsb);
  ln_w = lp(ln_w);
  ln_b = lp(ln_b);
  b_s = lp(b_s);
  mix = lp(mix);
  smem += zoff();
  float* red = (float*)smem;
  float* stats = (float*)(smem + 32768);
  for (int chunk = bx_; chunk < 256; chunk += G_) {
    const int tid = otid(), lane = tid & 63, wid = tid >> 6, fr = lane & 15, fq = lane >> 4;
    {
      const int s8 = tid & 15, cgp = tid >> 4;
      float sm[8], sq[8];
#pragma unroll
      for (int j = 0; j < 8; j++) { sm[j] = 0.f; sq[j] = 0.f; }
#pragma unroll 8
      for (int cc = 0; cc < 32; cc++) {
        const u32x4 raw = *(const u32x4*)(VT + (((size_t)chunk * 1024 + cgp * 32 + cc) << 7) + s8 * 8);
        float v[8]; unpack8(raw, v);
#pragma unroll
        for (int j = 0; j < 8; j++) { sm[j] += v[j]; sq[j] += v[j] * v[j]; }
      }
#pragma unroll
      for (int j = 0; j < 8; j++) { red[(cgp * 128 + s8 * 8 + j) * 2] = sm[j]; red[(cgp * 128 + s8 * 8 + j) * 2 + 1] = sq[j]; }
    }
    __syncthreads();
    if (tid < 128) {
      float S = 0.f, Q = 0.f;
      for (int g2 = 0; g2 < 32; g2++) { S += red[(g2 * 128 + tid) * 2]; Q += red[(g2 * 128 + tid) * 2 + 1]; }
      const float mean = S * (1.f / 1024.f), var = Q * (1.f / 1024.f) - mean * mean;
      stats[tid * 2] = mean; stats[tid * 2 + 1] = rsqrtf(fmaxf(var, 0.f) + EPS);
    }
    __syncthreads();
    const int g = wid;
    float lwv[8], lbv[8];
#pragma unroll
    for (int ct = 0; ct < 8; ct++) { lwv[ct] = ln_w[g * 128 + 16 * ct + fr]; lbv[ct] = ln_b[g * 128 + 16 * ct + fr]; }
#pragma unroll
    for (int tq = 0; tq < 4; tq++) {
      f32x4 acc[8][2];
#pragma unroll
      for (int ct = 0; ct < 8; ct++)
#pragma unroll
        for (int tt = 0; tt < 2; tt++) acc[ct][tt] = (f32x4){0.f, 0.f, 0.f, 0.f};
#pragma unroll
      for (int ks = 0; ks < 4; ks++) {
        if (ks <= tq) {
          float mean8[8], rstd8[8];
#pragma unroll
          for (int j = 0; j < 8; j++) { mean8[j] = stats[(32 * ks + 8 * fq + j) * 2]; rstd8[j] = stats[(32 * ks + 8 * fq + j) * 2 + 1]; }
          bf16x8 bfr[2];
#pragma unroll
          for (int tt = 0; tt < 2; tt++) bfr[tt] = *(const bf16x8*)(Wsb + ((size_t)g * 128 + 32 * tq + 16 * tt + fr) * 128 + 32 * ks + 8 * fq);
          u32x4 rawv[8];
#pragma unroll
          for (int ct = 0; ct < 8; ct++) rawv[ct] = *(const u32x4*)(VT + (((size_t)chunk * 1024 + g * 128 + 16 * ct + fr) << 7) + 32 * ks + 8 * fq);
#pragma unroll
          for (int ct = 0; ct < 8; ct++) {
            const float lw = lwv[ct], lb = lbv[ct];
            float v[8]; unpack8(rawv[ct], v);
#pragma unroll
            for (int j = 0; j < 8; j++) v[j] = (v[j] - mean8[j]) * rstd8[j] * lw + lb;
            u32x4 pa; pa[0] = pk2(v[0], v[1]); pa[1] = pk2(v[2], v[3]); pa[2] = pk2(v[4], v[5]); pa[3] = pk2(v[6], v[7]);
            const bf16x8 af = __builtin_bit_cast(bf16x8, pa);
#pragma unroll
            for (int tt = 0; tt < 2; tt++) acc[ct][tt] = mfma16(af, bfr[tt], acc[ct][tt]);
            if (ct & 1) __builtin_amdgcn_sched_barrier(0);
          }
        }
      }
#pragma unroll
      for (int tt = 0; tt < 2; tt++) {
        const int t = 32 * tq + 16 * tt + fr;
        const size_t tok = (size_t)chunk * 128 + t;
        const float bs = b_s[g * 128 + t];
        u32x2 uuv[8];
#pragma unroll
        for (int ct = 0; ct < 8; ct++) uuv[ct] = *(const u32x2*)(U + tok * 1024 + g * 128 + 16 * ct + 4 * fq);
#pragma unroll
        for (int ct = 0; ct < 8; ct++) {
          const int col = g * 128 + 16 * ct + 4 * fq;
          const u32x2 uu = uuv[ct];
          const f32x4 a = acc[ct][tt];
          *(u32x2*)(mix + tok * 1536 + col) = (u32x2){pk2(lo2f(uu[0]) * (a[0] + bs), hi2f(uu[0]) * (a[1] + bs)), pk2(lo2f(uu[1]) * (a[2] + bs), hi2f(uu[1]) * (a[3] + bs))};
        }
      }
      __builtin_amdgcn_sched_barrier(0);
    }
    __syncthreads();
  }
}

DI void sconv_phase(const bf16_t* __restrict__ R, const float* __restrict__ cw, bf16_t* __restrict__ mix) {
  const int bx_ = obid(), G_ = ogrid(); (void)bx_; (void)G_;
  R = lp(R);
  cw = lp(cw);
  mix = lp(mix);
  for (int idx = bx_ * 512 + otid(); idx < NTOK * 128; idx += G_ * 512) {
    const int row = idx >> 7, c = (idx & 127) * 8, s = row & 8191;
    float acc[8];
#pragma unroll
    for (int j = 0; j < 8; j++) acc[j] = 0.f;
#pragma unroll
    for (int k = 0; k < 3; k++) {
      if (s - 2 + k >= 0) {
        const size_t r2 = (size_t)(row - 2 + k);
        float a[8], b[8]; unpack8(*(const u32x4*)(R + r2 * 3584 + 1024 + c), a); unpack8(*(const u32x4*)(R + r2 * 3584 + 2048 + c), b);
        const f32x4 w0 = *(const f32x4*)(cw + k * 1024 + c), w1 = *(const f32x4*)(cw + k * 1024 + c + 4);
#pragma unroll
        for (int j = 0; j < 4; j++) { acc[j] += w0[j] * a[j] * b[j]; acc[4 + j] += w1[j] * a[4 + j] * b[4 + j]; }
      }
    }
    float g[8]; unpack8(*(const u32x4*)(R + (size_t)row * 3584 + c), g);
    u32x4 o;
#pragma unroll
    for (int j = 0; j < 4; j++) o[j] = pk2(g[2 * j] * acc[2 * j], g[2 * j + 1] * acc[2 * j + 1]);
    *(u32x4*)(mix + (size_t)row * 1536 + c) = o;
  }
}

constexpr int P_SET = 1024 + 3 * 17408;
constexpr int P_AF = 0, P_SET0 = 16384, P_WB = P_SET0 + 2 * P_SET, P_QK = P_WB + 17408, P_END = P_QK + 9216;
constexpr int P_WL = P_END;
constexpr int XST_OFF = P_END + 2 * 6144;
static_assert(XST_OFF + 64 <= LDS_BYTES, "prep lds");

DI void prep_loadw(const float* __restrict__ cw, int ci, float* wl, int t0, int nth) {
  const int hh = (ci >> 6) & 7;
  for (int i = t0; i < 384; i += nth) {
    const int sec = i >> 7, kk = (i >> 5) & 3, c4 = i & 31;
    *(f32x4*)(wl + i * 4) = *(const f32x4*)(cw + (size_t)kk * 3072 + sec * 1024 + hh * 128 + c4 * 4);
  }
}
DI void prep_conv(const bf16_t* __restrict__ R, const float* __restrict__ ab, const float* wl, const float* __restrict__ a_log,
                  const float* __restrict__ dt_bias, float* __restrict__ glbuf, bf16_t* __restrict__ stash, int half, int ci, char* sb, int t0, int nth) {
  float* gc = (float*)sb; float* be = gc + 64; float* eg = gc + 128; float* ek = gc + 192;
  bf16_t* Kb = (bf16_t*)(sb + 1024); bf16_t* Qb = Kb + 64 * 136; bf16_t* Vb = Qb + 64 * 136;
  const int bl = ci >> 9, hh = (ci >> 6) & 7, n = ci & 63;
  const int tokg = bl * 8192 + half * 4096 + n * 64;
  if (t0 < 64) {
    const int lane = t0;
    const float a = ab[(size_t)(tokg + lane) * 16 + hh], bb = ab[(size_t)(tokg + lane) * 16 + 8 + hh];
    const float xs = a + dt_bias[hh];
    const float sp = xs > 20.f ? xs : log1pf(__expf(xs));
    float g = -__expf(a_log[hh]) * sp;
#pragma unroll
    for (int o = 1; o < 64; o <<= 1) { const float t = __shfl_up(g, o); if (lane >= o) g += t; }
    const float gl = __shfl(g, 63);
    gc[lane] = g; be[lane] = sigmoidf_(bb); eg[lane] = __expf(g); ek[lane] = __expf(gl - g);
    if (lane == 63) glbuf[ci] = __expf(gl);
  }
  for (int idx = t0; idx < 512; idx += nth) {
    const int t = idx >> 3, sub = idx & 7;
    u32x4 raw[3][4][2];
#pragma unroll
    for (int sec = 0; sec < 3; sec++)
#pragma unroll
      for (int kk = 0; kk < 4; kk++) {
        const int sl = n * 64 + t - 3 + kk;
        if (sl >= 0 || half == 1) {
          const bf16_t* src = sl >= 0 ? R + (size_t)(bl * 4096 + sl) * 3584 + sec * 1024 + hh * 128 + sub * 16
                                      : stash + (size_t)((bl * 8 + hh) * 3 + (sl + 3)) * 384 + sec * 128 + sub * 16;
          raw[sec][kk][0] = *(const u32x4*)src; raw[sec][kk][1] = *(const u32x4*)(src + 8);
        } else {
          raw[sec][kk][0] = (u32x4){0u, 0u, 0u, 0u}; raw[sec][kk][1] = (u32x4){0u, 0u, 0u, 0u};
        }
      }
#pragma unroll
    for (int sec = 0; sec < 3; sec++) {
      float acc[16];
#pragma unroll
      for (int j = 0; j < 16; j++) acc[j] = 0.f;
#pragma unroll
      for (int kk = 0; kk < 4; kk++) {
        float xv[16]; unpack8(raw[sec][kk][0], xv); unpack8(raw[sec][kk][1], xv + 8);
#pragma unroll
        for (int q4 = 0; q4 < 4; q4++) {
          const f32x4 w = *(const f32x4*)(wl + (sec * 4 + kk) * 128 + sub * 16 + q4 * 4);
#pragma unroll
          for (int j = 0; j < 4; j++) acc[q4 * 4 + j] += w[j] * xv[q4 * 4 + j];
        }
      }
      float ss = 0.f;
#pragma unroll
      for (int j = 0; j < 16; j++) { acc[j] = siluf_(acc[j]); ss += acc[j] * acc[j]; }
      float scale = 1.f;
      if (sec < 2) {
        ss += __shfl_xor(ss, 1); ss += __shfl_xor(ss, 2); ss += __shfl_xor(ss, 4);
        scale = rsqrtf(ss + EPS) * (sec == 0 ? 0.08838834764831845f : 1.f);
      }
      bf16_t* dst = (sec == 0 ? Qb : (sec == 1 ? Kb : Vb)) + t * 136 + sub * 16;
      u32x4 p0, p1;
#pragma unroll
      for (int j = 0; j < 4; j++) { p0[j] = pk2(acc[2 * j] * scale, acc[2 * j + 1] * scale); p1[j] = pk2(acc[8 + 2 * j] * scale, acc[9 + 2 * j] * scale); }
      *(u32x4*)dst = p0; *(u32x4*)(dst + 8) = p1;
    }
    __builtin_amdgcn_sched_barrier(0);
  }
  if (half == 0 && n == 63 && t0 < 144) {
    const int r = t0 / 48, piece = t0 % 48, sec = piece >> 4, c16 = piece & 15;
    *(u32x4*)(stash + (size_t)((bl * 8 + hh) * 3 + r) * 384 + sec * 128 + c16 * 8) =
        *(const u32x4*)(R + (size_t)(bl * 4096 + 4093 + r) * 3584 + sec * 1024 + hh * 128 + c16 * 8);
  }
}


DI void prep_phase(const bf16_t* __restrict__ R, const float* __restrict__ ab, const float* __restrict__ cw, const float* __restrict__ a_log,
                   const float* __restrict__ dt_bias, char* __restrict__ ops, float* __restrict__ glbuf, bf16_t* __restrict__ stash, int half, char* smem) {
  const int bx_ = obid(), G_ = ogrid(); (void)bx_; (void)G_;
  R = lp(R);
  ab = lp(ab);
  cw = lp(cw);
  a_log = lp(a_log);
  dt_bias = lp(dt_bias);
  ops = lp(ops);
  glbuf = lp(glbuf);
  stash = lp(stash);
  smem += zoff();
  float* Af = (float*)(smem + P_AF); bf16_t* Wb = (bf16_t*)(smem + P_WB); bf16_t* QKb = (bf16_t*)(smem + P_QK);
  float* WL = (float*)(smem + P_WL);
  if (bx_ < 2048) prep_loadw(cw, bx_, WL, otid(), 512);
  LDS_BAR();
  int k = -1;
  for (int ci = bx_ - G_; ci < 2048; ci += G_, k++) {
    const bool live = ci >= 0;
    const int tid = otid(), lane = tid & 63, wid = tid >> 6, fr = lane & 15, fq = lane >> 4;
    char* sb = smem + P_SET0 + (k & 1) * P_SET;
    const float* gc = (const float*)sb; const float* be = gc + 64; const float* eg = gc + 128; const float* ek = gc + 192;
    const bf16_t* Kb = (const bf16_t*)(sb + 1024); const bf16_t* Qb = Kb + 64 * 136; const bf16_t* Vb = Qb + 64 * 136;
    char* op = ops + (size_t)ci * OPS_STRIDE;
    if (live) {
      const int it = wid & 3, which = wid >> 2;
      const bf16_t* X = which ? Qb : Kb;
      bf16x8 af[4];
#pragma unroll
      for (int ks = 0; ks < 4; ks++) af[ks] = *(const bf16x8*)(X + (16 * it + fr) * 136 + 32 * ks + 8 * fq);
#pragma unroll
      for (int jt = 0; jt < 4; jt++) {
        f32x4 a = (f32x4){0.f, 0.f, 0.f, 0.f};
#pragma unroll
        for (int ks = 0; ks < 4; ks++) a = mfma16(af[ks], *(const bf16x8*)(Kb + (16 * jt + fr) * 136 + 32 * ks + 8 * fq), a);
        const int j = 16 * jt + fr;
        const float gj = gc[j];
#pragma unroll
        for (int ii = 0; ii < 4; ii++) {
          const int i = 16 * it + 4 * fq + ii;
          const float dec = __expf(fminf(gc[i] - gj, 0.f));
          if (which == 0) Af[i * 64 + j] = (j < i) ? be[i] * a[ii] * dec : 0.f;
          else QKb[i * 72 + j] = f2bf((j <= i) ? a[ii] * dec : 0.f);
        }
      }
    }
    LDS_BAR();
    if (tid < 256) {
      if (live) {
      const int col = tid;
      float Uv[64];
      const bool isv = col < 128;
      const bf16_t* xs = isv ? (Vb + col) : (Kb + (col - 128));
#pragma unroll
      for (int i = 0; i < 64; i++) { Uv[i] = bf2f(xs[i * 136]) * (be[i] * (isv ? 1.f : eg[i])); asm volatile("" : "+v"(Uv[i])); }
      __builtin_amdgcn_sched_barrier(0);
      f32x4 ac[16], an[16];
      ac[0] = *(const f32x4*)(Af + 1 * 64);
#pragma unroll
      for (int i = 1; i < 64; i++) {
        if (i + 1 < 64) {
#pragma unroll
          for (int j4 = 0; j4 < (i + 1 + 3) / 4; j4++) an[j4] = *(const f32x4*)(Af + (i + 1) * 64 + j4 * 4);
        }
        __builtin_amdgcn_sched_barrier(0);
        float xv = Uv[i], xw = 0.f, xy = 0.f, xz = 0.f;
#pragma unroll
        for (int j4 = 0; j4 < (i + 3) / 4; j4++) {
          const f32x4 a = ac[j4];
          if (j4 * 4 + 0 < i) xv -= a[0] * Uv[j4 * 4 + 0];
          if (j4 * 4 + 1 < i) xw -= a[1] * Uv[j4 * 4 + 1];
          if (j4 * 4 + 2 < i) xy -= a[2] * Uv[j4 * 4 + 2];
          if (j4 * 4 + 3 < i) xz -= a[3] * Uv[j4 * 4 + 3];
        }
        Uv[i] = (xv + xw) + (xy + xz);
        __builtin_amdgcn_sched_barrier(0);
        if (i + 1 < 64) {
#pragma unroll
          for (int j4 = 0; j4 < (i + 1 + 3) / 4; j4++) ac[j4] = an[j4];
        }
      }
      if (col < 128) {
        const int w8 = col >> 4, lo = col & 15;
#pragma unroll
        for (int ct = 0; ct < 4; ct++)
#pragma unroll
          for (int jq = 0; jq < 4; jq++)
            *(u32x2*)(op + 57344 + (((w8 * 4 + ct) * 64 + jq * 16 + lo) * 8)) = (u32x2){pk2(Uv[16 * ct + 4 * jq], Uv[16 * ct + 4 * jq + 1]), pk2(Uv[16 * ct + 4 * jq + 2], Uv[16 * ct + 4 * jq + 3])};
      } else {
#pragma unroll
        for (int i = 0; i < 64; i++) Wb[i * 136 + col - 128] = f2bf(Uv[i]);
      }
      }
    } else {
      const int t2 = tid - 256;
      if (live) {
#pragma unroll
      for (int i = 0; i < 4; i++) {
        const int idx = t2 + 256 * i, frag = idx >> 6, ln = idx & 63, ct = frag >> 2, m = frag & 3, r = ln & 15, jq = ln >> 4;
        const int c = 16 * ct + r, d0 = 32 * m + 4 * jq;
        const u32x2 lo = *(const u32x2*)(Qb + c * 136 + d0), hi = *(const u32x2*)(Qb + c * 136 + d0 + 16);
        const float e = eg[c];
        *(u32x4*)(op + 16384 + idx * 16) = (u32x4){pk2(lo2f(lo[0]) * e, hi2f(lo[0]) * e), pk2(lo2f(lo[1]) * e, hi2f(lo[1]) * e), pk2(lo2f(hi[0]) * e, hi2f(hi[0]) * e), pk2(lo2f(hi[1]) * e, hi2f(hi[1]) * e)};
      }
#pragma unroll
      for (int i = 0; i < 4; i++) {
        const int idx = t2 + 256 * i, frag = idx >> 6, ln = idx & 63, dt = frag >> 1, kk = frag & 1, r = ln & 15, jq = ln >> 4;
        const int d = 16 * dt + r;
        float v[8];
#pragma unroll
        for (int j = 0; j < 8; j++) { const int c = 32 * kk + 16 * (j >> 2) + 4 * jq + (j & 3); v[j] = bf2f(Kb[c * 136 + d]) * ek[c]; }
        *(u32x4*)(op + 40960 + idx * 16) = (u32x4){pk2(v[0], v[1]), pk2(v[2], v[3]), pk2(v[4], v[5]), pk2(v[6], v[7])};
      }
#pragma unroll
      for (int i = 0; i < 2; i++) {
        const int idx = t2 + 256 * i, frag = idx >> 6, ln = idx & 63, ct = frag >> 1, kk = frag & 1, r = ln & 15, jq = ln >> 4;
        const int row = 16 * ct + r, c0 = 32 * kk + 4 * jq;
        const u32x2 lo = *(const u32x2*)(QKb + row * 72 + c0), hi = *(const u32x2*)(QKb + row * 72 + c0 + 16);
        *(u32x4*)(op + 32768 + idx * 16) = (u32x4){lo[0], lo[1], hi[0], hi[1]};
      }
      }
      if (ci + G_ < 2048) prep_conv(R, ab, WL + ((k + 1) & 1) * 1536, a_log, dt_bias, glbuf, stash, half, ci + G_, smem + P_SET0 + ((k + 1) & 1) * P_SET, t2, 256);
      if (ci + 2 * G_ < 2048) prep_loadw(cw, ci + 2 * G_, WL + (k & 1) * 1536, t2, 256);
    }
    LDS_BAR();
    if (live)
#pragma unroll
    for (int i = 0; i < 2; i++) {
      const int idx = tid + 512 * i, frag = idx >> 6, ln = idx & 63, ct = frag >> 2, m = frag & 3, r = ln & 15, jq = ln >> 4;
      const int c = 16 * ct + r, d0 = 32 * m + 4 * jq;
      const u32x2 lo = *(const u32x2*)(Wb + c * 136 + d0), hi = *(const u32x2*)(Wb + c * 136 + d0 + 16);
      *(u32x4*)(op + idx * 16) = (u32x4){lo[0], lo[1], hi[0], hi[1]};
    }
  }
  LDS_BAR();
}

DI void scan_block(const char* __restrict__ ops, const float* __restrict__ glbuf, bf16_t* __restrict__ mix, float* __restrict__ ssq,
                   f32x4* __restrict__ stbuf, int half, char* smem) {
  const int bx_ = obid(), G_ = ogrid(); (void)bx_; (void)G_;
  ops = lp(ops);
  glbuf = lp(glbuf);
  mix = lp(mix);
  ssq = lp(ssq);
  stbuf = lp(stbuf);
  smem += zoff();
  const int tid = otid(), lane = tid & 63, w = tid >> 6, fr = lane & 15, fq = lane >> 4;
  const bool comp = w < 4;
  const int blk = bx_, bl = blk >> 3, hh = blk & 7;
  const int chunk0 = (bl * 8 + hh) * 64;
  const int tokbase = bl * 8192 + half * 4096;
  const char* cp = ops + (size_t)chunk0 * OPS_STRIDE;
  float* part = (float*)(smem + 114688);
  {
    u32x4 pr0[7];
#pragma unroll
    for (int i = 0; i < 7; i++) pr0[i] = ((const u32x4*)cp)[tid + 512 * i];
    __builtin_amdgcn_sched_barrier(0);
#pragma unroll
    for (int i = 0; i < 7; i++) ((u32x4*)smem)[tid + 512 * i] = pr0[i];
  }
  __syncthreads();
  if (!comp) {
    const int t2 = tid - 256;
    u32x4 sx[14], sy[14];
    {
      const u32x4* np = (const u32x4*)(cp + (size_t)1 * OPS_STRIDE);
#pragma unroll
      for (int i = 0; i < 14; i++) sy[i] = np[t2 + 256 * i];
    }
    for (int n = 0; n < 64; n += 2) {
      if (n + 2 < 64) {
        const u32x4* np = (const u32x4*)(cp + (size_t)(n + 2) * OPS_STRIDE);
#pragma unroll
        for (int i = 0; i < 14; i++) sx[i] = np[t2 + 256 * i];
      }
      {
        u32x4* nb = (u32x4*)(smem + 57344);
#pragma unroll
        for (int i = 0; i < 14; i++) nb[t2 + 256 * i] = sy[i];
      }
      asm volatile("s_waitcnt lgkmcnt(0)" ::: "memory");
      __builtin_amdgcn_s_barrier();
      asm volatile("" ::: "memory");
      if (n + 3 < 64) {
        const u32x4* np = (const u32x4*)(cp + (size_t)(n + 3) * OPS_STRIDE);
#pragma unroll
        for (int i = 0; i < 14; i++) sy[i] = np[t2 + 256 * i];
      }
      if (n + 2 < 64) {
        u32x4* nb = (u32x4*)smem;
#pragma unroll
        for (int i = 0; i < 14; i++) nb[t2 + 256 * i] = sx[i];
      }
      asm volatile("s_waitcnt lgkmcnt(0)" ::: "memory");
      __builtin_amdgcn_s_barrier();
      asm volatile("" ::: "memory");
    }
  } else {
    f32x4* stp = stbuf + ((size_t)(blk * 4 + w) * 16) * 64 + lane;
    f32x4 S[8][2]; bf16x8 sB[4][2];
#pragma unroll
    for (int i = 0; i < 8; i++)
#pragma unroll
      for (int nt = 0; nt < 2; nt++) S[i][nt] = half ? stp[(i * 2 + nt) * 64] : (f32x4){0.f, 0.f, 0.f, 0.f};
#pragma unroll
    for (int m = 0; m < 4; m++)
#pragma unroll
      for (int nt = 0; nt < 2; nt++) sB[m][nt] = pack8(S[2 * m][nt], S[2 * m + 1][nt]);
    u32x2 uf[4][2];
#pragma unroll
    for (int ct = 0; ct < 4; ct++)
#pragma unroll
      for (int nt = 0; nt < 2; nt++) uf[ct][nt] = *(const u32x2*)(cp + 57344 + (((2 * w + nt) * 4 + ct) * 64 + lane) * 8);
    float gl = glbuf[chunk0];
    for (int n = 0; n < 64; n++) {
      const char* buf = smem + (n & 1) * 57344;
      if (n > 0 && lane < 16) {
        const float* pp = part + ((n - 1) & 1) * 256 + 16 * w + lane;
        ssq[(size_t)(tokbase + (n - 1) * 64 + 16 * w + lane) * 8 + hh] = pp[0] + pp[64] + pp[128] + pp[192];
      }
      bf16x8 vB[2][2];
      {
        f32x4 vn[4][2];
#pragma unroll
        for (int ct = 0; ct < 4; ct++) {
          f32x4 t0 = (f32x4){0.f, 0.f, 0.f, 0.f}, t1 = t0;
#pragma unroll
          for (int m = 0; m < 4; m++) {
            const bf16x8 a = *(const bf16x8*)(buf + ((ct * 4 + m) * 64 + lane) * 16);
            t0 = mfma16(a, sB[m][0], t0); t1 = mfma16(a, sB[m][1], t1);
          }
          vn[ct][0] = (f32x4){lo2f(uf[ct][0][0]) - t0[0], hi2f(uf[ct][0][0]) - t0[1], lo2f(uf[ct][0][1]) - t0[2], hi2f(uf[ct][0][1]) - t0[3]};
          vn[ct][1] = (f32x4){lo2f(uf[ct][1][0]) - t1[0], hi2f(uf[ct][1][0]) - t1[1], lo2f(uf[ct][1][1]) - t1[2], hi2f(uf[ct][1][1]) - t1[3]};
        }
#pragma unroll
        for (int kk = 0; kk < 2; kk++)
#pragma unroll
          for (int nt = 0; nt < 2; nt++) vB[kk][nt] = pack8(vn[2 * kk][nt], vn[2 * kk + 1][nt]);
      }
      const float glc = gl;
      if (n + 1 < 64) {
        const char* np = cp + (size_t)(n + 1) * OPS_STRIDE;
#pragma unroll
        for (int ct = 0; ct < 4; ct++)
#pragma unroll
          for (int nt = 0; nt < 2; nt++) uf[ct][nt] = *(const u32x2*)(np + 57344 + (((2 * w + nt) * 4 + ct) * 64 + lane) * 8);
        gl = glbuf[chunk0 + n + 1];
      }
      __builtin_amdgcn_sched_barrier(0);
      float v[16];
      {
        bf16_t* mp = mix + (size_t)(tokbase + n * 64) * 1536 + hh * 128 + 32 * w + fr;
#pragma unroll
        for (int ct = 0; ct < 4; ct++) {
          f32x4 t0 = (f32x4){0.f, 0.f, 0.f, 0.f}, t1 = t0;
#pragma unroll
          for (int m = 0; m < 4; m++) {
            const bf16x8 a = *(const bf16x8*)(buf + 16384 + ((ct * 4 + m) * 64 + lane) * 16);
            t0 = mfma16(a, sB[m][0], t0); t1 = mfma16(a, sB[m][1], t1);
          }
#pragma unroll
          for (int kk = 0; kk < 2; kk++) {
            const bf16x8 a = *(const bf16x8*)(buf + 32768 + ((ct * 2 + kk) * 64 + lane) * 16);
            t0 = mfma16(a, vB[kk][0], t0); t1 = mfma16(a, vB[kk][1], t1);
          }
#pragma unroll
          for (int ii = 0; ii < 4; ii++) {
            const bf16_t b0 = f2bf(t0[ii]), b1 = f2bf(t1[ii]);
            bf16_t* rp = mp + (size_t)(16 * ct + 4 * fq + ii) * 1536;
            rp[0] = b0; rp[16] = b1;
            const float f0 = bf2f(b0), f1 = bf2f(b1);
            v[ct * 4 + ii] = f0 * f0 + f1 * f1;
          }
        }
      }
      __builtin_amdgcn_sched_barrier(0);
#pragma unroll
      for (int dt = 0; dt < 8; dt++) {
        f32x4 t0 = S[dt][0] * glc, t1 = S[dt][1] * glc;
#pragma unroll
        for (int kk = 0; kk < 2; kk++) {
          const bf16x8 a = *(const bf16x8*)(buf + 40960 + ((dt * 2 + kk) * 64 + lane) * 16);
          t0 = mfma16(a, vB[kk][0], t0); t1 = mfma16(a, vB[kk][1], t1);
        }
        S[dt][0] = t0; S[dt][1] = t1;
      }
#pragma unroll
      for (int m = 0; m < 4; m++)
#pragma unroll
        for (int nt = 0; nt < 2; nt++) sB[m][nt] = pack8(S[2 * m][nt], S[2 * m + 1][nt]);
      __builtin_amdgcn_sched_barrier(0);
#pragma unroll
      for (int st = 8; st >= 1; st >>= 1) {
        const bool hiL = (fr & st) != 0;
#pragma unroll
        for (int k = 0; k < st; k++) {
          const float keep = hiL ? v[k + st] : v[k];
          const float send = hiL ? v[k] : v[k + st];
          v[k] = keep + __shfl_xor(send, st);
        }
      }
      part[(n & 1) * 256 + w * 64 + 16 * (fr >> 2) + 4 * fq + (fr & 3)] = v[0];
      asm volatile("s_waitcnt lgkmcnt(0)" ::: "memory");
      __builtin_amdgcn_s_barrier();
      asm volatile("" ::: "memory");
    }
    if (lane < 16) {
      const float* pp = part + (63 & 1) * 256 + 16 * w + lane;
      ssq[(size_t)(tokbase + 63 * 64 + 16 * w + lane) * 8 + hh] = pp[0] + pp[64] + pp[128] + pp[192];
    }
    if (half == 0) {
#pragma unroll
      for (int i = 0; i < 8; i++)
#pragma unroll
        for (int nt = 0; nt < 2; nt++) stp[(i * 2 + nt) * 64] = S[i][nt];
    }
  }
  __syncthreads();
}

#define XB_TMO      128
#define XB_XCNT(j)  (256  + 64 * (j))
#define XB_XSUB(j)  (1280 + 64 * (j))
#define XB_XGEN(j)  (2304 + 64 * (j))
#define XB_TOP      3328
#define XB_TOPGEN   3392
#define XCD_BAR_WORDS 3456
#define XB_SPIN_CAP (1u << 18)

__device__ __forceinline__ unsigned xb_ld(unsigned* p)              { return __hip_atomic_load(p, __ATOMIC_RELAXED, __HIP_MEMORY_SCOPE_AGENT); }
__device__ __forceinline__ unsigned xb_add(unsigned* p, unsigned v) { return __hip_atomic_fetch_add(p, v, __ATOMIC_RELAXED, __HIP_MEMORY_SCOPE_AGENT); }
__device__ __forceinline__ unsigned xb_xcc_id() { return (unsigned)__builtin_amdgcn_s_getreg((3 << 11) | 20) & 0xFu; }
#define XB_SPIN(cond, bar) do { unsigned _sp = 0; while (cond) { __builtin_amdgcn_s_sleep(1); \
    if ((++_sp & 255u) == 0u) { if (xb_ld(&(bar)[XB_TMO])) break; if (_sp > XB_SPIN_CAP) { atomicAdd(&(bar)[XB_TMO], 1u); break; } } } } while (0)

struct XcdBarrier {
    unsigned* bar; unsigned x;
    volatile LAS unsigned* st;
};

__device__ __forceinline__ XcdBarrier xcd_barrier_post(unsigned* bar, volatile LAS unsigned* st) {
    XcdBarrier b; b.bar = bar; b.x = xb_xcc_id(); b.st = st;
    if (threadIdx.x == 0) (void)xb_add(&bar[XB_XCNT(b.x)], 1u);
    return b;
}
__device__ __forceinline__ void xcd_barrier_complete(unsigned* bar, unsigned x, unsigned& nloc, unsigned& nx) {
    const unsigned G = gridDim.x * gridDim.y * gridDim.z;
    unsigned sum, cnt, mine, sp = 0u;
    for (;;) {
        sum = 0u; cnt = 0u; mine = 0u;
#pragma unroll
        for (unsigned j = 0; j < 16; ++j) { const unsigned c = xb_ld(&bar[XB_XCNT(j)]); sum += c; cnt += (c > 0u) ? 1u : 0u; mine = (j == x) ? c : mine; }
        if (sum == G) break;
        __builtin_amdgcn_s_sleep(1);
        if ((++sp & 255u) == 0u) { if (xb_ld(&bar[XB_TMO])) break; if (sp > XB_SPIN_CAP) { atomicAdd(&bar[XB_TMO], 1u); break; } }
    }
    nloc = mine > 0u ? mine : 1u; nx = cnt > 0u ? cnt : 1u;
}

__device__ __forceinline__ void xcd_barrier(const XcdBarrier& b) {
    asm volatile("s_waitcnt vmcnt(0)" ::: "memory");
    __syncthreads();
    if (threadIdx.x == 0) {
        unsigned* bar = b.bar;
        __builtin_amdgcn_s_waitcnt(0);
        unsigned nloc = b.st[0], nx = b.st[1];
        if (nloc == 0u) { xcd_barrier_complete(bar, b.x, nloc, nx); b.st[0] = nloc; b.st[1] = nx; }
        const unsigned old = xb_add(&bar[XB_XSUB(b.x)], 1u);
        const unsigned gen = old / nloc;
        if (old + 1u == (gen + 1u) * nloc) {
            __builtin_amdgcn_fence(__ATOMIC_RELEASE, "agent");
            asm volatile("s_waitcnt vmcnt(0)" ::: "memory");
            const unsigned og = xb_add(&bar[XB_TOP], 1u);
            const unsigned tg = og / nx;
            if (og + 1u == (tg + 1u) * nx) xb_add(&bar[XB_TOPGEN], 1u);
            else XB_SPIN(xb_ld(&bar[XB_TOPGEN]) == tg, bar);
            __builtin_amdgcn_fence(__ATOMIC_ACQUIRE, "agent");
            xb_add(&bar[XB_XGEN(b.x)], 1u);
            asm volatile("s_waitcnt vmcnt(0)" ::: "memory");
        } else {
            XB_SPIN(xb_ld(&bar[XB_XGEN(b.x)]) == gen, bar);
            __builtin_amdgcn_fence(__ATOMIC_ACQUIRE, "agent");
            asm volatile("s_waitcnt vmcnt(0)" ::: "memory");
        }
    }
    __syncthreads();
}

constexpr int PRM_NPRE = 0, PRM_NPOST = 4096, PRM_ALNW = 8192, PRM_ALNB = 10240, PRM_ABS = 12288, PRM_BCW = 14336, PRM_CCW = 17408, PRM_CALOG = 29696, PRM_CDT = 29704, PRM_CONW = 29712;
#define WS_PTRS(ws) \
  const float* PRM = (const float*)(ws + OFF_PRM); \
  bf16_t* W2 = (bf16_t*)(ws + OFF_W2); \
  bf16_t* WO = (bf16_t*)(ws + OFF_WO); \
  bf16_t* WM = (bf16_t*)(ws + OFF_WM); \
  bf16_t* WS = (bf16_t*)(ws + OFF_WS); \
  bf16_t* HMEM = (bf16_t*)(ws + OFF_HMEM); \
  bf16_t* KIMG = (bf16_t*)(ws + OFF_KIMG); \
  bf16_t* VIMG = (bf16_t*)(ws + OFF_VIMG); \
  float* AB = (float*)(ws + OFF_AB); \
  float* SSQ = (float*)(ws + OFF_SSQ); \
  float* GL = (float*)(ws + OFF_GL); \
  f32x4* STB = (f32x4*)(ws + OFF_ST); \
  bf16_t* STASH = (bf16_t*)(ws + OFF_STASH); \
  bf16_t* H = (bf16_t*)(ws + OFF_H); \
  bf16_t* MIX = (bf16_t*)(ws + OFF_MIX); \
  char* BIG = ws + OFF_BIG;
__global__ void __launch_bounds__(512) mega_kernel(Params p) {
  __shared__ __attribute__((aligned(16))) char smem[LDS_BYTES];
  cg::grid_group grid = cg::this_grid();
  char* ws0 = p.ws;
  volatile LAS unsigned* xst = (volatile LAS unsigned*)(LAS unsigned char*)(smem + XST_OFF);
  if (threadIdx.x < 2) xst[threadIdx.x] = 0u;
  __syncthreads();
  const XcdBarrier xb = xcd_barrier_post((unsigned*)(ws0 + OFF_BAR), xst);

  {
  char* ws = lp(ws0);
  WS_PTRS(ws)
  conv_seg(p.a_w_in, 4096, 0, 2560, (bf16_t*)(ws + OFF_W1_0), 1024, smem);
  conv_seg(p.a_w_in, 4096, 2560, 1536, W2, 1024, smem);
  conv_seg(p.a_w_in + 1024 * 4096, 4096, 0, 2560, (bf16_t*)(ws + OFF_W1_3), 1024, smem);
  conv_seg(p.a_w_in + 1024 * 4096, 4096, 2560, 1536, W2 + 3 * 1536 * 1024, 1024, smem);
  conv_seg(p.b_w_in, 5120, 0, 3584, (bf16_t*)(ws + OFF_W1_1), 1024, smem);
  conv_seg(p.b_w_in, 5120, 3584, 1536, W2 + 1 * 1536 * 1024, 1024, smem);
  conv_seg(p.c_w_in, 5136, 0, 3072, ((bf16_t*)(ws + OFF_W1_2)), 1024, smem);
  conv_seg(p.c_w_in, 5136, 3088, 512, ((bf16_t*)(ws + OFF_W1_2)) + 3072 * 1024, 1024, smem);
  conv_seg(p.c_w_in, 5136, 3072, 16, ((bf16_t*)(ws + OFF_W1_2)) + 3584 * 1024, 1024, smem);
  conv_seg(p.c_w_in, 5136, 3600, 1536, W2 + 2 * 1536 * 1024, 1024, smem);
  for (int l = 0; l < 4; l++) conv_seg(p.w_out + (size_t)l * 1536 * 1024, 1024, 0, 1024, WO + (size_t)l * 1024 * 1536, 1536, smem);
  conv_seg(p.w_mem_kv, 1024, 0, 1024, WM, 1024, smem);
  for (int i = blockIdx.x * 512 + otid(); i < 240 * 1024 / 2; i += gridDim.x * 512) ((unsigned*)(((bf16_t*)(ws + OFF_W1_2)) + 3600 * 1024))[i] = 0u;
  for (int i = blockIdx.x * 512 + otid(); i < 2 * 8 * 128 * 128; i += gridDim.x * 512) {
    const int s = i & 127, t = (i >> 7) & 127;
    WS[i] = (s <= t) ? f2bf(p.a_w_s[i]) : (bf16_t)0;
  }
  {
    float* prm = (float*)(ws + OFF_PRM);
    const int gt = blockIdx.x * 512 + otid(), gs = gridDim.x * 512;
    for (int i = gt; i < 4096; i += gs) { prm[PRM_NPRE + i] = p.norm_pre[i]; prm[PRM_NPOST + i] = p.norm_post[i]; }
    for (int i = gt; i < 2048; i += gs) { prm[PRM_ALNW + i] = p.a_ln_w[i]; prm[PRM_ALNB + i] = p.a_ln_b[i]; prm[PRM_ABS + i] = p.a_b_s[i]; }
    for (int i = gt; i < 3072; i += gs) prm[PRM_BCW + i] = p.b_conv_w[i];
    for (int i = gt; i < 12288; i += gs) prm[PRM_CCW + i] = p.c_conv_w[i];
    for (int i = gt; i < 8; i += gs) { prm[PRM_CALOG + i] = p.c_a_log[i]; prm[PRM_CDT + i] = p.c_dt_bias[i]; }
    for (int i = gt; i < 128; i += gs) prm[PRM_CONW + i] = p.c_o_norm_w[i];
  }
  rmsnorm_rows(p.x, p.norm_pre, H, NTOK);
  rmsnorm_rows(p.mem, p.mem_norm_w, HMEM, 1024);
  }
  grid.sync();

  for (int ph = 0; ph < 23; ph++) {
    char* ws = lp(ws0);
    WS_PTRS(ws)
    int l, q;
    if (ph < 5) { l = 0; q = ph; } else if (ph < 10) { l = 1; q = ph - 5; } else if (ph < 18) { l = 2; q = ph - 10; } else { l = 3; q = ph - 18; }
    const int kind = l % 3;
    int op, hf = 0;
    if (kind == 2) { op = q == 0 ? 0 : q == 1 ? 1 : q == 2 ? 6 : q == 3 ? 1 : q == 4 ? 7 : q == 5 ? 8 : q == 6 ? 4 : 5; hf = q >= 3 ? 1 : 0; }
    else op = q == 0 ? 0 : (q == 1 ? 2 : q + 1);
    const int bx = blockIdx.x, G = gridDim.x;
    const bool scanblk = (op == 6 || op == 7) && bx < 32;
    if (op == 0 || (op == 6 && !scanblk)) {
      const bf16_t* W1l = (const bf16_t*)(ws + (l == 0 ? OFF_W1_0 : l == 1 ? OFF_W1_1 : l == 2 ? OFF_W1_2 : OFF_W1_3));
      if (kind == 0) {
        EpiA1 e{(bf16_t*)BIG, (bf16_t*)(BIG + BIG_VT), (bf16_t*)(BIG + BIG_QX)};
        gemm_phase(H, W1l, NTOK, 2560, 1024, e, smem);
      } else if (kind == 1) {
        EpiPlain e{(bf16_t*)BIG, 3584};
        gemm_phase(H, W1l, NTOK, 3584, 1024, e, smem);
      } else {
        const int g1h = op == 6 ? 1 : 0;
        EpiC1 e{(bf16_t*)BIG, AB, g1h * 4096};
        gemm_phase(H, W1l, 16384, 3840, 1024, e, smem, g1h * 4096, op == 6 ? G - 32 : -1, bx - 32);
      }
      if (l == 0) {
        EpiMem e{KIMG, VIMG};
        gemm_phase(HMEM, WM, 1024, 1024, 1024, e, smem);
      }
    }
    if (op == 1) prep_phase((const bf16_t*)BIG, AB, PRM + PRM_CCW, PRM + PRM_CALOG, PRM + PRM_CDT, BIG + BIG_OPS, GL, STASH, hf, smem);
    if (op == 2) {
      if (kind == 0) {
        const int j = l / 3;
        gmlp_phase((const bf16_t*)BIG, (const bf16_t*)(BIG + BIG_VT), WS + (size_t)j * 8 * 128 * 128, PRM + PRM_ALNW + j * 1024, PRM + PRM_ALNB + j * 1024,
                   PRM + PRM_ABS + j * 1024, MIX, smem);
      } else {
        sconv_phase((const bf16_t*)BIG, PRM + PRM_BCW, MIX);
      }
    }
    if (scanblk) scan_block(BIG + BIG_OPS, GL, MIX, SSQ, STB, op == 6 ? 0 : 1, smem);
    if (op == 1 || op == 2) {
      const bf16_t* Q; int ldq, tok0, nrows;
      if (kind == 0) { Q = (const bf16_t*)(BIG + BIG_QX); ldq = 512; tok0 = -1; nrows = NTOK; }
      else if (kind == 1) { Q = (const bf16_t*)BIG + 3072; ldq = 3584; tok0 = -1; nrows = NTOK; }
      else { Q = (const bf16_t*)BIG + 3072; ldq = 3584; tok0 = hf * 4096; nrows = 16384; }
      attn_phase(Q, ldq, tok0, nrows, KIMG, VIMG, MIX, bx, G, smem);
    }
    if (op == 3 || op == 8 || (op == 7 && !scanblk)) {
      const int nv = op == 7 ? 2 : 1;
      for (int v = 0; v < nv; v++) {
        const bf16_t* Bz = W2 + (size_t)l * 1536 * 1024;
        int M = NTOK, N = 1536, asplit = -1, col0 = 0;
        if (op == 7 && v == 0) { Bz += (size_t)1024 * 1024; N = 512; col0 = 1024; }
        if ((op == 7 && v == 1) || op == 8) { M = 16384; N = 1024; asplit = op == 8 ? 4096 : 0; }
        EpiGate e{MIX, SSQ, PRM + PRM_CONW, kind == 2 ? 1 : 0, col0, asplit};
        gemm_phase(H, Bz, M, N, 1024, e, smem, asplit, op == 7 ? G - 32 : -1, bx - 32);
      }
    }
    if (op == 4) {
      EpiOut e{(bf16_t*)BIG};
      gemm_phase(MIX, WO + (size_t)l * 1024 * 1536, NTOK, 1024, 1536, e, smem);
    }
    if (op == 5) {
      norm_phase((const bf16_t*)BIG, l == 0 ? p.x : p.out, p.out, PRM + PRM_NPOST + l * 1024, l < 3 ? PRM + PRM_NPRE + (l + 1) * 1024 : nullptr, H);
    }
    xcd_barrier(xb);
  }
}

extern "C" void kernel_launch(void* const* d_in, const int* in_sizes, int n_in, void* d_out, int out_size, void* d_ws, size_t ws_size,
                              hipStream_t stream) {
  static int grid_blocks = 0;
  if (!grid_blocks) {
    int dev = 0, cus = 0, per_cu = 0;
    (void)hipGetDevice(&dev);
    (void)hipDeviceGetAttribute(&cus, hipDeviceAttributeMultiprocessorCount, dev);
    (void)hipOccupancyMaxActiveBlocksPerMultiprocessor(&per_cu, mega_kernel, 512, 0);
    if (per_cu > 1) per_cu = 1;
    if (per_cu < 1) per_cu = 1;
    grid_blocks = cus * per_cu;
  }
  Params p{};
  p.x = (const float*)d_in[0]; p.mem = (const float*)d_in[1]; p.mem_norm_w = (const float*)d_in[2]; p.w_mem_kv = (const float*)d_in[3];
  p.norm_pre = (const float*)d_in[4]; p.norm_post = (const float*)d_in[5]; p.w_out = (const float*)d_in[6]; p.a_w_in = (const float*)d_in[7];
  p.a_ln_w = (const float*)d_in[8]; p.a_ln_b = (const float*)d_in[9]; p.a_w_s = (const float*)d_in[10]; p.a_b_s = (const float*)d_in[11];
  p.b_w_in = (const float*)d_in[12]; p.b_conv_w = (const float*)d_in[13]; p.c_w_in = (const float*)d_in[14]; p.c_conv_w = (const float*)d_in[15];
  p.c_a_log = (const float*)d_in[16]; p.c_dt_bias = (const float*)d_in[17]; p.c_o_norm_w = (const float*)d_in[18];
  p.out = (float*)d_out;
  p.ws = (char*)d_ws;
  (void)hipMemsetAsync((char*)d_ws + OFF_BAR, 0, XCD_BAR_WORDS * sizeof(unsigned), stream);
  void* args[] = {&p};
  hipError_t e = hipLaunchCooperativeKernel((void*)mega_kernel, dim3(grid_blocks), dim3(512), args, 0, stream);
  if (e != hipSuccess) fprintf(stderr, "cooperative launch failed: %s (grid %d)\n", hipGetErrorString(e), grid_blocks);
}
```

```cpp
#include <hip/hip_runtime.h>
#include <hip/hip_cooperative_groups.h>
#include <cstdio>
namespace cg = cooperative_groups;

#define DI __device__ __forceinline__
typedef unsigned short bf16_t;
typedef short bf16x8 __attribute__((ext_vector_type(8)));
typedef float f32x4 __attribute__((ext_vector_type(4)));
typedef unsigned u32x4 __attribute__((ext_vector_type(4)));
typedef unsigned u32x2 __attribute__((ext_vector_type(2)));

constexpr int NTOK = 32768;
constexpr float EPS = 1e-6f;
constexpr int LDS_BYTES = 161856;
constexpr int OPS_STRIDE = 73728;

constexpr size_t SZ_W1A = 2560ull * 1024 * 2, SZ_W1B = 3584ull * 1024 * 2, SZ_W1C = 3840ull * 1024 * 2;
constexpr size_t OFF_W1_0 = 0;
constexpr size_t OFF_W1_1 = OFF_W1_0 + SZ_W1A;
constexpr size_t OFF_W1_2 = OFF_W1_1 + SZ_W1B;
constexpr size_t OFF_W1_3 = OFF_W1_2 + SZ_W1C;
constexpr size_t SZ_W2 = 1536ull * 1024 * 2;
constexpr size_t OFF_W2 = OFF_W1_3 + SZ_W1A;
constexpr size_t OFF_WO = OFF_W2 + 4 * SZ_W2;
constexpr size_t OFF_WM = OFF_WO + 4 * SZ_W2;
constexpr size_t OFF_WS = OFF_WM + 2097152;
constexpr size_t OFF_HMEM = OFF_WS + 524288;
constexpr size_t OFF_KIMG = OFF_HMEM + 2097152;
constexpr size_t OFF_VIMG = OFF_KIMG + 1048576;
constexpr size_t OFF_AB = OFF_VIMG + 1048576;
constexpr size_t OFF_SSQ = OFF_AB + 2097152;
constexpr size_t OFF_GL = OFF_SSQ + 1048576;
constexpr size_t OFF_ST = OFF_GL + 65536;
constexpr size_t OFF_STASH = OFF_ST + 2097152;
constexpr size_t OFF_BAR = OFF_STASH + 131072;
constexpr size_t OFF_PRM = OFF_BAR + 65536;
constexpr size_t OFF_H = OFF_PRM + 131072;
constexpr size_t OFF_MIX = OFF_H + 67108864;
constexpr size_t OFF_BIG = OFF_MIX + 100663296;
constexpr size_t BIG_VT = 67108864, BIG_QX = 134217728, BIG_OPS = 117440512;
static_assert(OFF_BIG + 268435456ull <= 536870912ull, "workspace overflow");

struct Params {
  const float *x, *mem, *mem_norm_w, *w_mem_kv, *norm_pre, *norm_post, *w_out, *a_w_in, *a_ln_w, *a_ln_b, *a_w_s, *a_b_s,
      *b_w_in, *b_conv_w, *c_w_in, *c_conv_w, *c_a_log, *c_dt_bias, *c_o_norm_w;
  float* out;
  char* ws;
};

typedef float f32x2 __attribute__((ext_vector_type(2)));
typedef __bf16 bf16x2_t __attribute__((ext_vector_type(2)));
DI unsigned pk2(float lo, float hi) { f32x2 v = {lo, hi}; bf16x2_t b = __builtin_convertvector(v, bf16x2_t); return __builtin_bit_cast(unsigned, b); }
DI float lo2f(unsigned p) { return __uint_as_float(p << 16); }
DI float hi2f(unsigned p) { return __uint_as_float(p & 0xffff0000u); }
DI float bf2f(bf16_t v) { return __uint_as_float(((unsigned)v) << 16); }
DI bf16_t f2bf(float f) { return (bf16_t)(pk2(f, 0.f) & 0xffffu); }
DI int zoff() { int z; asm volatile("s_mov_b32 %0, 0" : "=s"(z)); return z; }
DI int obid() { int r; asm volatile("s_mov_b32 %0, %1" : "=s"(r) : "s"(blockIdx.x)); return r; }
DI int ogrid() { int r; asm volatile("s_mov_b32 %0, %1" : "=s"(r) : "s"(gridDim.x)); return r; }
template <class T> DI T* lp(T* p) { return (T*)((char*)p + zoff()); }
DI int otid() { int t; asm volatile("v_mov_b32 %0, %1" : "=v"(t) : "v"(threadIdx.x)); return t; }
DI float wsum(float v) {
#pragma unroll
  for (int o = 32; o; o >>= 1) v += __shfl_xor(v, o);
  return v;
}
DI float sigmoidf_(float x) { return __builtin_amdgcn_rcpf(1.f + __expf(-x)); }
DI float siluf_(float x) { return x * sigmoidf_(x); }
DI float geluf_(float x) { const float u = 0.7978845608028654f * (x + 0.044715f * x * x * x); return x * sigmoidf_(2.f * u); }
DI f32x4 mfma16(bf16x8 a, bf16x8 b, f32x4 c) { return __builtin_amdgcn_mfma_f32_16x16x32_bf16(a, b, c, 0, 0, 0); }
DI bf16x8 pack8(f32x4 a, f32x4 b) {
  u32x4 p; p[0] = pk2(a[0], a[1]); p[1] = pk2(a[2], a[3]); p[2] = pk2(b[0], b[1]); p[3] = pk2(b[2], b[3]);
  return __builtin_bit_cast(bf16x8, p);
}
DI void unpack8(u32x4 p, float* v) {
#pragma unroll
  for (int i = 0; i < 4; i++) { v[2 * i] = lo2f(p[i]); v[2 * i + 1] = hi2f(p[i]); }
}

#define LAS __attribute__((address_space(3)))
constexpr int G_BM = 256, G_BK = 64, G_HALF = 128, G_HTB = G_HALF * G_BK * 2, G_NXCD = 8, G_WGM = 8;
DI int lds_byte(int r, int c) { const int st = (r >> 4) * 2 + (c >> 5), rr = r & 15, cc = c & 31, ob = rr * 64 + cc * 2; return st * 1024 + (ob ^ (((ob >> 9) & 1) << 5)); }
DI void stage_rc(int b, int& R, int& C) { const int st = b / 1024, sb = b % 1024, swz = sb ^ (((sb >> 9) & 1) << 5); R = (st >> 1) * 16 + swz / 64; C = (st & 1) * 32 + (swz % 64) / 2; }
struct UnitOrder {
  int nM, nN, nwg, G, c;
  DI void init(int M, int N, int G_, int c_) { nM = M / G_BM; nN = N / G_BM; nwg = nM * nN; G = G_; c = c_; }
  DI bool next(int i, int& pm, int& pn) const {
    const long L = (long)i * G + c; if (L >= nwg) return false;
    int wgid = (int)L; { const int q = nwg / G_NXCD, r = nwg % G_NXCD, xcd = wgid % G_NXCD, off = wgid / G_NXCD; wgid = (xcd < r ? xcd * (q + 1) : r * (q + 1) + (xcd - r) * q) + off; }
    const int nig = G_WGM * nN, gid = wgid / nig, fm = gid * G_WGM, gsz = (nM - fm) < G_WGM ? (nM - fm) : G_WGM;
    pm = fm + ((wgid % nig) % gsz); pn = (wgid % nig) / gsz; return true;
  }
};
template <class Epi>
DI void gemm_phase(const bf16_t* __restrict__ A, const bf16_t* __restrict__ Bt, int M, int N, int K, const Epi& epi, char* smem, int asplit = -1, int gG = -1, int gC = 0) {
  const int bx_ = obid(), G_ = ogrid(); (void)bx_; (void)G_;
  A = lp(A);
  Bt = lp(Bt);
  smem += zoff();
  LAS unsigned char* lds = (LAS unsigned char*)smem;
  const int tid = otid(), wid = __builtin_amdgcn_readfirstlane(tid >> 6), lane = tid & 63, wr = wid >> 2, wc = wid & 3, fr = lane & 15, fq = lane >> 4;
  const int nt = K / G_BK;
  unsigned voff[2], voffB[2];
#pragma unroll
  for (int i = 0; i < 2; ++i) { int R, C; stage_rc(tid * 16 + i * 8192, R, C); const int rho = R & 31, Rb = (R & ~31) + 8 * ((rho & 15) >> 2) + 4 * (rho >> 4) + (rho & 3);
    voff[i] = (unsigned)(R * K + C) * 2u; voffB[i] = (unsigned)(Rb * K + C) * 2u; }
  const size_t kstep = (size_t)(G_BK * 2);
  const size_t hstep = (size_t)G_HALF * K * 2;
  const size_t tstep = 2 * hstep;
  const unsigned ldsw = (unsigned)wid * 1024u;
  const int aoff = lds_byte(wr * 64 + fr, fq * 8), boff = lds_byte(wc * 32 + fr, fq * 8);
#define PG8_SA(b, h) (((b) * 2 + (h)) * G_HTB)
#define PG8_SB(b, h) ((4 + (b) * 2 + (h)) * G_HTB)
#define PG8_STAGEV(bufoff, gbase, vo) do { _Pragma("unroll") for (int _i = 0; _i < 2; ++_i) \
    __builtin_amdgcn_global_load_lds((const unsigned*)((const char*)(gbase) + (vo)[_i]), (LAS unsigned*)(lds + (bufoff) + ldsw + _i * 8192), 16, 0, 0); } while (0)
#define PG8_STAGE(bufoff, gbase) PG8_STAGEV(bufoff, gbase, voff)
#define PG8_STAGEB(bufoff, gbase) PG8_STAGEV(bufoff, gbase, voffB)
#define PG8_LDA(dst, b, h) do { _Pragma("unroll") for (int m = 0; m < 4; ++m) _Pragma("unroll") for (int k = 0; k < 2; ++k) dst[m][k] = *(const LAS bf16x8*)(lds + PG8_SA(b, h) + aoff + m * 2048 + k * 1024); } while (0)
#define PG8_LDB(dst, b, h) do { _Pragma("unroll") for (int n = 0; n < 2; ++n) _Pragma("unroll") for (int k = 0; k < 2; ++k) dst[n][k] = *(const LAS bf16x8*)(lds + PG8_SB(b, h) + boff + n * 2048 + k * 1024); } while (0)
#define PG8_MMA(ai, bj, At, Bt_) do { __builtin_amdgcn_s_setprio(1); _Pragma("unroll") for (int m = 0; m < 4; ++m) _Pragma("unroll") for (int n = 0; n < 2; ++n) _Pragma("unroll") for (int k = 0; k < 2; ++k) \
    acc[ai][bj][m][n] = __builtin_amdgcn_mfma_f32_16x16x32_bf16(Bt_[n][k], At[m][k], acc[ai][bj][m][n], 0, 0, 0); __builtin_amdgcn_s_setprio(0); } while (0)
#define PG8_WAIT_V(n) asm volatile("s_waitcnt vmcnt(" #n ")" ::: "memory")
#define PG8_WAIT_L(n) asm volatile("s_waitcnt lgkmcnt(" #n ")" ::: "memory")
#define PG8_BAR __builtin_amdgcn_s_barrier()
#define PG8_SCHED __builtin_amdgcn_sched_barrier(0)
#define PG8_AROW(pm) ((size_t)(asplit < 0 ? (pm) * 256 : (((pm) >> 4) << 13) + asplit + (((pm) & 15) << 8)))
  UnitOrder S; S.init(M, N, gG < 0 ? G_ : gG, gG < 0 ? bx_ : gC);
  int cpm, cpn, npm = 0, npn = 0, ui = 0;
  if (!S.next(0, cpm, cpn)) return;
  f32x4 acc[2][2][4][2];
#pragma unroll
  for (int a = 0; a < 2; ++a)
#pragma unroll
    for (int b = 0; b < 2; ++b)
#pragma unroll
      for (int m = 0; m < 4; ++m)
#pragma unroll
        for (int n = 0; n < 2; ++n) acc[a][b][m][n] = (f32x4){0.f, 0.f, 0.f, 0.f};
  bf16x8 At[4][2], B0[2][2], B1[2][2];
  const char* cA = (const char*)A + PG8_AROW(cpm) * K * 2; const char* cB = (const char*)Bt + (size_t)cpn * tstep;
  PG8_STAGEB(PG8_SB(0, 0), cB); PG8_STAGE(PG8_SA(0, 0), cA); PG8_STAGEB(PG8_SB(0, 1), cB + hstep); PG8_STAGE(PG8_SA(0, 1), cA + hstep);
  if (wr == 1) PG8_BAR;
  PG8_WAIT_V(4); PG8_BAR;
  PG8_STAGEB(PG8_SB(1, 0), cB + kstep); PG8_STAGE(PG8_SA(1, 0), cA + kstep); PG8_STAGEB(PG8_SB(1, 1), cB + hstep + kstep);
  PG8_WAIT_V(6); PG8_BAR;
  for (;;) {
    const bool has_next = S.next(ui + 1, npm, npn);
    const char* nA = has_next ? (const char*)A + PG8_AROW(npm) * K * 2 : cA; const char* nB = has_next ? (const char*)Bt + (size_t)npn * tstep : cB;
    for (int t = 0; t < nt; t += 2) {
      const bool last = (t == nt - 2);
      const char* a1 = cA + (size_t)(t + 1) * kstep;
      const char* a2 = last ? nA : cA + (size_t)(t + 2) * kstep; const char* b2 = last ? nB : cB + (size_t)(t + 2) * kstep;
      const char* a3 = a2 + kstep; const char* b3 = b2 + kstep;
      PG8_LDB(B0, 0, 0); PG8_SCHED; PG8_LDA(At, 0, 0); PG8_STAGE(PG8_SA(1, 1), a1 + hstep);
      PG8_WAIT_L(8); PG8_BAR; PG8_WAIT_L(0); PG8_MMA(0, 0, At, B0); PG8_BAR; PG8_SCHED;
      PG8_LDB(B1, 0, 1); PG8_STAGEB(PG8_SB(0, 0), b2);
      PG8_BAR; PG8_WAIT_L(0); PG8_MMA(0, 1, At, B1); PG8_BAR;
      PG8_LDA(At, 0, 1); PG8_STAGE(PG8_SA(0, 0), a2);
      PG8_BAR; PG8_WAIT_L(0); PG8_MMA(1, 0, At, B0); PG8_BAR; PG8_SCHED;
      PG8_STAGEB(PG8_SB(0, 1), b2 + hstep);
      PG8_WAIT_V(6); PG8_BAR; PG8_MMA(1, 1, At, B1); PG8_BAR;
      PG8_LDB(B0, 1, 0); PG8_SCHED; PG8_LDA(At, 1, 0); PG8_STAGE(PG8_SA(0, 1), a2 + hstep);
      PG8_WAIT_L(8); PG8_BAR; PG8_WAIT_L(0); PG8_MMA(0, 0, At, B0); PG8_BAR; PG8_SCHED;
      PG8_LDB(B1, 1, 1); PG8_STAGEB(PG8_SB(1, 0), b3);
      PG8_BAR; PG8_WAIT_L(0); PG8_MMA(0, 1, At, B1); PG8_BAR;
      PG8_LDA(At, 1, 1); PG8_STAGE(PG8_SA(1, 0), a3);
      PG8_BAR; PG8_WAIT_L(0); PG8_MMA(1, 0, At, B0); PG8_BAR; PG8_SCHED;
      PG8_STAGEB(PG8_SB(1, 1), b3 + hstep);
      PG8_WAIT_V(6); PG8_BAR; PG8_MMA(1, 1, At, B1); PG8_BAR;
    }
    if constexpr (Epi::PRELOAD) {
#pragma unroll
      for (int ai = 0; ai < 2; ++ai) {
        u32x4 pre[4][2]; float prq[4][2];
#pragma unroll
        for (int m = 0; m < 4; ++m)
#pragma unroll
          for (int bj = 0; bj < 2; ++bj)
            pre[m][bj] = epi.pre(cpm * 256 + ai * 128 + wr * 64 + m * 16 + fr, cpn * 256 + bj * 128 + wc * 32 + fq * 8, prq[m][bj]);
        __builtin_amdgcn_sched_barrier(0);
#pragma unroll
        for (int m = 0; m < 4; ++m)
#pragma unroll
          for (int bj = 0; bj < 2; ++bj)
            epi.fin(cpm * 256 + ai * 128 + wr * 64 + m * 16 + fr, cpn * 256 + bj * 128 + wc * 32 + fq * 8, acc[ai][bj][m][0], acc[ai][bj][m][1], pre[m][bj], prq[m][bj]);
      }
    } else {
      bool done = false;
      if constexpr (Epi::VTRANS) {
        if (cpn * 256 >= 1024 && cpn * 256 < 2048) {
          char* tl = smem + 131072 + wid * 2048;
#pragma unroll
          for (int ai = 0; ai < 2; ++ai)
#pragma unroll
            for (int bj = 0; bj < 2; ++bj)
#pragma unroll
              for (int mh = 0; mh < 2; ++mh) {
#pragma unroll
                for (int mm = 0; mm < 2; ++mm)
#pragma unroll
                  for (int n = 0; n < 2; ++n)
#pragma unroll
                    for (int i = 0; i < 4; ++i)
                      *(bf16_t*)(tl + (8 * fq + 4 * n + i) * 64 + (mm * 16 + fr) * 2) = f2bf(geluf_(acc[ai][bj][2 * mh + mm][n][i]));
                const size_t vbase = ((size_t)(cpm * 2 + ai) * 1024 + (cpn * 256 + bj * 128 + wc * 32 - 1024)) << 7;
#pragma unroll
                for (int k = 0; k < 2; ++k) {
                  const int idx = lane + 64 * k, colr = idx >> 2, q = idx & 3;
                  *(u32x4*)(epi.VT + vbase + ((size_t)colr << 7) + wr * 64 + mh * 32 + 8 * q) = *(const u32x4*)(tl + colr * 64 + q * 16);
                }
              }
          done = true;
        }
      }
      if (!done) {
#pragma unroll
      for (int ai = 0; ai < 2; ++ai)
#pragma unroll
        for (int m = 0; m < 4; ++m)
#pragma unroll
          for (int bj = 0; bj < 2; ++bj)
            epi(cpm * 256 + ai * 128 + wr * 64 + m * 16 + fr, cpn * 256 + bj * 128 + wc * 32 + fq * 8, acc[ai][bj][m][0], acc[ai][bj][m][1]);
      }
    }
    if (!has_next) break;
#pragma unroll
    for (int a = 0; a < 2; ++a)
#pragma unroll
      for (int b = 0; b < 2; ++b)
#pragma unroll
        for (int m = 0; m < 4; ++m)
#pragma unroll
          for (int n = 0; n < 2; ++n) acc[a][b][m][n] = (f32x4){0.f, 0.f, 0.f, 0.f};
    cpm = npm; cpn = npn; cA = nA; cB = nB; ++ui;
  }
  PG8_WAIT_V(0);
  if (wr == 0) PG8_BAR;
  PG8_BAR;
#undef PG8_SA
#undef PG8_SB
#undef PG8_STAGE
#undef PG8_STAGEB
#undef PG8_STAGEV
#undef PG8_LDA
#undef PG8_LDB
#undef PG8_MMA
#undef PG8_WAIT_V
#undef PG8_WAIT_L
#undef PG8_BAR
#undef PG8_SCHED
#undef PG8_AROW
}

DI u32x4 pk8(f32x4 a, f32x4 b) { return (u32x4){pk2(a[0], a[1]), pk2(a[2], a[3]), pk2(b[0], b[1]), pk2(b[2], b[3])}; }
struct EpiMem {
  static constexpr bool VTRANS = false; static constexpr bool PRELOAD = false;
  bf16_t *kimg, *vimg;
  DI void operator()(int row, int col, f32x4 v0, f32x4 v1) const {
    const int b = row >> 8, m = row & 255;
    const int cb = __builtin_amdgcn_readfirstlane(col & ~127);
    if (cb < 512) {
      const int head = col >> 7, d = col & 127;
      const int mt = m >> 4, n = m & 15, ks = d >> 5, jq = (d & 31) >> 3;
      *(u32x4*)(kimg + (size_t)(b * 4 + head) * 32768 + ((mt * 4 + ks) * 64 + jq * 16 + n) * 8) = pk8(v0, v1);
    } else {
      const int c2 = col - 512, head = c2 >> 7, d0 = c2 & 127;
      const int kk = m >> 5, mm = m & 31, j = 4 * (mm >> 4) + (mm & 3), jq = (mm & 15) >> 2;
#pragma unroll
      for (int i = 0; i < 8; i++) {
        const int d = d0 + i, dt = d >> 4, r = d & 15;
        vimg[(size_t)(b * 4 + head) * 32768 + ((dt * 8 + kk) * 64 + jq * 16 + r) * 8 + j] = f2bf(i < 4 ? v0[i & 3] : v1[i & 3]);
      }
    }
  }
};
struct EpiA1 {
  static constexpr bool VTRANS = true; static constexpr bool PRELOAD = false;
  bf16_t *U, *VT, *QX;
  DI void operator()(int row, int col, f32x4 v0, f32x4 v1) const {
    const int cb = __builtin_amdgcn_readfirstlane(col & ~127);
    if (cb < 2048) {
#pragma unroll
      for (int i = 0; i < 4; i++) { v0[i] = geluf_(v0[i]); v1[i] = geluf_(v1[i]); }
      if (cb < 1024) {
        *(u32x4*)(U + (size_t)row * 1024 + col) = pk8(v0, v1);
      } else {
        const int c = col - 1024, chunk = row >> 7, s = row & 127;
#pragma unroll
        for (int i = 0; i < 8; i++) VT[(((size_t)chunk * 1024 + c + i) << 7) + s] = f2bf(i < 4 ? v0[i & 3] : v1[i & 3]);
      }
    } else {
      *(u32x4*)(QX + (size_t)row * 512 + (col - 2048)) = pk8(v0, v1);
    }
  }
};
struct EpiPlain {
  static constexpr bool VTRANS = false; static constexpr bool PRELOAD = false;
  bf16_t* R; int ld;
  DI void operator()(int row, int col, f32x4 v0, f32x4 v1) const { *(u32x4*)(R + (size_t)row * ld + col) = pk8(v0, v1); }
};
struct EpiC1 {
  static constexpr bool VTRANS = false; static constexpr bool PRELOAD = false;
  bf16_t* R; float* ab; int hfoff;
  DI void operator()(int row, int col, f32x4 v0, f32x4 v1) const {
    const int cb = __builtin_amdgcn_readfirstlane(col & ~127);
    if (cb < 3584) *(u32x4*)(R + (size_t)row * 3584 + col) = pk8(v0, v1);
    else if (cb == 3584 && col < 3600) {
      float* p = ab + (size_t)(((row >> 12) << 13) + hfoff + (row & 4095)) * 16 + (col - 3584);
      *(f32x4*)p = v0; *(f32x4*)(p + 4) = v1;
    }
  }
};
struct EpiGate {
  static constexpr bool VTRANS = false; static constexpr bool PRELOAD = true;
  bf16_t* Y; const float* __restrict__ ssq; const float* __restrict__ onw; int isC, col0, hfoff;
  DI int tokof(int row) const { return hfoff < 0 ? row : ((row >> 12) << 13) + hfoff + (row & 4095); }
  DI u32x4 pre(int row, int col, float& q) const {
    const int tok = tokof(row), yc = col + col0;
    q = 0.f;
    if (isC && __builtin_amdgcn_readfirstlane(yc & ~127) < 1024) q = ssq[(size_t)tok * 8 + (yc >> 7)];
    return *(const u32x4*)(Y + (size_t)tok * 1536 + yc);
  }
  DI void fin(int row, int col, f32x4 v0, f32x4 v1, u32x4 pr, float q) const {
    const int tok = tokof(row), yc = col + col0;
    float a[8]; unpack8(pr, a);
    if (isC && __builtin_amdgcn_readfirstlane(yc & ~127) < 1024) {
      const float r = rsqrtf(q * (1.f / 128.f) + EPS);
      const f32x4 w0 = *(const f32x4*)(onw + (yc & 127)), w1 = *(const f32x4*)(onw + (yc & 127) + 4);
#pragma unroll
      for (int i = 0; i < 4; i++) { a[i] *= r * w0[i]; a[4 + i] *= r * w1[i]; }
    }
    f32x4 o0, o1;
#pragma unroll
    for (int i = 0; i < 4; i++) { o0[i] = a[i] * siluf_(v0[i]); o1[i] = a[4 + i] * siluf_(v1[i]); }
    *(u32x4*)(Y + (size_t)tok * 1536 + yc) = pk8(o0, o1);
  }
};
struct EpiOut {
  static constexpr bool VTRANS = false; static constexpr bool PRELOAD = false;
  bf16_t* O;
  DI void operator()(int row, int col, f32x4 v0, f32x4 v1) const { *(u32x4*)(O + (size_t)row * 1024 + col) = pk8(v0, v1); }
};

#define LDS_BAR() do { asm volatile("s_waitcnt lgkmcnt(0)" ::: "memory"); __builtin_amdgcn_s_barrier(); asm volatile("" ::: "memory"); } while (0)
DI void conv_seg(const float* __restrict__ src, int ld, int col0, int ncols, bf16_t* __restrict__ dst, int K, char* smem) {
  const int bx_ = obid(), G_ = ogrid();
  smem += zoff();
  float* tile = (float*)smem;
  const int tid = otid();
  const int ntj = (ncols + 63) >> 6, ntk = K >> 6, nt = ntj * ntk;
  const int jj = tid & 63, k0 = tid >> 6;
  float r[8];
  int t = bx_;
  if (t < nt) {
    const int tj = t % ntj, tk = t / ntj;
    const bool ok = (tj * 64 + jj) < ncols;
#pragma unroll
    for (int i = 0; i < 8; i++) r[i] = ok ? src[(size_t)(tk * 64 + k0 + 8 * i) * ld + col0 + tj * 64 + jj] : 0.f;
  }
  for (; t < nt; t += G_) {
    const int tj = t % ntj, tk = t / ntj;
#pragma unroll
    for (int i = 0; i < 8; i++) tile[(k0 + 8 * i) * 65 + jj] = r[i];
    LDS_BAR();
    if (t + G_ < nt) {
      const int t2 = t + G_, tj2 = t2 % ntj, tk2 = t2 / ntj;
      const bool ok = (tj2 * 64 + jj) < ncols;
#pragma unroll
      for (int i = 0; i < 8; i++) r[i] = ok ? src[(size_t)(tk2 * 64 + k0 + 8 * i) * ld + col0 + tj2 * 64 + jj] : 0.f;
    }
    {
      const int kk2 = (tid & 31) * 2, j2 = tid >> 5;
#pragma unroll
      for (int i = 0; i < 4; i++) {
        const int j = j2 + 16 * i;
        if (tj * 64 + j < ncols) *(unsigned*)(dst + (size_t)(tj * 64 + j) * K + tk * 64 + kk2) = pk2(tile[kk2 * 65 + j], tile[(kk2 + 1) * 65 + j]);
      }
    }
    LDS_BAR();
  }
}

DI void rmsnorm_rows(const float* __restrict__ x, const float* __restrict__ w, bf16_t* __restrict__ h, int nrows) {
  const int bx_ = obid(), G_ = ogrid(); (void)bx_; (void)G_;
  x = lp(x);
  w = lp(w);
  h = lp(h);
  const int lane = otid() & 63, wid = otid() >> 6;
  f32x4 wv[4];
#pragma unroll
  for (int i = 0; i < 4; i++) wv[i] = *(const f32x4*)(w + i * 256 + lane * 4);
  for (int row = bx_ * 8 + wid; row < nrows; row += G_ * 8) {
    f32x4 v[4]; float ss = 0.f;
#pragma unroll
    for (int i = 0; i < 4; i++) { v[i] = *(const f32x4*)(x + (size_t)row * 1024 + i * 256 + lane * 4); ss += v[i][0] * v[i][0] + v[i][1] * v[i][1] + v[i][2] * v[i][2] + v[i][3] * v[i][3]; }
    ss = wsum(ss);
    const float r = rsqrtf(ss * (1.f / 1024.f) + EPS);
#pragma unroll
    for (int i = 0; i < 4; i++)
      *(u32x2*)(h + (size_t)row * 1024 + i * 256 + lane * 4) = (u32x2){pk2(v[i][0] * r * wv[i][0], v[i][1] * r * wv[i][1]), pk2(v[i][2] * r * wv[i][2], v[i][3] * r * wv[i][3])};
  }
}

DI void norm_phase(const bf16_t* __restrict__ O, const float* xin, float* xout, const float* __restrict__ wpost, const float* __restrict__ wpre, bf16_t* __restrict__ h) {
  const int bx_ = obid(), G_ = ogrid(); (void)bx_; (void)G_;
  O = lp(O);
  xin = lp(xin);
  xout = lp(xout);
  wpost = lp(wpost);
  wpre = lp(wpre);
  h = lp(h);
  const int lane = otid() & 63, wid = otid() >> 6;
  f32x4 wp[4], wq[4];
#pragma unroll
  for (int i = 0; i < 4; i++) { wp[i] = *(const f32x4*)(wpost + i * 256 + lane * 4); wq[i] = wpre ? *(const f32x4*)(wpre + i * 256 + lane * 4) : (f32x4){0.f, 0.f, 0.f, 0.f}; }
  for (int row = bx_ * 8 + wid; row < NTOK; row += G_ * 8) {
    f32x4 o[4], xv[4]; float ss = 0.f;
#pragma unroll
    for (int i = 0; i < 4; i++) {
      { const u32x2 ob = *(const u32x2*)(O + (size_t)row * 1024 + i * 256 + lane * 4); o[i] = (f32x4){lo2f(ob[0]), hi2f(ob[0]), lo2f(ob[1]), hi2f(ob[1])}; }
      xv[i] = *(const f32x4*)(xin + (size_t)row * 1024 + i * 256 + lane * 4);
      ss += o[i][0] * o[i][0] + o[i][1] * o[i][1] + o[i][2] * o[i][2] + o[i][3] * o[i][3];
    }
    ss = wsum(ss);
    const float r = rsqrtf(ss * (1.f / 1024.f) + EPS);
    float s2 = 0.f;
#pragma unroll
    for (int i = 0; i < 4; i++) {
#pragma unroll
      for (int j = 0; j < 4; j++) { xv[i][j] += o[i][j] * r * wp[i][j]; s2 += xv[i][j] * xv[i][j]; }
      *(f32x4*)(xout + (size_t)row * 1024 + i * 256 + lane * 4) = xv[i];
    }
    if (wpre) {
      s2 = wsum(s2);
      const float r2 = rsqrtf(s2 * (1.f / 1024.f) + EPS);
#pragma unroll
      for (int i = 0; i < 4; i++)
        *(u32x2*)(h + (size_t)row * 1024 + i * 256 + lane * 4) = (u32x2){pk2(xv[i][0] * r2 * wq[i][0], xv[i][1] * r2 * wq[i][1]), pk2(xv[i][2] * r2 * wq[i][2], xv[i][3] * r2 * wq[i][3])};
    }
  }
}

DI void attn_phase(const bf16_t* __restrict__ Q, int ldq, int hfoff  , int nrows, const bf16_t* __restrict__ Kimg, const bf16_t* __restrict__ Vimg,
                   bf16_t* __restrict__ mix, int bid, int nb, char* smem) {
  const int bx_ = obid(), G_ = ogrid(); (void)bx_; (void)G_;
  Q = lp(Q);
  Kimg = lp(Kimg);
  Vimg = lp(Vimg);
  mix = lp(mix);
  smem += zoff();
  const int tid = otid(), lane = tid & 63, wid = tid >> 6, fr = lane & 15, fq = lane >> 4;
  const int items = (nrows >> 9) * 4;
  for (int it = bid; it < items; it += nb) {
    const int head = it & 3, span = it >> 2, lrow0 = span * 512;
    const int tokb = hfoff < 0 ? lrow0 : ((lrow0 >> 12) << 13) + hfoff + (lrow0 & 4095);
    const int b = tokb >> 13;
    const u32x4* ksrc = (const u32x4*)(Kimg + (size_t)(b * 4 + head) * 32768);
    const u32x4* vsrc = (const u32x4*)(Vimg + (size_t)(b * 4 + head) * 32768);
    {
      u32x4 kr[8], vr[8];
#pragma unroll
      for (int i = 0; i < 8; i++) { kr[i] = ksrc[tid + 512 * i]; vr[i] = vsrc[tid + 512 * i]; }
      __builtin_amdgcn_sched_barrier(0);
#pragma unroll
      for (int i = 0; i < 8; i++) { ((u32x4*)smem)[tid + 512 * i] = kr[i]; ((u32x4*)(smem + 65536))[tid + 512 * i] = vr[i]; }
    }
    __syncthreads();
    for (int qi = 0; qi < 4; qi++) {
      const int lr = lrow0 + qi * 128 + wid * 16;
      bf16x8 qf[4];
#pragma unroll
      for (int ks = 0; ks < 4; ks++) qf[ks] = *(const bf16x8*)(Q + (size_t)(lr + fr) * ldq + head * 128 + ks * 32 + fq * 8);
      f32x4 st[16];
#pragma unroll
      for (int mt = 0; mt < 16; mt++) {
        f32x4 a = (f32x4){0.f, 0.f, 0.f, 0.f};
#pragma unroll
        for (int ks = 0; ks < 4; ks++) a = mfma16(*(const bf16x8*)(smem + ((mt * 4 + ks) * 64 + lane) * 16), qf[ks], a);
        st[mt] = a;
        if (mt & 1) __builtin_amdgcn_sched_barrier(0);
      }
      float mx = -3.0e38f;
#pragma unroll
      for (int mt = 0; mt < 16; mt++)
#pragma unroll
        for (int i = 0; i < 4; i++) mx = fmaxf(mx, st[mt][i]);
      mx = fmaxf(mx, __shfl_xor(mx, 16)); mx = fmaxf(mx, __shfl_xor(mx, 32));
      const float sc = 0.08838834764831845f * 1.4426950408889634f;
      float sum = 0.f;
#pragma unroll
      for (int mt = 0; mt < 16; mt++)
#pragma unroll
        for (int i = 0; i < 4; i++) { const float pz = __builtin_amdgcn_exp2f((st[mt][i] - mx) * sc); st[mt][i] = pz; sum += pz; }
      sum += __shfl_xor(sum, 16); sum += __shfl_xor(sum, 32);
      bf16x8 pf[8];
#pragma unroll
      for (int kk = 0; kk < 8; kk++) pf[kk] = pack8(st[2 * kk], st[2 * kk + 1]);
      const float inv = 1.f / sum;
      bf16_t* op = mix + (size_t)(tokb + (lr - lrow0) + fr) * 1536 + 1024 + head * 128 + fq * 4;
#pragma unroll
      for (int dt = 0; dt < 8; dt++) {
        f32x4 o = (f32x4){0.f, 0.f, 0.f, 0.f};
#pragma unroll
        for (int kk = 0; kk < 8; kk++) o = mfma16(*(const bf16x8*)(smem + 65536 + ((dt * 8 + kk) * 64 + lane) * 16), pf[kk], o);
        *(u32x2*)(op + dt * 16) = (u32x2){pk2(o[0] * inv, o[1] * inv), pk2(o[2] * inv, o[3] * inv)};
        __builtin_amdgcn_sched_barrier(0);
      }
    }
    __syncthreads();
  }
}

DI void gmlp_phase(const bf16_t* __restrict__ U, const bf16_t* __restrict__ VT, const bf16_t* __restrict__ Wsb, const float* __restrict__ ln_w,
                   const float* __restrict__ ln_b, const float* __restrict__ b_s, bf16_t* __restrict__ mix, char* smem) {
  const int bx_ = obid(), G_ = ogrid(); (void)bx_; (void)G_;
  U = lp(U);
  VT = lp(VT);
  Wsb = lp(Wsb);
  ln_w = lp(ln_w);
  ln_b = lp(ln_b);
  b_s = lp(b_s);
  mix = lp(mix);
  smem += zoff();
  float* red = (float*)smem;
  float* stats = (float*)(smem + 32768);
  for (int chunk = bx_; chunk < 256; chunk += G_) {
    const int tid = otid(), lane = tid & 63, wid = tid >> 6, fr = lane & 15, fq = lane >> 4;
    {
      const int s8 = tid & 15, cgp = tid >> 4;
      float sm[8], sq[8];
#pragma unroll
      for (int j = 0; j < 8; j++) { sm[j] = 0.f; sq[j] = 0.f; }
#pragma unroll 8
      for (int cc = 0; cc < 32; cc++) {
        const u32x4 raw = *(const u32x4*)(VT + (((size_t)chunk * 1024 + cgp * 32 + cc) << 7) + s8 * 8);
        float v[8]; unpack8(raw, v);
#pragma unroll
        for (int j = 0; j < 8; j++) { sm[j] += v[j]; sq[j] += v[j] * v[j]; }
      }
#pragma unroll
      for (int j = 0; j < 8; j++) { red[(cgp * 128 + s8 * 8 + j) * 2] = sm[j]; red[(cgp * 128 + s8 * 8 + j) * 2 + 1] = sq[j]; }
    }
    __syncthreads();
    if (tid < 128) {
      float S = 0.f, Q = 0.f;
      for (int g2 = 0; g2 < 32; g2++) { S += red[(g2 * 128 + tid) * 2]; Q += red[(g2 * 128 + tid) * 2 + 1]; }
      const float mean = S * (1.f / 1024.f), var = Q * (1.f / 1024.f) - mean * mean;
      stats[tid * 2] = mean; stats[tid * 2 + 1] = rsqrtf(fmaxf(var, 0.f) + EPS);
    }
    __syncthreads();
    const int g = wid;
    float lwv[8], lbv[8];
#pragma unroll
    for (int ct = 0; ct < 8; ct++) { lwv[ct] = ln_w[g * 128 + 16 * ct + fr]; lbv[ct] = ln_b[g * 128 + 16 * ct + fr]; }
#pragma unroll
    for (int tq = 0; tq < 4; tq++) {
      f32x4 acc[8][2];
#pragma unroll
      for (int ct = 0; ct < 8; ct++)
#pragma unroll
        for (int tt = 0; tt < 2; tt++) acc[ct][tt] = (f32x4){0.f, 0.f, 0.f, 0.f};
#pragma unroll
      for (int ks = 0; ks < 4; ks++) {
        if (ks <= tq) {
          float mean8[8], rstd8[8];
#pragma unroll
          for (int j = 0; j < 8; j++) { mean8[j] = stats[(32 * ks + 8 * fq + j) * 2]; rstd8[j] = stats[(32 * ks + 8 * fq + j) * 2 + 1]; }
          bf16x8 bfr[2];
#pragma unroll
          for (int tt = 0; tt < 2; tt++) bfr[tt] = *(const bf16x8*)(Wsb + ((size_t)g * 128 + 32 * tq + 16 * tt + fr) * 128 + 32 * ks + 8 * fq);
          u32x4 rawv[8];
#pragma unroll
          for (int ct = 0; ct < 8; ct++) rawv[ct] = *(const u32x4*)(VT + (((size_t)chunk * 1024 + g * 128 + 16 * ct + fr) << 7) + 32 * ks + 8 * fq);
#pragma unroll
          for (int ct = 0; ct < 8; ct++) {
            const float lw = lwv[ct], lb = lbv[ct];
            float v[8]; unpack8(rawv[ct], v);
#pragma unroll
            for (int j = 0; j < 8; j++) v[j] = (v[j] - mean8[j]) * rstd8[j] * lw + lb;
            u32x4 pa; pa[0] = pk2(v[0], v[1]); pa[1] = pk2(v[2], v[3]); pa[2] = pk2(v[4], v[5]); pa[3] = pk2(v[6], v[7]);
            const bf16x8 af = __builtin_bit_cast(bf16x8, pa);
#pragma unroll
            for (int tt = 0; tt < 2; tt++) acc[ct][tt] = mfma16(af, bfr[tt], acc[ct][tt]);
            if (ct & 1) __builtin_amdgcn_sched_barrier(0);
          }
        }
      }
#pragma unroll
      for (int tt = 0; tt < 2; tt++) {
        const int t = 32 * tq + 16 * tt + fr;
        const size_t tok = (size_t)chunk * 128 + t;
        const float bs = b_s[g * 128 + t];
        u32x2 uuv[8];
#pragma unroll
        for (int ct = 0; ct < 8; ct++) uuv[ct] = *(const u32x2*)(U + tok * 1024 + g * 128 + 16 * ct + 4 * fq);
#pragma unroll
        for (int ct = 0; ct < 8; ct++) {
          const int col = g * 128 + 16 * ct + 4 * fq;
          const u32x2 uu = uuv[ct];
          const f32x4 a = acc[ct][tt];
          *(u32x2*)(mix + tok * 1536 + col) = (u32x2){pk2(lo2f(uu[0]) * (a[0] + bs), hi2f(uu[0]) * (a[1] + bs)), pk2(lo2f(uu[1]) * (a[2] + bs), hi2f(uu[1]) * (a[3] + bs))};
        }
      }
      __builtin_amdgcn_sched_barrier(0);
    }
    __syncthreads();
  }
}

DI void sconv_phase(const bf16_t* __restrict__ R, const float* __restrict__ cw, bf16_t* __restrict__ mix) {
  const int bx_ = obid(), G_ = ogrid(); (void)bx_; (void)G_;
  R = lp(R);
  cw = lp(cw);
  mix = lp(mix);
  for (int idx = bx_ * 512 + otid(); idx < NTOK * 128; idx += G_ * 512) {
    const int row = idx >> 7, c = (idx & 127) * 8, s = row & 8191;
    float acc[8];
#pragma unroll
    for (int j = 0; j < 8; j++) acc[j] = 0.f;
#pragma unroll
    for (int k = 0; k < 3; k++) {
      if (s - 2 + k >= 0) {
        const size_t r2 = (size_t)(row - 2 + k);
        float a[8], b[8]; unpack8(*(const u32x4*)(R + r2 * 3584 + 1024 + c), a); unpack8(*(const u32x4*)(R + r2 * 3584 + 2048 + c), b);
        const f32x4 w0 = *(const f32x4*)(cw + k * 1024 + c), w1 = *(const f32x4*)(cw + k * 1024 + c + 4);
#pragma unroll
        for (int j = 0; j < 4; j++) { acc[j] += w0[j] * a[j] * b[j]; acc[4 + j] += w1[j] * a[4 + j] * b[4 + j]; }
      }
    }
    float g[8]; unpack8(*(const u32x4*)(R + (size_t)row * 3584 + c), g);
    u32x4 o;
#pragma unroll
    for (int j = 0; j < 4; j++) o[j] = pk2(g[2 * j] * acc[2 * j], g[2 * j + 1] * acc[2 * j + 1]);
    *(u32x4*)(mix + (size_t)row * 1536 + c) = o;
  }
}

constexpr int P_SET = 1024 + 3 * 17408;
constexpr int P_AF = 0, P_SET0 = 16384, P_WB = P_SET0 + 2 * P_SET, P_QK = P_WB + 17408, P_END = P_QK + 9216;
constexpr int P_WL = P_END;
constexpr int XST_OFF = P_END + 2 * 6144;
static_assert(XST_OFF + 64 <= LDS_BYTES, "prep lds");

DI void prep_loadw(const float* __restrict__ cw, int ci, float* wl, int t0, int nth) {
  const int hh = (ci >> 6) & 7;
  for (int i = t0; i < 384; i += nth) {
    const int sec = i >> 7, kk = (i >> 5) & 3, c4 = i & 31;
    *(f32x4*)(wl + i * 4) = *(const f32x4*)(cw + (size_t)kk * 3072 + sec * 1024 + hh * 128 + c4 * 4);
  }
}
DI void prep_conv(const bf16_t* __restrict__ R, const float* __restrict__ ab, const float* wl, const float* __restrict__ a_log,
                  const float* __restrict__ dt_bias, float* __restrict__ glbuf, bf16_t* __restrict__ stash, int half, int ci, char* sb, int t0, int nth) {
  float* gc = (float*)sb; float* be = gc + 64; float* eg = gc + 128; float* ek = gc + 192;
  bf16_t* Kb = (bf16_t*)(sb + 1024); bf16_t* Qb = Kb + 64 * 136; bf16_t* Vb = Qb + 64 * 136;
  const int bl = ci >> 9, hh = (ci >> 6) & 7, n = ci & 63;
  const int tokg = bl * 8192 + half * 4096 + n * 64;
  if (t0 < 64) {
    const int lane = t0;
    const float a = ab[(size_t)(tokg + lane) * 16 + hh], bb = ab[(size_t)(tokg + lane) * 16 + 8 + hh];
    const float xs = a + dt_bias[hh];
    const float sp = xs > 20.f ? xs : log1pf(__expf(xs));
    float g = -__expf(a_log[hh]) * sp;
#pragma unroll
    for (int o = 1; o < 64; o <<= 1) { const float t = __shfl_up(g, o); if (lane >= o) g += t; }
    const float gl = __shfl(g, 63);
    gc[lane] = g; be[lane] = sigmoidf_(bb); eg[lane] = __expf(g); ek[lane] = __expf(gl - g);
    if (lane == 63) glbuf[ci] = __expf(gl);
  }
  for (int idx = t0; idx < 512; idx += nth) {
    const int t = idx >> 3, sub = idx & 7;
    u32x4 raw[3][4][2];
#pragma unroll
    for (int sec = 0; sec < 3; sec++)
#pragma unroll
      for (int kk = 0; kk < 4; kk++) {
        const int sl = n * 64 + t - 3 + kk;
        if (sl >= 0 || half == 1) {
          const bf16_t* src = sl >= 0 ? R + (size_t)(bl * 4096 + sl) * 3584 + sec * 1024 + hh * 128 + sub * 16
                                      : stash + (size_t)((bl * 8 + hh) * 3 + (sl + 3)) * 384 + sec * 128 + sub * 16;
          raw[sec][kk][0] = *(const u32x4*)src; raw[sec][kk][1] = *(const u32x4*)(src + 8);
        } else {
          raw[sec][kk][0] = (u32x4){0u, 0u, 0u, 0u}; raw[sec][kk][1] = (u32x4){0u, 0u, 0u, 0u};
        }
      }
#pragma unroll
    for (int sec = 0; sec < 3; sec++) {
      float acc[16];
#pragma unroll
      for (int j = 0; j < 16; j++) acc[j] = 0.f;
#pragma unroll
      for (int kk = 0; kk < 4; kk++) {
        float xv[16]; unpack8(raw[sec][kk][0], xv); unpack8(raw[sec][kk][1], xv + 8);
#pragma unroll
        for (int q4 = 0; q4 < 4; q4++) {
          const f32x4 w = *(const f32x4*)(wl + (sec * 4 + kk) * 128 + sub * 16 + q4 * 4);
#pragma unroll
          for (int j = 0; j < 4; j++) acc[q4 * 4 + j] += w[j] * xv[q4 * 4 + j];
        }
      }
      float ss = 0.f;
#pragma unroll
      for (int j = 0; j < 16; j++) { acc[j] = siluf_(acc[j]); ss += acc[j] * acc[j]; }
      float scale = 1.f;
      if (sec < 2) {
        ss += __shfl_xor(ss, 1); ss += __shfl_xor(ss, 2); ss += __shfl_xor(ss, 4);
        scale = rsqrtf(ss + EPS) * (sec == 0 ? 0.08838834764831845f : 1.f);
      }
      bf16_t* dst = (sec == 0 ? Qb : (sec == 1 ? Kb : Vb)) + t * 136 + sub * 16;
      u32x4 p0, p1;
#pragma unroll
      for (int j = 0; j < 4; j++) { p0[j] = pk2(acc[2 * j] * scale, acc[2 * j + 1] * scale); p1[j] = pk2(acc[8 + 2 * j] * scale, acc[9 + 2 * j] * scale); }
      *(u32x4*)dst = p0; *(u32x4*)(dst + 8) = p1;
    }
    __builtin_amdgcn_sched_barrier(0);
  }
  if (half == 0 && n == 63 && t0 < 144) {
    const int r = t0 / 48, piece = t0 % 48, sec = piece >> 4, c16 = piece & 15;
    *(u32x4*)(stash + (size_t)((bl * 8 + hh) * 3 + r) * 384 + sec * 128 + c16 * 8) =
        *(const u32x4*)(R + (size_t)(bl * 4096 + 4093 + r) * 3584 + sec * 1024 + hh * 128 + c16 * 8);
  }
}


DI void prep_phase(const bf16_t* __restrict__ R, const float* __restrict__ ab, const float* __restrict__ cw, const float* __restrict__ a_log,
                   const float* __restrict__ dt_bias, char* __restrict__ ops, float* __restrict__ glbuf, bf16_t* __restrict__ stash, int half, char* smem) {
  const int bx_ = obid(), G_ = ogrid(); (void)bx_; (void)G_;
  R = lp(R);
  ab = lp(ab);
  cw = lp(cw);
  a_log = lp(a_log);
  dt_bias = lp(dt_bias);
  ops = lp(ops);
  glbuf = lp(glbuf);
  stash = lp(stash);
  smem += zoff();
  float* Af = (float*)(smem + P_AF); bf16_t* Wb = (bf16_t*)(smem + P_WB); bf16_t* QKb = (bf16_t*)(smem + P_QK);
  float* WL = (float*)(smem + P_WL);
  if (bx_ < 2048) prep_loadw(cw, bx_, WL, otid(), 512);
  LDS_BAR();
  int k = -1;
  for (int ci = bx_ - G_; ci < 2048; ci += G_, k++) {
    const bool live = ci >= 0;
    const int tid = otid(), lane = tid & 63, wid = tid >> 6, fr = lane & 15, fq = lane >> 4;
    char* sb = smem + P_SET0 + (k & 1) * P_SET;
    const float* gc = (const float*)sb; const float* be = gc + 64; const float* eg = gc + 128; const float* ek = gc + 192;
    const bf16_t* Kb = (const bf16_t*)(sb + 1024); const bf16_t* Qb = Kb + 64 * 136; const bf16_t* Vb = Qb + 64 * 136;
    char* op = ops + (size_t)ci * OPS_STRIDE;
    if (live) {
      const int it = wid & 3, which = wid >> 2;
      const bf16_t* X = which ? Qb : Kb;
      bf16x8 af[4];
#pragma unroll
      for (int ks = 0; ks < 4; ks++) af[ks] = *(const bf16x8*)(X + (16 * it + fr) * 136 + 32 * ks + 8 * fq);
#pragma unroll
      for (int jt = 0; jt < 4; jt++) {
        f32x4 a = (f32x4){0.f, 0.f, 0.f, 0.f};
#pragma unroll
        for (int ks = 0; ks < 4; ks++) a = mfma16(af[ks], *(const bf16x8*)(Kb + (16 * jt + fr) * 136 + 32 * ks + 8 * fq), a);
        const int j = 16 * jt + fr;
        const float gj = gc[j];
#pragma unroll
        for (int ii = 0; ii < 4; ii++) {
          const int i = 16 * it + 4 * fq + ii;
          const float dec = __expf(fminf(gc[i] - gj, 0.f));
          if (which == 0) Af[i * 64 + j] = (j < i) ? be[i] * a[ii] * dec : 0.f;
          else QKb[i * 72 + j] = f2bf((j <= i) ? a[ii] * dec : 0.f);
        }
      }
    }
    LDS_BAR();
    if (tid < 256) {
      if (live) {
      const int col = tid;
      float Uv[64];
      const bool isv = col < 128;
      const bf16_t* xs = isv ? (Vb + col) : (Kb + (col - 128));
#pragma unroll
      for (int i = 0; i < 64; i++) { Uv[i] = bf2f(xs[i * 136]) * (be[i] * (isv ? 1.f : eg[i])); asm volatile("" : "+v"(Uv[i])); }
      __builtin_amdgcn_sched_barrier(0);
      f32x4 ac[16], an[16];
      ac[0] = *(const f32x4*)(Af + 1 * 64);
#pragma unroll
      for (int i = 1; i < 64; i++) {
        if (i + 1 < 64) {
#pragma unroll
          for (int j4 = 0; j4 < (i + 1 + 3) / 4; j4++) an[j4] = *(const f32x4*)(Af + (i + 1) * 64 + j4 * 4);
        }
        __builtin_amdgcn_sched_barrier(0);
        float xv = Uv[i], xw = 0.f, xy = 0.f, xz = 0.f;
#pragma unroll
        for (int j4 = 0; j4 < (i + 3) / 4; j4++) {
          const f32x4 a = ac[j4];
          if (j4 * 4 + 0 < i) xv -= a[0] * Uv[j4 * 4 + 0];
          if (j4 * 4 + 1 < i) xw -= a[1] * Uv[j4 * 4 + 1];
          if (j4 * 4 + 2 < i) xy -= a[2] * Uv[j4 * 4 + 2];
          if (j4 * 4 + 3 < i) xz -= a[3] * Uv[j4 * 4 + 3];
        }
        Uv[i] = (xv + xw) + (xy + xz);
        __builtin_amdgcn_sched_barrier(0);
        if (i + 1 < 64) {
#pragma unroll
          for (int j4 = 0; j4 < (i + 1 + 3) / 4; j4++) ac[j4] = an[j4];
        }
      }
      if (col < 128) {
        const int w8 = col >> 4, lo = col & 15;
#pragma unroll
        for (int ct = 0; ct < 4; ct++)
#pragma unroll
          for (int jq = 0; jq < 4; jq++)
            *(u32x2*)(op + 57344 + (((w8 * 4 + ct) * 64 + jq * 16 + lo) * 8)) = (u32x2){pk2(Uv[16 * ct + 4 * jq], Uv[16 * ct + 4 * jq + 1]), pk2(Uv[16 * ct + 4 * jq + 2], Uv[16 * ct + 4 * jq + 3])};
      } else {
#pragma unroll
        for (int i = 0; i < 64; i++) Wb[i * 136 + col - 128] = f2bf(Uv[i]);
      }
      }
    } else {
      const int t2 = tid - 256;
      if (live) {
#pragma unroll
      for (int i = 0; i < 4; i++) {
        const int idx = t2 + 256 * i, frag = idx >> 6, ln = idx & 63, ct = frag >> 2, m = frag & 3, r = ln & 15, jq = ln >> 4;
        const int c = 16 * ct + r, d0 = 32 * m + 4 * jq;
        const u32x2 lo = *(const u32x2*)(Qb + c * 136 + d0), hi = *(const u32x2*)(Qb + c * 136 + d0 + 16);
        const float e = eg[c];
        *(u32x4*)(op + 16384 + idx * 16) = (u32x4){pk2(lo2f(lo[0]) * e, hi2f(lo[0]) * e), pk2(lo2f(lo[1]) * e, hi2f(lo[1]) * e), pk2(lo2f(hi[0]) * e, hi2f(hi[0]) * e), pk2(lo2f(hi[1]) * e, hi2f(hi[1]) * e)};
      }
#pragma unroll
      for (int i = 0; i < 4; i++) {
        const int idx = t2 + 256 * i, frag = idx >> 6, ln = idx & 63, dt = frag >> 1, kk = frag & 1, r = ln & 15, jq = ln >> 4;
        const int d = 16 * dt + r;
        float v[8];
#pragma unroll
        for (int j = 0; j < 8; j++) { const int c = 32 * kk + 16 * (j >> 2) + 4 * jq + (j & 3); v[j] = bf2f(Kb[c * 136 + d]) * ek[c]; }
        *(u32x4*)(op + 40960 + idx * 16) = (u32x4){pk2(v[0], v[1]), pk2(v[2], v[3]), pk2(v[4], v[5]), pk2(v[6], v[7])};
      }
#pragma unroll
      for (int i = 0; i < 2; i++) {
        const int idx = t2 + 256 * i, frag = idx >> 6, ln = idx & 63, ct = frag >> 1, kk = frag & 1, r = ln & 15, jq = ln >> 4;
        const int row = 16 * ct + r, c0 = 32 * kk + 4 * jq;
        const u32x2 lo = *(const u32x2*)(QKb + row * 72 + c0), hi = *(const u32x2*)(QKb + row * 72 + c0 + 16);
        *(u32x4*)(op + 32768 + idx * 16) = (u32x4){lo[0], lo[1], hi[0], hi[1]};
      }
      }
      if (ci + G_ < 2048) prep_conv(R, ab, WL + ((k + 1) & 1) * 1536, a_log, dt_bias, glbuf, stash, half, ci + G_, smem + P_SET0 + ((k + 1) & 1) * P_SET, t2, 256);
      if (ci + 2 * G_ < 2048) prep_loadw(cw, ci + 2 * G_, WL + (k & 1) * 1536, t2, 256);
    }
    LDS_BAR();
    if (live)
#pragma unroll
    for (int i = 0; i < 2; i++) {
      const int idx = tid + 512 * i, frag = idx >> 6, ln = idx & 63, ct = frag >> 2, m = frag & 3, r = ln & 15, jq = ln >> 4;
      const int c = 16 * ct + r, d0 = 32 * m + 4 * jq;
      const u32x2 lo = *(const u32x2*)(Wb + c * 136 + d0), hi = *(const u32x2*)(Wb + c * 136 + d0 + 16);
      *(u32x4*)(op + idx * 16) = (u32x4){lo[0], lo[1], hi[0], hi[1]};
    }
  }
  LDS_BAR();
}

DI void scan_block(const char* __restrict__ ops, const float* __restrict__ glbuf, bf16_t* __restrict__ mix, float* __restrict__ ssq,
                   f32x4* __restrict__ stbuf, int half, char* smem) {
  const int bx_ = obid(), G_ = ogrid(); (void)bx_; (void)G_;
  ops = lp(ops);
  glbuf = lp(glbuf);
  mix = lp(mix);
  ssq = lp(ssq);
  stbuf = lp(stbuf);
  smem += zoff();
  const int tid = otid(), lane = tid & 63, w = tid >> 6, fr = lane & 15, fq = lane >> 4;
  const bool comp = w < 4;
  const int blk = bx_, bl = blk >> 3, hh = blk & 7;
  const int chunk0 = (bl * 8 + hh) * 64;
  const int tokbase = bl * 8192 + half * 4096;
  const char* cp = ops + (size_t)chunk0 * OPS_STRIDE;
  float* part = (float*)(smem + 114688);
  {
    u32x4 pr0[7];
#pragma unroll
    for (int i = 0; i < 7; i++) pr0[i] = ((const u32x4*)cp)[tid + 512 * i];
    __builtin_amdgcn_sched_barrier(0);
#pragma unroll
    for (int i = 0; i < 7; i++) ((u32x4*)smem)[tid + 512 * i] = pr0[i];
  }
  __syncthreads();
  if (!comp) {
    const int t2 = tid - 256;
    u32x4 sx[14], sy[14];
    {
      const u32x4* np = (const u32x4*)(cp + (size_t)1 * OPS_STRIDE);
#pragma unroll
      for (int i = 0; i < 14; i++) sy[i] = np[t2 + 256 * i];
    }
    for (int n = 0; n < 64; n += 2) {
      if (n + 2 < 64) {
        const u32x4* np = (const u32x4*)(cp + (size_t)(n + 2) * OPS_STRIDE);
#pragma unroll
        for (int i = 0; i < 14; i++) sx[i] = np[t2 + 256 * i];
      }
      {
        u32x4* nb = (u32x4*)(smem + 57344);
#pragma unroll
        for (int i = 0; i < 14; i++) nb[t2 + 256 * i] = sy[i];
      }
      asm volatile("s_waitcnt lgkmcnt(0)" ::: "memory");
      __builtin_amdgcn_s_barrier();
      asm volatile("" ::: "memory");
      if (n + 3 < 64) {
        const u32x4* np = (const u32x4*)(cp + (size_t)(n + 3) * OPS_STRIDE);
#pragma unroll
        for (int i = 0; i < 14; i++) sy[i] = np[t2 + 256 * i];
      }
      if (n + 2 < 64) {
        u32x4* nb = (u32x4*)smem;
#pragma unroll
        for (int i = 0; i < 14; i++) nb[t2 + 256 * i] = sx[i];
      }
      asm volatile("s_waitcnt lgkmcnt(0)" ::: "memory");
      __builtin_amdgcn_s_barrier();
      asm volatile("" ::: "memory");
    }
  } else {
    f32x4* stp = stbuf + ((size_t)(blk * 4 + w) * 16) * 64 + lane;
    f32x4 S[8][2]; bf16x8 sB[4][2];
#pragma unroll
    for (int i = 0; i < 8; i++)
#pragma unroll
      for (int nt = 0; nt < 2; nt++) S[i][nt] = half ? stp[(i * 2 + nt) * 64] : (f32x4){0.f, 0.f, 0.f, 0.f};
#pragma unroll
    for (int m = 0; m < 4; m++)
#pragma unroll
      for (int nt = 0; nt < 2; nt++) sB[m][nt] = pack8(S[2 * m][nt], S[2 * m + 1][nt]);
    u32x2 uf[4][2];
#pragma unroll
    for (int ct = 0; ct < 4; ct++)
#pragma unroll
      for (int nt = 0; nt < 2; nt++) uf[ct][nt] = *(const u32x2*)(cp + 57344 + (((2 * w + nt) * 4 + ct) * 64 + lane) * 8);
    float gl = glbuf[chunk0];
    for (int n = 0; n < 64; n++) {
      const char* buf = smem + (n & 1) * 57344;
      if (n > 0 && lane < 16) {
        const float* pp = part + ((n - 1) & 1) * 256 + 16 * w + lane;
        ssq[(size_t)(tokbase + (n - 1) * 64 + 16 * w + lane) * 8 + hh] = pp[0] + pp[64] + pp[128] + pp[192];
      }
      bf16x8 vB[2][2];
      {
        f32x4 vn[4][2];
#pragma unroll
        for (int ct = 0; ct < 4; ct++) {
          f32x4 t0 = (f32x4){0.f, 0.f, 0.f, 0.f}, t1 = t0;
#pragma unroll
          for (int m = 0; m < 4; m++) {
            const bf16x8 a = *(const bf16x8*)(buf + ((ct * 4 + m) * 64 + lane) * 16);
            t0 = mfma16(a, sB[m][0], t0); t1 = mfma16(a, sB[m][1], t1);
          }
          vn[ct][0] = (f32x4){lo2f(uf[ct][0][0]) - t0[0], hi2f(uf[ct][0][0]) - t0[1], lo2f(uf[ct][0][1]) - t0[2], hi2f(uf[ct][0][1]) - t0[3]};
          vn[ct][1] = (f32x4){lo2f(uf[ct][1][0]) - t1[0], hi2f(uf[ct][1][0]) - t1[1], lo2f(uf[ct][1][1]) - t1[2], hi2f(uf[ct][1][1]) - t1[3]};
        }
#pragma unroll
        for (int kk = 0; kk < 2; kk++)
#pragma unroll
          for (int nt = 0; nt < 2; nt++) vB[kk][nt] = pack8(vn[2 * kk][nt], vn[2 * kk + 1][nt]);
      }
      const float glc = gl;
      if (n + 1 < 64) {
        const char* np = cp + (size_t)(n + 1) * OPS_STRIDE;
#pragma unroll
        for (int ct = 0; ct < 4; ct++)
#pragma unroll
          for (int nt = 0; nt < 2; nt++) uf[ct][nt] = *(const u32x2*)(np + 57344 + (((2 * w + nt) * 4 + ct) * 64 + lane) * 8);
        gl = glbuf[chunk0 + n + 1];
      }
      __builtin_amdgcn_sched_barrier(0);
      float v[16];
      {
        bf16_t* mp = mix + (size_t)(tokbase + n * 64) * 1536 + hh * 128 + 32 * w + fr;
#pragma unroll
        for (int ct = 0; ct < 4; ct++) {
          f32x4 t0 = (f32x4){0.f, 0.f, 0.f, 0.f}, t1 = t0;
#pragma unroll
          for (int m = 0; m < 4; m++) {
            const bf16x8 a = *(const bf16x8*)(buf + 16384 + ((ct * 4 + m) * 64 + lane) * 16);
            t0 = mfma16(a, sB[m][0], t0); t1 = mfma16(a, sB[m][1], t1);
          }
#pragma unroll
          for (int kk = 0; kk < 2; kk++) {
            const bf16x8 a = *(const bf16x8*)(buf + 32768 + ((ct * 2 + kk) * 64 + lane) * 16);
            t0 = mfma16(a, vB[kk][0], t0); t1 = mfma16(a, vB[kk][1], t1);
          }
#pragma unroll
          for (int ii = 0; ii < 4; ii++) {
            const bf16_t b0 = f2bf(t0[ii]), b1 = f2bf(t1[ii]);
            bf16_t* rp = mp + (size_t)(16 * ct + 4 * fq + ii) * 1536;
            rp[0] = b0; rp[16] = b1;
            const float f0 = bf2f(b0), f1 = bf2f(b1);
            v[ct * 4 + ii] = f0 * f0 + f1 * f1;
          }
        }
      }
      __builtin_amdgcn_sched_barrier(0);
#pragma unroll
      for (int dt = 0; dt < 8; dt++) {
        f32x4 t0 = S[dt][0] * glc, t1 = S[dt][1] * glc;
#pragma unroll
        for (int kk = 0; kk < 2; kk++) {
          const bf16x8 a = *(const bf16x8*)(buf + 40960 + ((dt * 2 + kk) * 64 + lane) * 16);
          t0 = mfma16(a, vB[kk][0], t0); t1 = mfma16(a, vB[kk][1], t1);
        }
        S[dt][0] = t0; S[dt][1] = t1;
      }
#pragma unroll
      for (int m = 0; m < 4; m++)
#pragma unroll
        for (int nt = 0; nt < 2; nt++) sB[m][nt] = pack8(S[2 * m][nt], S[2 * m + 1][nt]);
      __builtin_amdgcn_sched_barrier(0);
#pragma unroll
      for (int st = 8; st >= 1; st >>= 1) {
        const bool hiL = (fr & st) != 0;
#pragma unroll
        for (int k = 0; k < st; k++) {
          const float keep = hiL ? v[k + st] : v[k];
          const float send = hiL ? v[k] : v[k + st];
          v[k] = keep + __shfl_xor(send, st);
        }
      }
      part[(n & 1) * 256 + w * 64 + 16 * (fr >> 2) + 4 * fq + (fr & 3)] = v[0];
      asm volatile("s_waitcnt lgkmcnt(0)" ::: "memory");
      __builtin_amdgcn_s_barrier();
      asm volatile("" ::: "memory");
    }
    if (lane < 16) {
      const float* pp = part + (63 & 1) * 256 + 16 * w + lane;
      ssq[(size_t)(tokbase + 63 * 64 + 16 * w + lane) * 8 + hh] = pp[0] + pp[64] + pp[128] + pp[192];
    }
    if (half == 0) {
#pragma unroll
      for (int i = 0; i < 8; i++)
#pragma unroll
        for (int nt = 0; nt < 2; nt++) stp[(i * 2 + nt) * 64] = S[i][nt];
    }
  }
  __syncthreads();
}

#define XB_TMO      128
#define XB_XCNT(j)  (256  + 64 * (j))
#define XB_XSUB(j)  (1280 + 64 * (j))
#define XB_XGEN(j)  (2304 + 64 * (j))
#define XB_TOP      3328
#define XB_TOPGEN   3392
#define XCD_BAR_WORDS 3456
#define XB_SPIN_CAP (1u << 18)

__device__ __forceinline__ unsigned xb_ld(unsigned* p)              { return __hip_atomic_load(p, __ATOMIC_RELAXED, __HIP_MEMORY_SCOPE_AGENT); }
__device__ __forceinline__ unsigned xb_add(unsigned* p, unsigned v) { return __hip_atomic_fetch_add(p, v, __ATOMIC_RELAXED, __HIP_MEMORY_SCOPE_AGENT); }
__device__ __forceinline__ unsigned xb_xcc_id() { return (unsigned)__builtin_amdgcn_s_getreg((3 << 11) | 20) & 0xFu; }
#define XB_SPIN(cond, bar) do { unsigned _sp = 0; while (cond) { __builtin_amdgcn_s_sleep(1); \
    if ((++_sp & 255u) == 0u) { if (xb_ld(&(bar)[XB_TMO])) break; if (_sp > XB_SPIN_CAP) { atomicAdd(&(bar)[XB_TMO], 1u); break; } } } } while (0)

struct XcdBarrier {
    unsigned* bar; unsigned x;
    volatile LAS unsigned* st;
};

__device__ __forceinline__ XcdBarrier xcd_barrier_post(unsigned* bar, volatile LAS unsigned* st) {
    XcdBarrier b; b.bar = bar; b.x = xb_xcc_id(); b.st = st;
    if (threadIdx.x == 0) (void)xb_add(&bar[XB_XCNT(b.x)], 1u);
    return b;
}
__device__ __forceinline__ void xcd_barrier_complete(unsigned* bar, unsigned x, unsigned& nloc, unsigned& nx) {
    const unsigned G = gridDim.x * gridDim.y * gridDim.z;
    unsigned sum, cnt, mine, sp = 0u;
    for (;;) {
        sum = 0u; cnt = 0u; mine = 0u;
#pragma unroll
        for (unsigned j = 0; j < 16; ++j) { const unsigned c = xb_ld(&bar[XB_XCNT(j)]); sum += c; cnt += (c > 0u) ? 1u : 0u; mine = (j == x) ? c : mine; }
        if (sum == G) break;
        __builtin_amdgcn_s_sleep(1);
        if ((++sp & 255u) == 0u) { if (xb_ld(&bar[XB_TMO])) break; if (sp > XB_SPIN_CAP) { atomicAdd(&bar[XB_TMO], 1u); break; } }
    }
    nloc = mine > 0u ? mine : 1u; nx = cnt > 0u ? cnt : 1u;
}

__device__ __forceinline__ void xcd_barrier(const XcdBarrier& b) {
    asm volatile("s_waitcnt vmcnt(0)" ::: "memory");
    __syncthreads();
    if (threadIdx.x == 0) {
        unsigned* bar = b.bar;
        __builtin_amdgcn_s_waitcnt(0);
        unsigned nloc = b.st[0], nx = b.st[1];
        if (nloc == 0u) { xcd_barrier_complete(bar, b.x, nloc, nx); b.st[0] = nloc; b.st[1] = nx; }
        const unsigned old = xb_add(&bar[XB_XSUB(b.x)], 1u);
        const unsigned gen = old / nloc;
        if (old + 1u == (gen + 1u) * nloc) {
            __builtin_amdgcn_fence(__ATOMIC_RELEASE, "agent");
            asm volatile("s_waitcnt vmcnt(0)" ::: "memory");
            const unsigned og = xb_add(&bar[XB_TOP], 1u);
            const unsigned tg = og / nx;
            if (og + 1u == (tg + 1u) * nx) xb_add(&bar[XB_TOPGEN], 1u);
            else XB_SPIN(xb_ld(&bar[XB_TOPGEN]) == tg, bar);
            __builtin_amdgcn_fence(__ATOMIC_ACQUIRE, "agent");
            xb_add(&bar[XB_XGEN(b.x)], 1u);
            asm volatile("s_waitcnt vmcnt(0)" ::: "memory");
        } else {
            XB_SPIN(xb_ld(&bar[XB_XGEN(b.x)]) == gen, bar);
            __builtin_amdgcn_fence(__ATOMIC_ACQUIRE, "agent");
            asm volatile("s_waitcnt vmcnt(0)" ::: "memory");
        }
    }
    __syncthreads();
}

constexpr int PRM_NPRE = 0, PRM_NPOST = 4096, PRM_ALNW = 8192, PRM_ALNB = 10240, PRM_ABS = 12288, PRM_BCW = 14336, PRM_CCW = 17408, PRM_CALOG = 29696, PRM_CDT = 29704, PRM_CONW = 29712;
#define WS_PTRS(ws) \
  const float* PRM = (const float*)(ws + OFF_PRM); \
  bf16_t* W2 = (bf16_t*)(ws + OFF_W2); \
  bf16_t* WO = (bf16_t*)(ws + OFF_WO); \
  bf16_t* WM = (bf16_t*)(ws + OFF_WM); \
  bf16_t* WS = (bf16_t*)(ws + OFF_WS); \
  bf16_t* HMEM = (bf16_t*)(ws + OFF_HMEM); \
  bf16_t* KIMG = (bf16_t*)(ws + OFF_KIMG); \
  bf16_t* VIMG = (bf16_t*)(ws + OFF_VIMG); \
  float* AB = (float*)(ws + OFF_AB); \
  float* SSQ = (float*)(ws + OFF_SSQ); \
  float* GL = (float*)(ws + OFF_GL); \
  f32x4* STB = (f32x4*)(ws + OFF_ST); \
  bf16_t* STASH = (bf16_t*)(ws + OFF_STASH); \
  bf16_t* H = (bf16_t*)(ws + OFF_H); \
  bf16_t* MIX = (bf16_t*)(ws + OFF_MIX); \
  char* BIG = ws + OFF_BIG;
__global__ void __launch_bounds__(512) mega_kernel(Params p) {
  __shared__ __attribute__((aligned(16))) char smem[LDS_BYTES];
  cg::grid_group grid = cg::this_grid();
  char* ws0 = p.ws;
  volatile LAS unsigned* xst = (volatile LAS unsigned*)(LAS unsigned char*)(smem + XST_OFF);
  if (threadIdx.x < 2) xst[threadIdx.x] = 0u;
  __syncthreads();
  const XcdBarrier xb = xcd_barrier_post((unsigned*)(ws0 + OFF_BAR), xst);

  {
  char* ws = lp(ws0);
  WS_PTRS(ws)
  conv_seg(p.a_w_in, 4096, 0, 2560, (bf16_t*)(ws + OFF_W1_0), 1024, smem);
  conv_seg(p.a_w_in, 4096, 2560, 1536, W2, 1024, smem);
  conv_seg(p.a_w_in + 1024 * 4096, 4096, 0, 2560, (bf16_t*)(ws + OFF_W1_3), 1024, smem);
  conv_seg(p.a_w_in + 1024 * 4096, 4096, 2560, 1536, W2 + 3 * 1536 * 1024, 1024, smem);
  conv_seg(p.b_w_in, 5120, 0, 3584, (bf16_t*)(ws + OFF_W1_1), 1024, smem);
  conv_seg(p.b_w_in, 5120, 3584, 1536, W2 + 1 * 1536 * 1024, 1024, smem);
  conv_seg(p.c_w_in, 5136, 0, 3072, ((bf16_t*)(ws + OFF_W1_2)), 1024, smem);
  conv_seg(p.c_w_in, 5136, 3088, 512, ((bf16_t*)(ws + OFF_W1_2)) + 3072 * 1024, 1024, smem);
  conv_seg(p.c_w_in, 5136, 3072, 16, ((bf16_t*)(ws + OFF_W1_2)) + 3584 * 1024, 1024, smem);
  conv_seg(p.c_w_in, 5136, 3600, 1536, W2 + 2 * 1536 * 1024, 1024, smem);
  for (int l = 0; l < 4; l++) conv_seg(p.w_out + (size_t)l * 1536 * 1024, 1024, 0, 1024, WO + (size_t)l * 1024 * 1536, 1536, smem);
  conv_seg(p.w_mem_kv, 1024, 0, 1024, WM, 1024, smem);
  for (int i = blockIdx.x * 512 + otid(); i < 240 * 1024 / 2; i += gridDim.x * 512) ((unsigned*)(((bf16_t*)(ws + OFF_W1_2)) + 3600 * 1024))[i] = 0u;
  for (int i = blockIdx.x * 512 + otid(); i < 2 * 8 * 128 * 128; i += gridDim.x * 512) {
    const int s = i & 127, t = (i >> 7) & 127;
    WS[i] = (s <= t) ? f2bf(p.a_w_s[i]) : (bf16_t)0;
  }
  {
    float* prm = (float*)(ws + OFF_PRM);
    const int gt = blockIdx.x * 512 + otid(), gs = gridDim.x * 512;
    for (int i = gt; i < 4096; i += gs) { prm[PRM_NPRE + i] = p.norm_pre[i]; prm[PRM_NPOST + i] = p.norm_post[i]; }
    for (int i = gt; i < 2048; i += gs) { prm[PRM_ALNW + i] = p.a_ln_w[i]; prm[PRM_ALNB + i] = p.a_ln_b[i]; prm[PRM_ABS + i] = p.a_b_s[i]; }
    for (int i = gt; i < 3072; i += gs) prm[PRM_BCW + i] = p.b_conv_w[i];
    for (int i = gt; i < 12288; i += gs) prm[PRM_CCW + i] = p.c_conv_w[i];
    for (int i = gt; i < 8; i += gs) { prm[PRM_CALOG + i] = p.c_a_log[i]; prm[PRM_CDT + i] = p.c_dt_bias[i]; }
    for (int i = gt; i < 128; i += gs) prm[PRM_CONW + i] = p.c_o_norm_w[i];
  }
  rmsnorm_rows(p.x, p.norm_pre, H, NTOK);
  rmsnorm_rows(p.mem, p.mem_norm_w, HMEM, 1024);
  }
  grid.sync();

  for (int ph = 0; ph < 23; ph++) {
    char* ws = lp(ws0);
    WS_PTRS(ws)
    int l, q;
    if (ph < 5) { l = 0; q = ph; } else if (ph < 10) { l = 1; q = ph - 5; } else if (ph < 18) { l = 2; q = ph - 10; } else { l = 3; q = ph - 18; }
    const int kind = l % 3;
    int op, hf = 0;
    if (kind == 2) { op = q == 0 ? 0 : q == 1 ? 1 : q == 2 ? 6 : q == 3 ? 1 : q == 4 ? 7 : q == 5 ? 8 : q == 6 ? 4 : 5; hf = q >= 3 ? 1 : 0; }
    else op = q == 0 ? 0 : (q == 1 ? 2 : q + 1);
    const int bx = blockIdx.x, G = gridDim.x;
    const bool scanblk = (op == 6 || op == 7) && bx < 32;
    if (op == 0 || (op == 6 && !scanblk)) {
      const bf16_t* W1l = (const bf16_t*)(ws + (l == 0 ? OFF_W1_0 : l == 1 ? OFF_W1_1 : l == 2 ? OFF_W1_2 : OFF_W1_3));
      if (kind == 0) {
        EpiA1 e{(bf16_t*)BIG, (bf16_t*)(BIG + BIG_VT), (bf16_t*)(BIG + BIG_QX)};
        gemm_phase(H, W1l, NTOK, 2560, 1024, e, smem);
      } else if (kind == 1) {
        EpiPlain e{(bf16_t*)BIG, 3584};
        gemm_phase(H, W1l, NTOK, 3584, 1024, e, smem);
      } else {
        const int g1h = op == 6 ? 1 : 0;
        EpiC1 e{(bf16_t*)BIG, AB, g1h * 4096};
        gemm_phase(H, W1l, 16384, 3840, 1024, e, smem, g1h * 4096, op == 6 ? G - 32 : -1, bx - 32);
      }
      if (l == 0) {
        EpiMem e{KIMG, VIMG};
        gemm_phase(HMEM, WM, 1024, 1024, 1024, e, smem);
      }
    }
    if (op == 1) prep_phase((const bf16_t*)BIG, AB, PRM + PRM_CCW, PRM + PRM_CALOG, PRM + PRM_CDT, BIG + BIG_OPS, GL, STASH, hf, smem);
    if (op == 2) {
      if (kind == 0) {
        const int j = l / 3;
        gmlp_phase((const bf16_t*)BIG, (const bf16_t*)(BIG + BIG_VT), WS + (size_t)j * 8 * 128 * 128, PRM + PRM_ALNW + j * 1024, PRM + PRM_ALNB + j * 1024,
                   PRM + PRM_ABS + j * 1024, MIX, smem);
      } else {
        sconv_phase((const bf16_t*)BIG, PRM + PRM_BCW, MIX);
      }
    }
    if (scanblk) scan_block(BIG + BIG_OPS, GL, MIX, SSQ, STB, op == 6 ? 0 : 1, smem);
    if (op == 1 || op == 2) {
      const bf16_t* Q; int ldq, tok0, nrows;
      if (kind == 0) { Q = (const bf16_t*)(BIG + BIG_QX); ldq = 512; tok0 = -1; nrows = NTOK; }
      else if (kind == 1) { Q = (const bf16_t*)BIG + 3072; ldq = 3584; tok0 = -1; nrows = NTOK; }
      else { Q = (const bf16_t*)BIG + 3072; ldq = 3584; tok0 = hf * 4096; nrows = 16384; }
      attn_phase(Q, ldq, tok0, nrows, KIMG, VIMG, MIX, bx, G, smem);
    }
    if (op == 3 || op == 8 || (op == 7 && !scanblk)) {
      const int nv = op == 7 ? 2 : 1;
      for (int v = 0; v < nv; v++) {
        const bf16_t* Bz = W2 + (size_t)l * 1536 * 1024;
        int M = NTOK, N = 1536, asplit = -1, col0 = 0;
        if (op == 7 && v == 0) { Bz += (size_t)1024 * 1024; N = 512; col0 = 1024; }
        if ((op == 7 && v == 1) || op == 8) { M = 16384; N = 1024; asplit = op == 8 ? 4096 : 0; }
        EpiGate e{MIX, SSQ, PRM + PRM_CONW, kind == 2 ? 1 : 0, col0, asplit};
        gemm_phase(H, Bz, M, N, 1024, e, smem, asplit, op == 7 ? G - 32 : -1, bx - 32);
      }
    }
    if (op == 4) {
      EpiOut e{(bf16_t*)BIG};
      gemm_phase(MIX, WO + (size_t)l * 1024 * 1536, NTOK, 1024, 1536, e, smem);
    }
    if (op == 5) {
      norm_phase((const bf16_t*)BIG, l == 0 ? p.x : p.out, p.out, PRM + PRM_NPOST + l * 1024, l < 3 ? PRM + PRM_NPRE + (l + 1) * 1024 : nullptr, H);
    }
    xcd_barrier(xb);
  }
}

extern "C" void kernel_launch(void* const* d_in, const int* in_sizes, int n_in, void* d_out, int out_size, void* d_ws, size_t ws_size,
                              hipStream_t stream) {
  static int grid_blocks = 0;
  if (!grid_blocks) {
    int dev = 0, cus = 0, per_cu = 0;
    (void)hipGetDevice(&dev);
    (void)hipDeviceGetAttribute(&cus, hipDeviceAttributeMultiprocessorCount, dev);
    (void)hipOccupancyMaxActiveBlocksPerMultiprocessor(&per_cu, mega_kernel, 512, 0);
    if (per_cu > 1) per_cu = 1;
    if (per_cu < 1) per_cu = 1;
    grid_blocks = cus * per_cu;
  }
  Params p{};
  p.x = (const float*)d_in[0]; p.mem = (const float*)d_in[1]; p.mem_norm_w = (const float*)d_in[2]; p.w_mem_kv = (const float*)d_in[3];
  p.norm_pre = (const float*)d_in[4]; p.norm_post = (const float*)d_in[5]; p.w_out = (const float*)d_in[6]; p.a_w_in = (const float*)d_in[7];
  p.a_ln_w = (const float*)d_in[8]; p.a_ln_b = (const float*)d_in[9]; p.a_w_s = (const float*)d_in[10]; p.a_b_s = (const float*)d_in[11];
  p.b_w_in = (const float*)d_in[12]; p.b_conv_w = (const float*)d_in[13]; p.c_w_in = (const float*)d_in[14]; p.c_conv_w = (const float*)d_in[15];
  p.c_a_log = (const float*)d_in[16]; p.c_dt_bias = (const float*)d_in[17]; p.c_o_norm_w = (const float*)d_in[18];
  p.out = (float*)d_out;
  p.ws = (char*)d_ws;
  (void)hipMemsetAsync((char*)d_ws + OFF_BAR, 0, XCD_BAR_WORDS * sizeof(unsigned), stream);
  void* args[] = {&p};
  hipError_t e = hipLaunchCooperativeKernel((void*)mega_kernel, dim3(grid_blocks), dim3(512), args, 0, stream);
  if (e != hipSuccess) fprintf(stderr, "cooperative launch failed: %s (grid %d)\n", hipGetErrorString(e), grid_blocks);
}
```
